# Optimizing an MI355X kernel written in HIP

```python
import jax, jax.numpy as jnp
from jax import lax
import numpy as np

D_MODEL = 1024
BATCH = 16
SEQ = 2048
DEPTH = 2

CTX_LEN = 256
GRID_W = 64
HEAD_DIM = 64
ROPE_THETA = 10000.0
NORM_EPS = 1e-6
Q_BLOCK = 128
NEG_INF = -1e30
MIX_HEADS = D_MODEL // HEAD_DIM

A_HEADS = MIX_HEADS // 2
A_KV_HEADS = 2
A_GROUP = A_HEADS // A_KV_HEADS
A_Q = A_HEADS * HEAD_DIM
A_KV = A_KV_HEADS * HEAD_DIM
B_HEADS = MIX_HEADS // 2
B_Q_RANK = D_MODEL // 4
B_KV_RANK = D_MODEL // 8
B_NOPE_DIM = 64
B_ROPE_DIM = 32
B_V_DIM = 64
B_QK_DIM = B_NOPE_DIM + B_ROPE_DIM
EVEN_SPLITS = (A_Q, A_Q + A_KV, A_Q + 2 * A_KV, A_Q + 2 * A_KV + B_Q_RANK,
               A_Q + 2 * A_KV + B_Q_RANK + B_KV_RANK)
EVEN_IN = EVEN_SPLITS[-1] + B_ROPE_DIM
EVEN_OUT = A_HEADS * HEAD_DIM + B_HEADS * B_V_DIM

C_GROUPS = MIX_HEADS // 2
C_WIDTH = C_GROUPS * HEAD_DIM
C_CHUNK = 128
D_HEADS = MIX_HEADS // 2
D_KV_HEADS = 2
D_GROUP = D_HEADS // D_KV_HEADS
D_Q = D_HEADS * HEAD_DIM
D_KV = D_KV_HEADS * HEAD_DIM
WINDOW = 128
ODD_SPLITS = (C_WIDTH, 2 * C_WIDTH, 2 * C_WIDTH + D_Q, 2 * C_WIDTH + D_Q + D_KV)
ODD_IN = ODD_SPLITS[-1] + D_KV
ODD_OUT = C_WIDTH + D_Q

D_FF = 2816
CONV_W = 3

N_EVEN = (DEPTH + 1) // 2
N_ODD = DEPTH // 2

kernel_name = "hybrid_diffusion_gqa_mla_gmlp_swa_convffn"


def rms_norm(x, g):
    xf = x.astype(jnp.float32)
    y = xf * lax.rsqrt(jnp.mean(xf * xf, axis=-1, keepdims=True) + NORM_EPS)
    return (y * g.astype(jnp.float32)).astype(x.dtype)


def layer_norm(x, g, b):
    xf = x.astype(jnp.float32)
    mu = jnp.mean(xf, axis=-1, keepdims=True)
    xc = xf - mu
    y = xc * lax.rsqrt(jnp.mean(xc * xc, axis=-1, keepdims=True) + NORM_EPS)
    return (y * g.astype(jnp.float32) + b.astype(jnp.float32)).astype(x.dtype)


def modulate(x, shift, scale):
    return x * (1 + scale) + shift


def axial_rope_tables(n_tok, dim):
    n_rows = n_tok // GRID_W
    rows = jnp.repeat(jnp.arange(n_rows), GRID_W).astype(jnp.float32)
    cols = jnp.tile(jnp.arange(GRID_W), n_rows).astype(jnp.float32)
    quarter = dim // 4
    inv_freq = ROPE_THETA ** (-jnp.arange(quarter, dtype=jnp.float32) / quarter)
    ang = jnp.concatenate([rows[:, None] * inv_freq, cols[:, None] * inv_freq], axis=-1)
    return jnp.cos(ang), jnp.sin(ang)


def apply_rope(x, cos, sin):
    half = x.shape[-1] // 2
    x1, x2 = x[..., :half], x[..., half:]
    cos = cos.astype(x.dtype)
    sin = sin.astype(x.dtype)
    return jnp.concatenate([x1 * cos - x2 * sin, x1 * sin + x2 * cos], axis=-1)


def to_q_heads(x, n_kv, group, d):
    b, t, _ = x.shape
    return x.reshape(b, t, n_kv, group, d).transpose(0, 2, 3, 1, 4)


def to_kv_heads(x, n_kv, d):
    b, t, _ = x.shape
    return x.reshape(b, t, n_kv, d).transpose(0, 2, 1, 3)


def merge_heads(o):
    b, hkv, g, t, d = o.shape
    return o.transpose(0, 3, 1, 2, 4).reshape(b, t, hkv * g * d)


def attend(q, k, v, scale, mask=None, sink=None):
    s = jnp.einsum('bhgqd,bhkd->bhgqk', q, k).astype(jnp.float32) * scale
    if mask is not None:
        s = jnp.where(mask, s, NEG_INF)
    if sink is not None:
        hkv, g = q.shape[1], q.shape[2]
        sink_col = jnp.broadcast_to(sink.astype(jnp.float32).reshape(1, hkv, g, 1, 1), s.shape[:-1] + (1,))
        s = jnp.concatenate([s, sink_col], axis=-1)
    p = jax.nn.softmax(s, axis=-1)
    if sink is not None:
        p = p[..., :-1]
    return jnp.einsum('bhgqk,bhkd->bhgqd', p.astype(v.dtype), v)


def blocked_attend(q, k, v, scale):
    b, hkv, g, s, dk = q.shape
    nb = s // Q_BLOCK
    qb = jnp.moveaxis(q.reshape(b, hkv, g, nb, Q_BLOCK, dk), 3, 0)
    out = lax.map(lambda qi: attend(qi, k, v, scale), qb)
    return jnp.moveaxis(out, 0, 3).reshape(b, hkv, g, s, v.shape[-1])


def window_attend(q, k, v, kc, vc, sink, scale):
    b, hkv, g, s, d = q.shape
    nb = s // Q_BLOCK
    n_ctx = kc.shape[2]
    pad = ((0, 0), (0, 0), (Q_BLOCK, Q_BLOCK), (0, 0))
    kp, vp = jnp.pad(k, pad), jnp.pad(v, pad)
    qb = jnp.moveaxis(q.reshape(b, hkv, g, nb, Q_BLOCK, d), 3, 0)
    offset = jnp.arange(Q_BLOCK)[:, None] + Q_BLOCK - jnp.arange(3 * Q_BLOCK)[None, :]
    band = jnp.abs(offset) <= WINDOW
    ctx_ok = jnp.ones((Q_BLOCK, n_ctx), dtype=bool)

    def one_block(args):
        n, qi = args
        start = n * Q_BLOCK
        kw = lax.dynamic_slice_in_dim(kp, start, 3 * Q_BLOCK, axis=2)
        vw = lax.dynamic_slice_in_dim(vp, start, 3 * Q_BLOCK, axis=2)
        kpos = start - Q_BLOCK + jnp.arange(3 * Q_BLOCK)
        local_ok = band & ((kpos >= 0) & (kpos < s))[None, :]
        mask = jnp.concatenate([ctx_ok, local_ok], axis=-1)
        return attend(qi, jnp.concatenate([kc, kw], axis=2), jnp.concatenate([vc, vw], axis=2),
                      scale, mask=mask, sink=sink)

    out = lax.map(one_block, (jnp.arange(nb), qb))
    return jnp.moveaxis(out, 0, 3).reshape(b, hkv, g, s, d)


def even_project(z, w_in, qa_g, ka_g, qlat_g, w_q_up, kvlat_g, w_kv_up, rope):
    h = z @ w_in
    qa, ka, va, cq, ckv, kr = jnp.split(h, EVEN_SPLITS, axis=-1)
    qa = rms_norm(to_q_heads(qa, A_KV_HEADS, A_GROUP, HEAD_DIM), qa_g)
    ka = rms_norm(to_kv_heads(ka, A_KV_HEADS, HEAD_DIM), ka_g)
    va = to_kv_heads(va, A_KV_HEADS, HEAD_DIM)
    qb = to_q_heads(rms_norm(cq, qlat_g) @ w_q_up, B_HEADS, 1, B_QK_DIM)
    kvb = to_kv_heads(rms_norm(ckv, kvlat_g) @ w_kv_up, B_HEADS, B_NOPE_DIM + B_V_DIM)
    kb_nope, vb = kvb[..., :B_NOPE_DIM], kvb[..., B_NOPE_DIM:]
    kr = kr[:, None]
    if rope is not None:
        cos_h, sin_h, cos_r, sin_r = rope
        qa = apply_rope(qa, cos_h, sin_h)
        ka = apply_rope(ka, cos_h, sin_h)
        qb = jnp.concatenate([qb[..., :B_NOPE_DIM], apply_rope(qb[..., B_NOPE_DIM:], cos_r, sin_r)], axis=-1)
        kr = apply_rope(kr, cos_r, sin_r)
    kb = jnp.concatenate([kb_nope, jnp.broadcast_to(kr, kb_nope.shape[:-1] + (B_ROPE_DIM,))], axis=-1)
    return qa, ka, va, qb, kb, vb


def even_mixer(zc, zl, w_in, qa_g, ka_g, qlat_g, w_q_up, kvlat_g, w_kv_up, w_out, rope, need_ctx):
    qa_c, ka_c, va_c, qb_c, kb_c, vb_c = even_project(zc, w_in, qa_g, ka_g, qlat_g, w_q_up, kvlat_g, w_kv_up, None)
    qa_l, ka_l, va_l, qb_l, kb_l, vb_l = even_project(zl, w_in, qa_g, ka_g, qlat_g, w_q_up, kvlat_g, w_kv_up, rope)
    scale_a = HEAD_DIM ** -0.5
    scale_b = B_QK_DIM ** -0.5
    ya = blocked_attend(qa_l, jnp.concatenate([ka_c, ka_l], axis=2), jnp.concatenate([va_c, va_l], axis=2), scale_a)
    yb = blocked_attend(qb_l, jnp.concatenate([kb_c, kb_l], axis=2), jnp.concatenate([vb_c, vb_l], axis=2), scale_b)
    yl = jnp.concatenate([merge_heads(ya), merge_heads(yb)], axis=-1) @ w_out
    yc = None
    if need_ctx:
        yac = attend(qa_c, ka_c, va_c, scale_a)
        ybc = attend(qb_c, kb_c, vb_c, scale_b)
        yc = jnp.concatenate([merge_heads(yac), merge_heads(ybc)], axis=-1) @ w_out
    return yc, yl


def chunk_sgu(u, v, ln_g, ln_b, w_s, b_s):
    bsz, t, _ = v.shape
    nc = t // C_CHUNK
    v = layer_norm(jax.nn.gelu(v), ln_g, ln_b)
    vg = v.reshape(bsz, nc, C_CHUNK, C_GROUPS, HEAD_DIM)
    mixed = jnp.einsum('gpq,bnqgd->bnpgd', w_s, vg) + b_s.T[:, :, None]
    return jax.nn.gelu(u) * mixed.reshape(bsz, t, C_WIDTH)


def odd_project(z, w_in, rope):
    h = z @ w_in
    u, v, qd, kd, vd = jnp.split(h, ODD_SPLITS, axis=-1)
    qd = to_q_heads(qd, D_KV_HEADS, D_GROUP, HEAD_DIM)
    kd = to_kv_heads(kd, D_KV_HEADS, HEAD_DIM)
    vd = to_kv_heads(vd, D_KV_HEADS, HEAD_DIM)
    if rope is not None:
        cos_h, sin_h = rope
        qd = apply_rope(qd, cos_h, sin_h)
        kd = apply_rope(kd, cos_h, sin_h)
    return u, v, qd, kd, vd


def odd_mixer(zc, zl, w_in, ln_g, ln_b, w_s, b_s, sink, w_out, rope, need_ctx):
    u_c, v_c, qd_c, kd_c, vd_c = odd_project(zc, w_in, None)
    u_l, v_l, qd_l, kd_l, vd_l = odd_project(zl, w_in, rope)
    scale = HEAD_DIM ** -0.5
    yc_l = chunk_sgu(u_l, v_l, ln_g, ln_b, w_s, b_s)
    yd_l = window_attend(qd_l, kd_l, vd_l, kd_c, vd_c, sink, scale)
    yl = jnp.concatenate([yc_l, merge_heads(yd_l)], axis=-1) @ w_out
    yc = None
    if need_ctx:
        yc_c = chunk_sgu(u_c, v_c, ln_g, ln_b, w_s, b_s)
        yd_c = attend(qd_c, kd_c, vd_c, scale, sink=sink)
        yc = jnp.concatenate([yc_c, merge_heads(yd_c)], axis=-1) @ w_out
    return yc, yl


def conv_ffn(z, w_up, conv_w, conv_b, w_down):
    h = z @ w_up
    t = h.shape[1]
    half = CONV_W // 2
    hp = jnp.pad(h, ((0, 0), (half, half), (0, 0)))
    h = sum(hp[:, i:i + t] * conv_w[i] for i in range(CONV_W)) + conv_b
    a, g = jnp.split(h, 2, axis=-1)
    return (jax.nn.silu(g) * a) @ w_down


def setup_inputs(seed: int = 0) -> dict:
    key = jax.random.key(seed)
    ks = iter(jax.random.split(key, 40))

    def nrm(shape, scale):
        return jax.random.normal(next(ks), shape, jnp.float32) * scale

    def gain(shape):
        return 1.0 + nrm(shape, 0.02)

    d = D_MODEL
    return {
        "x": nrm((BATCH, SEQ, d), 1.0),
        "c": nrm((BATCH, d), 1.0),
        "ctx": nrm((BATCH, CTX_LEN, d), 1.0),
        "c_ctx": nrm((d,), 1.0),
        "mod_w": nrm((DEPTH, d, 6 * d), 0.5 * d ** -0.5),
        "mod_b": nrm((DEPTH, 6 * d), 0.02),
        "norm1_g": gain((DEPTH, d)),
        "norm2_g": gain((DEPTH, d)),
        "ev_w_in": nrm((N_EVEN, d, EVEN_IN), d ** -0.5),
        "ev_qa_g": gain((N_EVEN, HEAD_DIM)),
        "ev_ka_g": gain((N_EVEN, HEAD_DIM)),
        "ev_qlat_g": gain((N_EVEN, B_Q_RANK)),
        "ev_w_q_up": nrm((N_EVEN, B_Q_RANK, B_HEADS * B_QK_DIM), B_Q_RANK ** -0.5),
        "ev_kvlat_g": gain((N_EVEN, B_KV_RANK)),
        "ev_w_kv_up": nrm((N_EVEN, B_KV_RANK, B_HEADS * (B_NOPE_DIM + B_V_DIM)), B_KV_RANK ** -0.5),
        "ev_w_out": nrm((N_EVEN, EVEN_OUT, d), EVEN_OUT ** -0.5),
        "od_w_in": nrm((N_ODD, d, ODD_IN), d ** -0.5),
        "od_ln_g": gain((N_ODD, C_WIDTH)),
        "od_ln_b": nrm((N_ODD, C_WIDTH), 0.02),
        "od_sgu_w": nrm((N_ODD, C_GROUPS, C_CHUNK, C_CHUNK), C_CHUNK ** -0.5),
        "od_sgu_b": 1.0 + nrm((N_ODD, C_GROUPS, C_CHUNK), 0.02),
        "od_sink": nrm((N_ODD, D_HEADS), 0.5),
        "od_w_out": nrm((N_ODD, ODD_OUT, d), ODD_OUT ** -0.5),
        "ffn_up": nrm((DEPTH, d, 2 * D_FF), d ** -0.5),
        "ffn_conv_w": nrm((DEPTH, CONV_W, 2 * D_FF), CONV_W ** -0.5),
        "ffn_conv_b": nrm((DEPTH, 2 * D_FF), 0.02),
        "ffn_down": nrm((DEPTH, D_FF, d), D_FF ** -0.5),
        "final_g": gain((d,)),
    }


def reference(x, c, ctx, c_ctx, mod_w, mod_b, norm1_g, norm2_g,
              ev_w_in, ev_qa_g, ev_ka_g, ev_qlat_g, ev_w_q_up, ev_kvlat_g, ev_w_kv_up, ev_w_out,
              od_w_in, od_ln_g, od_ln_b, od_sgu_w, od_sgu_b, od_sink, od_w_out,
              ffn_up, ffn_conv_w, ffn_conv_b, ffn_down, final_g):
    n_tok = x.shape[1]
    cos_h, sin_h = axial_rope_tables(n_tok, HEAD_DIM)
    cos_r, sin_r = axial_rope_tables(n_tok, B_ROPE_DIM)
    hl, hc = x, ctx
    for layer in range(DEPTH):
        need_ctx = layer != DEPTH - 1
        w_m, b_m = mod_w[layer], mod_b[layer]
        mod_l = [m[:, None, :] for m in jnp.split(jax.nn.silu(c) @ w_m + b_m, 6, axis=-1)]
        mod_c = jnp.split(jax.nn.silu(c_ctx) @ w_m + b_m, 6, axis=-1)
        zl = modulate(rms_norm(hl, norm1_g[layer]), mod_l[0], mod_l[1])
        zc = modulate(rms_norm(hc, norm1_g[layer]), mod_c[0], mod_c[1])
        if layer % 2 == 0:
            e = layer // 2
            yc, yl = even_mixer(zc, zl, ev_w_in[e], ev_qa_g[e], ev_ka_g[e], ev_qlat_g[e], ev_w_q_up[e],
                                ev_kvlat_g[e], ev_w_kv_up[e], ev_w_out[e],
                                (cos_h, sin_h, cos_r, sin_r), need_ctx)
        else:
            o = layer // 2
            yc, yl = odd_mixer(zc, zl, od_w_in[o], od_ln_g[o], od_ln_b[o], od_sgu_w[o], od_sgu_b[o],
                               od_sink[o], od_w_out[o], (cos_h, sin_h), need_ctx)
        hl = hl + mod_l[2] * yl
        hl = hl + mod_l[5] * conv_ffn(modulate(rms_norm(hl, norm2_g[layer]), mod_l[3], mod_l[4]),
                                      ffn_up[layer], ffn_conv_w[layer], ffn_conv_b[layer], ffn_down[layer])
        if need_ctx:
            hc = hc + mod_c[2] * yc
            hc = hc + mod_c[5] * conv_ffn(modulate(rms_norm(hc, norm2_g[layer]), mod_c[3], mod_c[4]),
                                          ffn_up[layer], ffn_conv_w[layer], ffn_conv_b[layer], ffn_down[layer])
    return rms_norm(hl, final_g)
```

```cpp
#include <hip/hip_runtime.h>
#include <hip/hip_cooperative_groups.h>
#include <cstdio>
#include <cstdint>
namespace cg = cooperative_groups;
namespace pg8 {
#define PG8_LAS __attribute__((address_space(3)))
typedef unsigned short bf16_t;
typedef short bf16x8 __attribute__((ext_vector_type(8)));
typedef float f32x4 __attribute__((ext_vector_type(4)));
typedef unsigned u32x4 __attribute__((ext_vector_type(4)));
constexpr int BM = 256, BK = 64, HALF = 128, HTB = HALF * BK * 2  , STAGE_BYTES = 8 * HTB, NXCD = 8, WGM = 8;

__host__ __device__ __forceinline__ int lds_byte(int r, int c) { const int st = (r >> 4) * 2 + (c >> 5), rr = r & 15, cc = c & 31, ob = rr * 64 + cc * 2; return st * 1024 + (ob ^ (((ob >> 9) & 1) << 5)); }
__host__ __device__ __forceinline__ void stage_rc(int b, int& R, int& C) { const int st = b / 1024, sb = b % 1024, swz = sb ^ (((sb >> 9) & 1) << 5); R = (st >> 1) * 16 + swz / 64; C = (st & 1) * 32 + (swz % 64) / 2; }
__host__ __device__ __forceinline__ int perm32(int rho) { const int n = rho >> 4, i = rho & 15; return 8 * (i >> 2) + 4 * n + (i & 3); }

struct Unit { int pm, pn; };
struct Gemm { const bf16_t* A; const bf16_t* Bt; int M, N, K, lda, ldb; };

struct StaticOrder {
    int nM, nN, nwg, G, c;
    __host__ __device__ void init(int M, int N, int G_, int c_) { nM = M / BM; nN = N / BM; nwg = nM * nN; G = G_; c = c_; }
    __host__ __device__ bool next(int i, Unit& u) const {
        const long L = (long)i * G + c; if (L >= nwg) return false;
        int wgid = (int)L; { const int q = nwg / NXCD, r = nwg % NXCD, xcd = wgid % NXCD, off = wgid / NXCD; wgid = (xcd < r ? xcd * (q + 1) : r * (q + 1) + (xcd - r) * q) + off; }
        const int nig = WGM * nN, gid = wgid / nig, fm = gid * WGM, gsz = (nM - fm) < WGM ? (nM - fm) : WGM;
        u.pm = fm + ((wgid % nig) % gsz); u.pn = (wgid % nig) / gsz; return true;
    }
    __device__ __forceinline__ void a_ready(const Unit&) const {}
    __device__ __forceinline__ void done(const Unit&) const {}
};

__device__ __forceinline__ unsigned cvt_pk_bf16(float lo, float hi) { unsigned r; asm volatile("v_cvt_pk_bf16_f32 %0, %1, %2" : "=v"(r) : "v"(lo), "v"(hi)); return r; }
typedef float f32x2 __attribute__((ext_vector_type(2)));
__device__ __forceinline__ f32x2 gelu_pk(f32x2 v) {
    const f32x2 av = __builtin_elementwise_abs(v), d = av * 0.2316418882f + 1.0f;
    f32x2 t; t.x = __builtin_amdgcn_rcpf(d.x); t.y = __builtin_amdgcn_rcpf(d.y);
    f32x2 q = t * 0.5307027145f + (-0.7265760135f); q = q * t + 0.7107068705f; q = q * t + (-0.142248368f); q = q * t + 0.127414796f; q = q * t;
    const f32x2 s = (v * v) * (-0.72134752044f);
    f32x2 e; e.x = __builtin_amdgcn_exp2f(s.x); e.y = __builtin_amdgcn_exp2f(s.y);
    const f32x2 m = v * (q * e), r = v - m;
    f32x2 o; o.x = v.x < 0.f ? m.x : r.x; o.y = v.y < 0.f ? m.y : r.y; return o;
}

template <int ACT  > struct EpiBf16 {
    static constexpr bool PERM = true, AFTER_DRAIN = false; static_assert(ACT == 0 || ACT == 1, "EpiBf16: ACT is 0 (none) or 1 (gelu_pk)");
    bf16_t* O; int ldc; const float* bias; int split_cols; size_t split_stride; float scale0;
    __device__ __forceinline__ void operator()(const f32x4 (&acc)[2][2][4][2], const Unit& u, int wr, int wc, int fr, int fq) const {
        const int row0 = u.pm * BM + wr * 64 + fr; int colt = u.pn * BM; bf16_t* base = O;
        float sc = 1.f; if (split_cols) { const int t = colt / split_cols; base += (size_t)t * split_stride; colt -= t * split_cols; if (t == 0) sc = scale0; }
        const int col0 = colt + wc * 32 + 8 * fq, bcol0 = u.pn * BM + wc * 32 + 8 * fq;
        f32x4 bv[2][2];
#pragma unroll
        for (int bj = 0; bj < 2; ++bj)
#pragma unroll
            for (int n = 0; n < 2; ++n) bv[bj][n] = bias ? *(const f32x4*)(bias + bcol0 + bj * HALF + 4 * n) : (f32x4){0.f, 0.f, 0.f, 0.f};
#pragma unroll
        for (int ai = 0; ai < 2; ++ai)
#pragma unroll
            for (int m = 0; m < 4; ++m) { bf16_t* rowp = base + (size_t)(row0 + ai * HALF + m * 16) * ldc + col0;
#pragma unroll
                for (int bj = 0; bj < 2; ++bj) { f32x4 v0 = acc[ai][bj][m][0] + bv[bj][0], v1 = acc[ai][bj][m][1] + bv[bj][1];
                    if (ACT == 1) { f32x2 a = gelu_pk((f32x2){v0[0], v0[1]}), b = gelu_pk((f32x2){v0[2], v0[3]}), c = gelu_pk((f32x2){v1[0], v1[1]}), d = gelu_pk((f32x2){v1[2], v1[3]});
                        v0 = (f32x4){a.x, a.y, b.x, b.y}; v1 = (f32x4){c.x, c.y, d.x, d.y}; }
                    v0 = v0 * sc; v1 = v1 * sc; u32x4 w; w.x = cvt_pk_bf16(v0[0], v0[1]); w.y = cvt_pk_bf16(v0[2], v0[3]); w.z = cvt_pk_bf16(v1[0], v1[1]); w.w = cvt_pk_bf16(v1[2], v1[3]);
                    *(u32x4*)(rowp + bj * HALF) = w; } }
    }
};
template <class Epi, class Sched, bool ALIGN_EPI = false, bool SP2 = false>
__device__ __forceinline__ void gemm_phase(PG8_LAS unsigned char* lds, const Gemm g, const Sched& S, const Epi& E) {
    int tid_ = threadIdx.x; asm volatile("" : "+v"(tid_));
    const int tid = tid_, wid = __builtin_amdgcn_readfirstlane(tid >> 6), lane = tid & 63, wr = wid >> 2, wc = wid & 3, fr = lane & 15, fq = lane >> 4;
    const int K = g.K, nt = K / BK;
    unsigned voffA[2], voffB[2];
#pragma unroll
    for (int i = 0; i < 2; ++i) { int R, C; stage_rc(tid * 16 + i * 8192, R, C); const int Rb = Epi::PERM ? ((R & ~31) + perm32(R & 31)) : R;
        voffA[i] = (unsigned)(R * g.lda + C) * 2u; voffB[i] = (unsigned)(Rb * g.ldb + C) * 2u; }
    const size_t kstep = (size_t)(BK * 2);
    const size_t hstepA = (size_t)HALF * g.lda * 2, hstepB = (size_t)HALF * g.ldb * 2;
    const size_t tstepA = 2 * hstepA, tstepB = 2 * hstepB;
    const unsigned ldsw = (unsigned)wid * 1024u;
    const int aoff = lds_byte(wr * 64 + fr, fq * 8), boff = lds_byte(wc * 32 + fr, fq * 8);
#define PG8_SA(b, h) (((b) * 2 + (h)) * HTB)
#define PG8_SB(b, h) ((4 + (b) * 2 + (h)) * HTB)
#define PG8_STAGE(bufoff, gbase, voff) do { _Pragma("unroll") for (int _i = 0; _i < 2; ++_i) \
        __builtin_amdgcn_global_load_lds((const unsigned*)((const char*)(gbase) + (voff)[_i]), (PG8_LAS unsigned*)(lds + (bufoff) + ldsw + _i * 8192), 16, 0, 0); } while (0)
#define PG8_LDA(dst, b, h) do { _Pragma("unroll") for (int m = 0; m < 4; ++m) _Pragma("unroll") for (int k = 0; k < 2; ++k) dst[m][k] = *(const PG8_LAS bf16x8*)(lds + PG8_SA(b, h) + aoff + m * 2048 + k * 1024); } while (0)
#define PG8_LDB(dst, b, h) do { _Pragma("unroll") for (int n = 0; n < 2; ++n) _Pragma("unroll") for (int k = 0; k < 2; ++k) dst[n][k] = *(const PG8_LAS bf16x8*)(lds + PG8_SB(b, h) + boff + n * 2048 + k * 1024); } while (0)
#define PG8_MMA(ai, bj, At, Bt) do { __builtin_amdgcn_s_setprio(1); _Pragma("unroll") for (int m = 0; m < 4; ++m) _Pragma("unroll") for (int n = 0; n < 2; ++n) _Pragma("unroll") for (int k = 0; k < 2; ++k) \
        acc[ai][bj][m][n] = __builtin_amdgcn_mfma_f32_16x16x32_bf16(Bt[n][k], At[m][k], acc[ai][bj][m][n], 0, 0, 0); __builtin_amdgcn_s_setprio(0); } while (0)
#define PG8_WAIT_V(n) asm volatile("s_waitcnt vmcnt(" #n ")" ::: "memory")
#define PG8_WAIT_L(n) asm volatile("s_waitcnt lgkmcnt(" #n ")" ::: "memory")
#define PG8_BAR __builtin_amdgcn_s_barrier()
#define PG8_SCHED __builtin_amdgcn_sched_barrier(0)
    Unit cur, nxt; int ui = 0;
    if (!S.next(0, cur)) return;
    f32x4 acc[2][2][4][2];
#pragma unroll
    for (int a = 0; a < 2; ++a)
#pragma unroll
        for (int b = 0; b < 2; ++b)
#pragma unroll
            for (int m = 0; m < 4; ++m)
#pragma unroll
                for (int n = 0; n < 2; ++n) acc[a][b][m][n] = (f32x4){0.f, 0.f, 0.f, 0.f};
    bf16x8 At[4][2], B0[2][2], B1[2][2];
    const char* cA = (const char*)g.A + (size_t)cur.pm * tstepA; const char* cB = (const char*)g.Bt + (size_t)cur.pn * tstepB;
    S.a_ready(cur);
    if constexpr (SP2) {
        PG8_STAGE(PG8_SB(0, 0), cB, voffB); PG8_STAGE(PG8_SB(0, 1), cB + hstepB, voffB); PG8_STAGE(PG8_SA(0, 0), cA, voffA); PG8_STAGE(PG8_SA(0, 1), cA + hstepA, voffA);
        if (wr == 1) PG8_BAR;
        PG8_WAIT_V(2); PG8_BAR;
        PG8_STAGE(PG8_SB(1, 0), cB + kstep, voffB); PG8_STAGE(PG8_SA(1, 0), cA + kstep, voffA); PG8_STAGE(PG8_SB(1, 1), cB + hstepB + kstep, voffB);
        PG8_WAIT_V(6); PG8_BAR;
    } else {
        PG8_STAGE(PG8_SB(0, 0), cB, voffB); PG8_STAGE(PG8_SA(0, 0), cA, voffA); PG8_STAGE(PG8_SB(0, 1), cB + hstepB, voffB); PG8_STAGE(PG8_SA(0, 1), cA + hstepA, voffA);
        if (wr == 1) PG8_BAR;
        PG8_WAIT_V(4); PG8_BAR;
        PG8_STAGE(PG8_SB(1, 0), cB + kstep, voffB); PG8_STAGE(PG8_SA(1, 0), cA + kstep, voffA); PG8_STAGE(PG8_SB(1, 1), cB + hstepB + kstep, voffB);
        PG8_WAIT_V(6); PG8_BAR;
    }
    for (;;) {
        const bool has_next = S.next(ui + 1, nxt);
        const char* nA = has_next ? (const char*)g.A + (size_t)nxt.pm * tstepA : cA; const char* nB = has_next ? (const char*)g.Bt + (size_t)nxt.pn * tstepB : cB;
        for (int t = 0; t < nt; t += 2) {
            const bool last = (t == nt - 2);
            const char* a1 = cA + (size_t)(t + 1) * kstep;
            const char* a2 = last ? nA : cA + (size_t)(t + 2) * kstep; const char* b2 = last ? nB : cB + (size_t)(t + 2) * kstep;
            const char* a3 = a2 + kstep; const char* b3 = b2 + kstep;
            if (last && has_next) S.a_ready(nxt);
            if constexpr (SP2) {
            PG8_LDB(B0, 0, 0); PG8_LDB(B1, 0, 1); PG8_SCHED; PG8_LDA(At, 0, 0); PG8_STAGE(PG8_SA(1, 1), a1 + hstepA, voffA);
            PG8_WAIT_V(8); PG8_WAIT_L(0); PG8_BAR; PG8_MMA(0, 0, At, B0); PG8_MMA(0, 1, At, B1); PG8_BAR; PG8_SCHED;
            PG8_LDA(At, 0, 1); PG8_STAGE(PG8_SB(0, 0), b2, voffB); PG8_STAGE(PG8_SB(0, 1), b2 + hstepB, voffB); PG8_STAGE(PG8_SA(0, 0), a2, voffA);
            PG8_WAIT_V(8); PG8_WAIT_L(0); PG8_BAR; PG8_MMA(1, 0, At, B0); PG8_MMA(1, 1, At, B1); PG8_BAR; PG8_SCHED;
            PG8_LDB(B0, 1, 0); PG8_LDB(B1, 1, 1); PG8_SCHED; PG8_LDA(At, 1, 0); PG8_STAGE(PG8_SA(0, 1), a2 + hstepA, voffA);
            PG8_WAIT_V(8); PG8_WAIT_L(0); PG8_BAR; PG8_MMA(0, 0, At, B0); PG8_MMA(0, 1, At, B1); PG8_BAR; PG8_SCHED;
            PG8_LDA(At, 1, 1); PG8_STAGE(PG8_SB(1, 0), b3, voffB); PG8_STAGE(PG8_SB(1, 1), b3 + hstepB, voffB); PG8_STAGE(PG8_SA(1, 0), a3, voffA);
            PG8_WAIT_V(8); PG8_WAIT_L(0); PG8_BAR; PG8_MMA(1, 0, At, B0); PG8_MMA(1, 1, At, B1); PG8_BAR; PG8_SCHED;
            } else {
            PG8_LDB(B0, 0, 0); PG8_SCHED; PG8_LDA(At, 0, 0); PG8_STAGE(PG8_SA(1, 1), a1 + hstepA, voffA);
            PG8_WAIT_L(8); PG8_BAR; PG8_WAIT_L(0); PG8_MMA(0, 0, At, B0); PG8_BAR; PG8_SCHED;
            PG8_LDB(B1, 0, 1); PG8_STAGE(PG8_SB(0, 0), b2, voffB);
            PG8_BAR; PG8_WAIT_L(0); PG8_MMA(0, 1, At, B1); PG8_BAR;
            PG8_LDA(At, 0, 1); PG8_STAGE(PG8_SA(0, 0), a2, voffA);
            PG8_BAR; PG8_WAIT_L(0); PG8_MMA(1, 0, At, B0); PG8_BAR; PG8_SCHED;
            PG8_STAGE(PG8_SB(0, 1), b2 + hstepB, voffB);
            PG8_WAIT_V(6); PG8_BAR; PG8_MMA(1, 1, At, B1); PG8_BAR;
            PG8_LDB(B0, 1, 0); PG8_SCHED; PG8_LDA(At, 1, 0); PG8_STAGE(PG8_SA(0, 1), a2 + hstepA, voffA);
            PG8_WAIT_L(8); PG8_BAR; PG8_WAIT_L(0); PG8_MMA(0, 0, At, B0); PG8_BAR; PG8_SCHED;
            PG8_LDB(B1, 1, 1); PG8_STAGE(PG8_SB(1, 0), b3, voffB);
            PG8_BAR; PG8_WAIT_L(0); PG8_MMA(0, 1, At, B1); PG8_BAR;
            PG8_LDA(At, 1, 1); PG8_STAGE(PG8_SA(1, 0), a3, voffA);
            PG8_BAR; PG8_WAIT_L(0); PG8_MMA(1, 0, At, B0); PG8_BAR; PG8_SCHED;
            PG8_STAGE(PG8_SB(1, 1), b3 + hstepB, voffB);
            PG8_WAIT_V(6); PG8_BAR; PG8_MMA(1, 1, At, B1); PG8_BAR;
            }
        }
        if constexpr (ALIGN_EPI) { if (wr == 0) PG8_BAR; }
        if constexpr (!Epi::AFTER_DRAIN) { E(acc, cur, wr, wc, fr, fq); S.done(cur); }
        if (!has_next) break;
#pragma unroll
        for (int a = 0; a < 2; ++a)
#pragma unroll
            for (int b = 0; b < 2; ++b)
#pragma unroll
                for (int m = 0; m < 4; ++m)
#pragma unroll
                    for (int n = 0; n < 2; ++n) acc[a][b][m][n] = (f32x4){0.f, 0.f, 0.f, 0.f};
        cur = nxt; cA = nA; cB = nB; ++ui;
        if constexpr (ALIGN_EPI) { if (wr == 1) PG8_BAR; }
    }
    PG8_WAIT_V(0);
    if constexpr (!ALIGN_EPI) { if (wr == 0) PG8_BAR; }
    PG8_BAR;
    if constexpr (Epi::AFTER_DRAIN) { E.fused(acc, cur, wr, wc, fr, fq, lds, wid, lane); S.done(cur); }
#undef PG8_SA
#undef PG8_SB
#undef PG8_STAGE
#undef PG8_LDA
#undef PG8_LDB
#undef PG8_MMA
#undef PG8_WAIT_V
#undef PG8_WAIT_L
#undef PG8_BAR
#undef PG8_SCHED
}
}

#define LAS __attribute__((address_space(3)))
#define DI __device__ __forceinline__
typedef unsigned short bf16_t;
typedef short bf16x8 __attribute__((ext_vector_type(8)));
typedef short s16x4 __attribute__((ext_vector_type(4)));
typedef float f32x4 __attribute__((ext_vector_type(4)));
typedef float f32x16 __attribute__((ext_vector_type(16)));
typedef unsigned u32x4 __attribute__((ext_vector_type(4)));
typedef unsigned u32x2 __attribute__((ext_vector_type(2)));
typedef float f32x2_t __attribute__((ext_vector_type(2)));
typedef __bf16 bf16x2_t __attribute__((ext_vector_type(2)));

constexpr int NB = 16, SEQ = 2048, DM = 1024, CTX = 256;
constexpr int ML = NB * SEQ;
constexpr int MC = NB * CTX;
constexpr int MT = ML + MC;
constexpr int FF = 2816, FF2 = 5632;
constexpr int EV_IN = 1184, EV_PITCH = 1280, OD_PITCH = 1792;
constexpr float EPS = 1e-6f;
constexpr float LOG2E = 1.4426950408889634f;
constexpr int NT = 512;

constexpr size_t MiB = 1u << 20;
constexpr size_t WS_MOD = 0;
constexpr size_t WS_TAB = 1 * MiB;
constexpr size_t WS_W_EVIN = 2 * MiB;
constexpr size_t WS_W_QUP = 5 * MiB;
constexpr size_t WS_W_KVUP = 6 * MiB;
constexpr size_t WS_W_EVOUT = 7 * MiB;
constexpr size_t WS_W_ODIN = 9 * MiB;
constexpr size_t WS_W_ODOUT = 13 * MiB;
constexpr size_t WS_W_UP = 15 * MiB;
constexpr size_t WS_W_DOWN = 37 * MiB;
constexpr size_t WS_HC = 48 * MiB;
constexpr size_t WS_Z = 64 * MiB;
constexpr size_t WS_BIG = 136 * MiB;
constexpr size_t WS_H = WS_BIG;
constexpr size_t WS_QB = WS_BIG + 126 * MiB;
constexpr size_t WS_KVB = WS_BIG + 180 * MiB;
constexpr size_t WS_Y = WS_BIG + 252 * MiB;
constexpr size_t WS_HUP = WS_BIG;
constexpr size_t WS_ACT = WS_BIG + 198 * MiB;

struct Params {
  const float *x, *c, *ctx, *c_ctx, *mod_w, *mod_b, *norm1_g, *norm2_g;
  const float *ev_w_in, *ev_qa_g, *ev_ka_g, *ev_qlat_g, *ev_w_q_up, *ev_kvlat_g, *ev_w_kv_up, *ev_w_out;
  const float *od_w_in, *od_ln_g, *od_ln_b, *od_sgu_w, *od_sgu_b, *od_sink, *od_w_out;
  const float *ffn_up, *ffn_conv_w, *ffn_conv_b, *ffn_down, *final_g;
  float* out; unsigned char* ws;
};

DI float bf2f(unsigned short b) { return __uint_as_float(((unsigned)b) << 16); }
DI float bflo(unsigned w) { return __uint_as_float(w << 16); }
DI float bfhi(unsigned w) { return __uint_as_float(w & 0xffff0000u); }
DI unsigned pk2(float lo, float hi) { f32x2_t v = {lo, hi}; bf16x2_t b = __builtin_convertvector(v, bf16x2_t); return __builtin_bit_cast(unsigned, b); }
DI unsigned short f2bf(float f) { return (unsigned short)(pk2(f, 0.f) & 0xffffu); }
DI float wave_sum(float v) {
#pragma unroll
  for (int o = 1; o < 64; o <<= 1) v += __shfl_xor(v, o);
  return v;
}
DI float sigmoidf_(float x) { return 1.f / (1.f + __expf(-x)); }
DI float siluf_(float x) { return x * sigmoidf_(x); }
DI float geluf_(float x) { const float u = 1.5957691216057308f * (x + 0.044715f * x * x * x); return x * sigmoidf_(u); }
DI int crow(int r, int hi) { return (r & 3) + 8 * (r >> 2) + 4 * hi; }
DI int modrow(int row) { return row < ML ? (row >> 11) : 16; }
DI int opaque_tid() { int t = threadIdx.x; asm volatile("" : "+v"(t)); return t; }

struct EpiRes {
  static constexpr bool PERM = false, AFTER_DRAIN = false;
  const float* baseL; const float* baseC; float* outL; float* outC; const float* gate;    int row0;
  DI void operator()(const pg8::f32x4 (&acc)[2][2][4][2], const pg8::Unit& u, int wr, int wc, int fr, int fq) const {
    const int rt = row0 + u.pm * 256; const bool lat = rt < ML; const int mr = lat ? (rt >> 11) : 16;
    const float* base = lat ? baseL + (size_t)rt * DM + u.pn * 256 : baseC + (size_t)(rt - ML) * DM + u.pn * 256;
    float* out = lat ? outL + (size_t)rt * DM + u.pn * 256 : outC + (size_t)(rt - ML) * DM + u.pn * 256;
    const float* gp = gate + (size_t)mr * 6144 + u.pn * 256;
    const int lo = (wr * 64 + fr) * DM + wc * 32 + 4 * fq;
    const int lc = wc * 32 + 4 * fq;
    pg8::f32x4 gv[2][2];
#pragma unroll
    for (int bj = 0; bj < 2; ++bj)
#pragma unroll
      for (int n = 0; n < 2; ++n) gv[bj][n] = *(const pg8::f32x4*)(gp + bj * 128 + n * 16 + lc);
#pragma unroll
    for (int ai = 0; ai < 2; ++ai)
#pragma unroll
      for (int m = 0; m < 4; ++m) {
        const float* bp = base + (ai * 128 + m * 16) * DM; float* op = out + (ai * 128 + m * 16) * DM;
#pragma unroll
        for (int bj = 0; bj < 2; ++bj)
#pragma unroll
          for (int n = 0; n < 2; ++n) {
            const pg8::f32x4 b = *(const pg8::f32x4*)(bp + bj * 128 + n * 16 + lo);
            *(pg8::f32x4*)(op + bj * 128 + n * 16 + lo) = b + gv[bj][n] * acc[ai][bj][m][n];
          }
        asm volatile("" ::: "memory");
      }
  }
};

DI void transpose_item(const float* W, int K, int N, bf16_t* WT, int row_off, LAS float* scr, int item, int lane) {
  const int nblk = N / 32, kb = item / nblk, nb = item % nblk, k0 = 64 * kb, n0 = 32 * nb;
#pragma unroll 8
  for (int i = 0; i < 32; ++i) { const int kk = 2 * i + (lane >> 5); scr[kk * 33 + (lane & 31)] = W[(size_t)(k0 + kk) * N + n0 + (lane & 31)]; }
  asm volatile("s_waitcnt lgkmcnt(0)" ::: "memory");
  const int c = lane & 7;
#pragma unroll
  for (int j = 0; j < 4; ++j) { const int n = (lane >> 3) + 8 * j; const LAS float* s = scr + (8 * c) * 33 + n;
    u32x4 o; o.x = pk2(s[0 * 33], s[1 * 33]); o.y = pk2(s[2 * 33], s[3 * 33]); o.z = pk2(s[4 * 33], s[5 * 33]); o.w = pk2(s[6 * 33], s[7 * 33]);
    *(u32x4*)(WT + (size_t)(row_off + n0 + n) * K + k0 + 8 * c) = o; }
  asm volatile("s_waitcnt lgkmcnt(0)" ::: "memory");
}

DI void phase_prologue(const Params& p, LAS unsigned char* lds) {
  const int tid = opaque_tid(), lane = tid & 63, wave = tid >> 6, G = gridDim.x;
  unsigned char* ws = p.ws;
  { float* COSH = (float*)(ws + WS_TAB); float* SINH = COSH + 2048 * 32; float* COSR = SINH + 2048 * 32; float* SINR = COSR + 2048 * 16;
    for (int i = blockIdx.x * NT + tid; i < 2048 * 32; i += G * NT) { const int t = i >> 5, f = i & 31; const float pos = (float)((f < 16) ? (t >> 6) : (t & 63));
      const float inv = powf(10000.f, -(float)(f & 15) / 16.f); const float a = pos * inv; COSH[i] = cosf(a); SINH[i] = sinf(a); }
    for (int i = blockIdx.x * NT + tid; i < 2048 * 16; i += G * NT) { const int t = i >> 4, f = i & 15; const float pos = (float)((f < 8) ? (t >> 6) : (t & 63));
      const float inv = powf(10000.f, -(float)(f & 7) / 8.f); const float a = pos * inv; COSR[i] = cosf(a); SINR[i] = sinf(a); }
  }
  { LAS float* s = (LAS float*)lds; LAS float* red = s + 17 * 1024; float* MOD = (float*)(ws + WS_MOD);
    for (int it = blockIdx.x; it < 192; it += G) {
      for (int i = tid; i < 17 * 1024; i += NT) { const int r = i >> 10, k = i & 1023; const float v = r < 16 ? p.c[r * 1024 + k] : p.c_ctx[k]; s[i] = siluf_(v); }
      __syncthreads();
      const int layer = it / 96, j0 = (it % 96) * 64, kq = tid >> 6, jl = tid & 63;
      float acc[17];
#pragma unroll
      for (int r = 0; r < 17; ++r) acc[r] = 0.f;
      const float* w = p.mod_w + (size_t)layer * 1024 * 6144 + j0 + jl;
#pragma unroll 4
      for (int k = kq * 128; k < kq * 128 + 128; ++k) { const float wv = w[(size_t)k * 6144];
#pragma unroll
        for (int r = 0; r < 17; ++r) acc[r] += s[r * 1024 + k] * wv; }
#pragma unroll
      for (int r = 0; r < 17; ++r) red[(kq * 17 + r) * 64 + jl] = acc[r];
      __syncthreads();
      for (int o = tid; o < 17 * 64; o += NT) { const int r = o >> 6, j = o & 63; float sum = p.mod_b[layer * 6144 + j0 + j];
#pragma unroll
        for (int q = 0; q < 8; ++q) sum += red[(q * 17 + r) * 64 + j];
        MOD[((size_t)layer * 17 + r) * 6144 + j0 + j] = sum; }
      __syncthreads();
    }
  }
  __syncthreads();
  { LAS float* scr = (LAS float*)(lds + wave * 8448);
    const int gw = blockIdx.x * 8 + wave, NGW = G * 8;
    constexpr int I1 = 16 * 37, I2 = 4 * 24, I3 = 2 * 32, I4 = 16 * 32, I5 = 16 * 56, I6 = 16 * 32, I7 = 16 * 176, I9 = 44 * 32;
    constexpr int NIT = I1 + I2 + I3 + I4 + I5 + I6 + 2 * I7 + 2 * I9;
    for (int it = gw; it < NIT; it += NGW) {
      int r = it;
      if (r < I1) { transpose_item(p.ev_w_in, 1024, EV_IN, (bf16_t*)(ws + WS_W_EVIN), 0, scr, r, lane); continue; } r -= I1;
      if (r < I2) { transpose_item(p.ev_w_q_up, 256, 768, (bf16_t*)(ws + WS_W_QUP), 0, scr, r, lane); continue; } r -= I2;
      if (r < I3) { transpose_item(p.ev_w_kv_up, 128, 1024, (bf16_t*)(ws + WS_W_KVUP), 0, scr, r, lane); continue; } r -= I3;
      if (r < I4) { transpose_item(p.ev_w_out, 1024, 1024, (bf16_t*)(ws + WS_W_EVOUT), 0, scr, r, lane); continue; } r -= I4;
      if (r < I5) { transpose_item(p.od_w_in, 1024, 1792, (bf16_t*)(ws + WS_W_ODIN), 0, scr, r, lane); continue; } r -= I5;
      if (r < I6) { transpose_item(p.od_w_out, 1024, 1024, (bf16_t*)(ws + WS_W_ODOUT), 0, scr, r, lane); continue; } r -= I6;
      if (r < I7) { transpose_item(p.ffn_up, 1024, FF2, (bf16_t*)(ws + WS_W_UP), 0, scr, r, lane); continue; } r -= I7;
      if (r < I7) { transpose_item(p.ffn_up + (size_t)1024 * FF2, 1024, FF2, (bf16_t*)(ws + WS_W_UP) + (size_t)FF2 * 1024, 0, scr, r, lane); continue; } r -= I7;
      if (r < I9) { transpose_item(p.ffn_down, FF, 1024, (bf16_t*)(ws + WS_W_DOWN), 0, scr, r, lane); continue; } r -= I9;
      transpose_item(p.ffn_down + (size_t)FF * 1024, FF, 1024, (bf16_t*)(ws + WS_W_DOWN) + (size_t)1024 * FF, 0, scr, r, lane);
    }
    u32x4* z = (u32x4*)((bf16_t*)(ws + WS_W_EVIN) + (size_t)EV_IN * 1024);
    for (int i = blockIdx.x * NT + tid; i < (EV_PITCH - EV_IN) * 1024 / 8; i += G * NT) z[i] = (u32x4){0u, 0u, 0u, 0u};
  }
}

DI void phase_norm_mod(const float* srcL, const float* srcC, const float* g, const float* modl, int shiftIdx, int scaleIdx, bf16_t* Z, int rowEnd) {
  const int tid = opaque_tid(), lane = tid & 63, gw = blockIdx.x * 8 + (tid >> 6), NGW = gridDim.x * 8;
  for (int row = gw; row < rowEnd; row += NGW) {
    const float* src = row < ML ? srcL + (size_t)row * DM : srcC + (size_t)(row - ML) * DM;
    const float* mp = modl + (size_t)modrow(row) * 6144;
    f32x4 v[4]; float ss = 0.f;
#pragma unroll
    for (int j = 0; j < 4; ++j) { v[j] = *(const f32x4*)(src + 4 * (64 * j + lane)); ss += (v[j].x * v[j].x + v[j].y * v[j].y) + (v[j].z * v[j].z + v[j].w * v[j].w); }
    const float r = rsqrtf(wave_sum(ss) * (1.f / DM) + EPS);
#pragma unroll
    for (int j = 0; j < 4; ++j) { const int k = 4 * (64 * j + lane);
      const f32x4 gg = *(const f32x4*)(g + k), sc = *(const f32x4*)(mp + scaleIdx * 1024 + k), sh = *(const f32x4*)(mp + shiftIdx * 1024 + k);
      const f32x4 z = (v[j] * r) * gg * (sc + 1.f) + sh;
      u32x2 w; w.x = pk2(z.x, z.y); w.y = pk2(z.z, z.w); *(u32x2*)(Z + (size_t)row * DM + k) = w; }
  }
}
DI void phase_final_norm(float* out, const float* g) {
  const int tid = opaque_tid(), lane = tid & 63, gw = blockIdx.x * 8 + (tid >> 6), NGW = gridDim.x * 8;
  for (int row = gw; row < ML; row += NGW) {
    float* src = out + (size_t)row * DM;
    f32x4 v[4]; float ss = 0.f;
#pragma unroll
    for (int j = 0; j < 4; ++j) { v[j] = *(const f32x4*)(src + 4 * (64 * j + lane)); ss += (v[j].x * v[j].x + v[j].y * v[j].y) + (v[j].z * v[j].z + v[j].w * v[j].w); }
    const float r = rsqrtf(wave_sum(ss) * (1.f / DM) + EPS);
#pragma unroll
    for (int j = 0; j < 4; ++j) { const int k = 4 * (64 * j + lane); const f32x4 gg = *(const f32x4*)(g + k); *(f32x4*)(src + k) = (v[j] * r) * gg; }
  }
}
DI void head_fix(bf16_t* base, int sub, const float* gain, bool norm, bool rope, const float* cs, const float* sn, float scale, bool doit) {
  const u32x2 a = *(const u32x2*)(base + 4 * sub), b = *(const u32x2*)(base + 32 + 4 * sub);
  float x1[4] = {bflo(a.x), bfhi(a.x), bflo(a.y), bfhi(a.y)}, x2[4] = {bflo(b.x), bfhi(b.x), bflo(b.y), bfhi(b.y)};
  if (norm) {
    float ss = 0.f;
#pragma unroll
    for (int j = 0; j < 4; ++j) ss += x1[j] * x1[j] + x2[j] * x2[j];
    ss += __shfl_xor(ss, 1); ss += __shfl_xor(ss, 2); ss += __shfl_xor(ss, 4);
    const float r = rsqrtf(ss * (1.f / 64.f) + EPS);
#pragma unroll
    for (int j = 0; j < 4; ++j) { x1[j] = x1[j] * r * gain[4 * sub + j]; x2[j] = x2[j] * r * gain[32 + 4 * sub + j]; }
  }
  if (rope) {
#pragma unroll
    for (int j = 0; j < 4; ++j) { const float c = cs[4 * sub + j], s = sn[4 * sub + j]; const float o1 = x1[j] * c - x2[j] * s, o2 = x1[j] * s + x2[j] * c; x1[j] = o1; x2[j] = o2; }
  }
  if (doit) {
    u32x2 wa, wb; wa.x = pk2(x1[0] * scale, x1[1] * scale); wa.y = pk2(x1[2] * scale, x1[3] * scale); wb.x = pk2(x2[0] * scale, x2[1] * scale); wb.y = pk2(x2[2] * scale, x2[3] * scale);
    *(u32x2*)(base + 4 * sub) = wa; *(u32x2*)(base + 32 + 4 * sub) = wb;
  }
}
DI void phase_post_even(const Params& p) {
  const int tid = opaque_tid(), lane = tid & 63, gw = blockIdx.x * 8 + (tid >> 6), NGW = gridDim.x * 8;
  bf16_t* H = (bf16_t*)(p.ws + WS_H);
  const float* COSH = (const float*)(p.ws + WS_TAB); const float* SINH = COSH + 2048 * 32; const float* COSR = SINH + 2048 * 32; const float* SINR = COSR + 2048 * 16;
  for (int row = gw; row < MT; row += NGW) {
    bf16_t* hr = H + (size_t)row * EV_PITCH; const bool lat = row < ML; const int t = row & (SEQ - 1);
    const int sub = lane & 7;
    head_fix(hr + (lane >> 3) * 64, sub, p.ev_qa_g, true, lat, COSH + t * 32, SINH + t * 32, 0.125f * LOG2E, true);
    head_fix(hr + 512 + ((lane >> 3) & 1) * 64, sub, p.ev_ka_g, true, lat, COSH + t * 32, SINH + t * 32, 1.f, lane < 16);
    {
      const u32x2 a = *(const u32x2*)(hr + 768 + 4 * lane); float x[4] = {bflo(a.x), bfhi(a.x), bflo(a.y), bfhi(a.y)};
      const float r = rsqrtf(wave_sum(x[0] * x[0] + x[1] * x[1] + x[2] * x[2] + x[3] * x[3]) * (1.f / 256.f) + EPS);
      const f32x4 g = *(const f32x4*)(p.ev_qlat_g + 4 * lane);
      u32x2 w; w.x = pk2(x[0] * r * g.x, x[1] * r * g.y); w.y = pk2(x[2] * r * g.z, x[3] * r * g.w); *(u32x2*)(hr + 768 + 4 * lane) = w; }
    {
      const unsigned a = *(const unsigned*)(hr + 1024 + 2 * lane); const float x0 = bflo(a), x1 = bfhi(a);
      const float r = rsqrtf(wave_sum(x0 * x0 + x1 * x1) * (1.f / 128.f) + EPS);
      *(unsigned*)(hr + 1024 + 2 * lane) = pk2(x0 * r * p.ev_kvlat_g[2 * lane], x1 * r * p.ev_kvlat_g[2 * lane + 1]); }
    if (lat && lane < 16) {
      const float x1 = bf2f(hr[1152 + lane]), x2 = bf2f(hr[1152 + 16 + lane]); const float c = COSR[t * 16 + lane], s = SINR[t * 16 + lane];
      hr[1152 + lane] = f2bf(x1 * c - x2 * s); hr[1152 + 16 + lane] = f2bf(x1 * s + x2 * c); }
  }
}
DI void phase_post_odd(const Params& p) {
  const int tid = opaque_tid(), lane = tid & 63, gw = blockIdx.x * 8 + (tid >> 6), NGW = gridDim.x * 8;
  bf16_t* H = (bf16_t*)(p.ws + WS_H);
  const float* COSH = (const float*)(p.ws + WS_TAB); const float* SINH = COSH + 2048 * 32;
  for (int row = gw; row < ML; row += NGW) {
    bf16_t* hr = H + (size_t)row * OD_PITCH; const int t = row & (SEQ - 1); const int sub = lane & 7;
    { const u32x4 a = *(const u32x4*)(hr + 512 + 8 * lane);
      float x[8] = {bflo(a.x), bfhi(a.x), bflo(a.y), bfhi(a.y), bflo(a.z), bfhi(a.z), bflo(a.w), bfhi(a.w)}; float s = 0.f;
#pragma unroll
      for (int j = 0; j < 8; ++j) { x[j] = geluf_(x[j]); s += x[j]; }
      const float mu = wave_sum(s) * (1.f / 512.f); float q = 0.f;
#pragma unroll
      for (int j = 0; j < 8; ++j) { x[j] -= mu; q += x[j] * x[j]; }
      const float r = rsqrtf(wave_sum(q) * (1.f / 512.f) + EPS);
      const f32x4 g0 = *(const f32x4*)(p.od_ln_g + 8 * lane), g1 = *(const f32x4*)(p.od_ln_g + 8 * lane + 4), b0 = *(const f32x4*)(p.od_ln_b + 8 * lane), b1 = *(const f32x4*)(p.od_ln_b + 8 * lane + 4);
      u32x4 w; w.x = pk2(x[0] * r * g0.x + b0.x, x[1] * r * g0.y + b0.y); w.y = pk2(x[2] * r * g0.z + b0.z, x[3] * r * g0.w + b0.w);
      w.z = pk2(x[4] * r * g1.x + b1.x, x[5] * r * g1.y + b1.y); w.w = pk2(x[6] * r * g1.z + b1.z, x[7] * r * g1.w + b1.w);
      *(u32x4*)(hr + 512 + 8 * lane) = w; }
    head_fix(hr + 1024 + (lane >> 3) * 64, sub, nullptr, false, true, COSH + t * 32, SINH + t * 32, 0.125f * LOG2E, true);
    head_fix(hr + 1536 + ((lane >> 3) & 1) * 64, sub, nullptr, false, true, COSH + t * 32, SINH + t * 32, 1.f, lane < 16);
  }
}
DI void phase_conv_act(const bf16_t* HUP, bf16_t* ACT, const float* cw, const float* cb, int rbeg, int rend) {
  const long total = (long)(rend - rbeg) * 352; const int tid = opaque_tid();
  for (long it = (long)blockIdx.x * NT + tid; it < total; it += (long)gridDim.x * NT) {
    const int lr = (int)(it / 352), ch = (int)(it % 352), row = rbeg + lr, j = ch * 8;
    const int pos = row < ML ? (row & (SEQ - 1)) : ((row - ML) & (CTX - 1)); const int len = row < ML ? SEQ : CTX;
    const bf16_t* h = HUP + (size_t)lr * FF2 + j;
    const u32x4 z4 = {0u, 0u, 0u, 0u};
    const u32x4 a0 = pos > 0 ? *(const u32x4*)(h - FF2) : z4, a1 = *(const u32x4*)h, a2 = pos < len - 1 ? *(const u32x4*)(h + FF2) : z4;
    const u32x4 g0 = pos > 0 ? *(const u32x4*)(h - FF2 + FF) : z4, g1 = *(const u32x4*)(h + FF), g2 = pos < len - 1 ? *(const u32x4*)(h + FF2 + FF) : z4;
    float o[8];
#pragma unroll
    for (int e = 0; e < 8; ++e) {
      const unsigned wa0 = a0[e >> 1], wa1 = a1[e >> 1], wa2 = a2[e >> 1], wg0 = g0[e >> 1], wg1 = g1[e >> 1], wg2 = g2[e >> 1];
      const float xa0 = (e & 1) ? bfhi(wa0) : bflo(wa0), xa1 = (e & 1) ? bfhi(wa1) : bflo(wa1), xa2 = (e & 1) ? bfhi(wa2) : bflo(wa2);
      const float xg0 = (e & 1) ? bfhi(wg0) : bflo(wg0), xg1 = (e & 1) ? bfhi(wg1) : bflo(wg1), xg2 = (e & 1) ? bfhi(wg2) : bflo(wg2);
      const int ja = j + e, jg = FF + j + e;
      const float A = cw[ja] * xa0 + cw[FF2 + ja] * xa1 + cw[2 * FF2 + ja] * xa2 + cb[ja];
      const float Gv = cw[jg] * xg0 + cw[FF2 + jg] * xg1 + cw[2 * FF2 + jg] * xg2 + cb[jg];
      o[e] = siluf_(Gv) * A;
    }
    u32x4 w; w.x = pk2(o[0], o[1]); w.y = pk2(o[2], o[3]); w.z = pk2(o[4], o[5]); w.w = pk2(o[6], o[7]);
    *(u32x4*)(ACT + (size_t)lr * FF + j) = w;
  }
}

struct AttnJob { const bf16_t *Q, *K1, *K2, *V; bf16_t* O; int qp, k1p, k2p, vp, op; int s0row, s0n, s1row, s1n; int win, qpos0, s1pos0; float sink2; int has_sink; const float* rope_cos; const float* rope_sin; };
DI s16x4 vtr(const LAS unsigned char* pp) { typedef short v4i16_t __attribute__((ext_vector_type(4))); return __builtin_bit_cast(s16x4, __builtin_amdgcn_ds_read_tr16_b64_v4i16((LAS v4i16_t*)pp)); }
#define MFMA32(a, b, c) __builtin_amdgcn_mfma_f32_32x32x16_bf16((a), (b), (c), 0, 0, 0)

template <int DK> DI void attn_unit(const AttnJob& J, LAS unsigned char* lds) {
  constexpr int KP = DK * 2 + 16, VP = 144, KBUF = 64 * KP, VBUF = 64 * VP, NS = DK / 16;
  const int tid = opaque_tid(), lane = tid & 63, wave = tid >> 6, r32 = lane & 31, h = lane >> 5;
  LAS unsigned char* Kl = lds; LAS unsigned char* Vl = lds + 2 * KBUF;
  const bf16_t* qrow = J.Q + (size_t)(wave * 32 + r32) * J.qp;
  bf16x8 qf[NS];
#pragma unroll
  for (int s = 0; s < NS; ++s) qf[s] = *(const bf16x8*)(qrow + 16 * s + 8 * h);
  if (DK == 96) { if (J.rope_cos) {
    const float* cs = J.rope_cos + (J.qpos0 + wave * 32 + r32) * 16 + 8 * h; const float* sn = J.rope_sin + (J.qpos0 + wave * 32 + r32) * 16 + 8 * h;
#pragma unroll
    for (int j = 0; j < 8; ++j) { const float x1 = bf2f((unsigned short)qf[NS - 2][j]), x2 = bf2f((unsigned short)qf[NS - 1][j]); const float c = cs[j], s_ = sn[j];
      qf[NS - 2][j] = (short)f2bf(x1 * c - x2 * s_); qf[NS - 1][j] = (short)f2bf(x1 * s_ + x2 * c); } } }
  const int nt0 = J.s0n >> 6, nt = nt0 + (J.s1n >> 6);
  const int srow = tid >> 3, sch = tid & 7;
  const int s2row = (tid >> 2) & 63, s2ch = tid & 3;
  u32x4 rk, rv, rk2;
  auto tile_row = [&](int t) -> int { return t < nt0 ? J.s0row + 64 * t : J.s1row + 64 * (t - nt0); };
  auto gload = [&](int t) { const int kr0 = tile_row(t);
    rk = *(const u32x4*)(J.K1 + (size_t)(kr0 + srow) * J.k1p + sch * 8);
    rv = *(const u32x4*)(J.V + (size_t)(kr0 + srow) * J.vp + sch * 8);
    if (DK == 96) { if (tid < 256) rk2 = *(const u32x4*)(J.K2 + (size_t)(kr0 + s2row) * J.k2p + s2ch * 8); } };
  auto lstore = [&](int b) {
    *(LAS u32x4*)(Kl + b * KBUF + srow * KP + sch * 16) = rk;
    *(LAS u32x4*)(Vl + b * VBUF + srow * VP + sch * 16) = rv;
    if (DK == 96) { if (tid < 256) *(LAS u32x4*)(Kl + b * KBUF + s2row * KP + 128 + s2ch * 16) = rk2; } };
  gload(0); lstore(0); __syncthreads();
  float m = -1e30f, lsum = 0.f; f32x16 O0 = {}, O1 = {};
  const int qpos = J.qpos0 + wave * 32 + r32, qmin = J.qpos0 + wave * 32;
  const int q4 = (lane & 15) >> 2, p4 = lane & 3, blk = (lane >> 4) & 1;
  for (int t = 0; t < nt; ++t) {
    if (t + 1 < nt) gload(t + 1);
    const LAS unsigned char* Kb = Kl + (t & 1) * KBUF; const LAS unsigned char* Vb = Vl + (t & 1) * VBUF;
    bool active = true; int kp0 = 0;
    if (J.win && t >= nt0) { kp0 = J.s1pos0 + 64 * (t - nt0); active = (kp0 + 63 >= qmin - 128) && (kp0 <= qmin + 31 + 128); }
    if (active) {
      f32x16 S0 = {}, S1 = {};
#pragma unroll
      for (int s = 0; s < NS; ++s) {
        const bf16x8 k0 = *(const LAS bf16x8*)(Kb + r32 * KP + (16 * s + 8 * h) * 2);
        const bf16x8 k1 = *(const LAS bf16x8*)(Kb + (32 + r32) * KP + (16 * s + 8 * h) * 2);
        S0 = MFMA32(k0, qf[s], S0); S1 = MFMA32(k1, qf[s], S1);
      }
      if (J.win && t >= nt0) {
#pragma unroll
        for (int i = 0; i < 16; ++i) { const int kpos = kp0 + crow(i, h); const int d0 = qpos - kpos, d1 = d0 - 32;
          if (d0 > 128 || d0 < -128) S0[i] = -1e30f; if (d1 > 128 || d1 < -128) S1[i] = -1e30f; }
      }
      float mx = fmaxf(S0[0], S1[0]);
#pragma unroll
      for (int i = 1; i < 16; ++i) mx = fmaxf(mx, fmaxf(S0[i], S1[i]));
      mx = fmaxf(mx, __shfl_xor(mx, 32));
      const float mnew = fmaxf(m, mx); const float alpha = __builtin_amdgcn_exp2f(m - mnew); m = mnew;
      float ps = 0.f;
#pragma unroll
      for (int i = 0; i < 16; ++i) { S0[i] = __builtin_amdgcn_exp2f(S0[i] - mnew); S1[i] = __builtin_amdgcn_exp2f(S1[i] - mnew); ps += S0[i] + S1[i]; }
      lsum = lsum * alpha + ps;
#pragma unroll
      for (int i = 0; i < 16; ++i) { O0[i] *= alpha; O1[i] *= alpha; }
#pragma unroll
      for (int kb = 0; kb < 2; ++kb)
#pragma unroll
        for (int s2 = 0; s2 < 2; ++s2) {
          u32x4 pw;
          if (kb == 0) { pw.x = pk2(S0[8 * s2 + 0], S0[8 * s2 + 1]); pw.y = pk2(S0[8 * s2 + 2], S0[8 * s2 + 3]); pw.z = pk2(S0[8 * s2 + 4], S0[8 * s2 + 5]); pw.w = pk2(S0[8 * s2 + 6], S0[8 * s2 + 7]); }
          else         { pw.x = pk2(S1[8 * s2 + 0], S1[8 * s2 + 1]); pw.y = pk2(S1[8 * s2 + 2], S1[8 * s2 + 3]); pw.z = pk2(S1[8 * s2 + 4], S1[8 * s2 + 5]); pw.w = pk2(S1[8 * s2 + 6], S1[8 * s2 + 7]); }
          const bf16x8 pf = __builtin_bit_cast(bf16x8, pw);
          const LAS unsigned char* vb = Vb + (kb * 32 + 16 * s2 + 4 * h + q4) * VP + (blk * 16 + 4 * p4) * 2;
          { const s16x4 lo = vtr(vb), hi = vtr(vb + 8 * VP); const bf16x8 vf = __builtin_shufflevector(lo, hi, 0, 1, 2, 3, 4, 5, 6, 7); O0 = MFMA32(vf, pf, O0); }
          { const s16x4 lo = vtr(vb + 64), hi = vtr(vb + 64 + 8 * VP); const bf16x8 vf = __builtin_shufflevector(lo, hi, 0, 1, 2, 3, 4, 5, 6, 7); O1 = MFMA32(vf, pf, O1); }
        }
    }
    if (t + 1 < nt) lstore((t + 1) & 1);
    __syncthreads();
  }
  lsum += __shfl_xor(lsum, 32);
  if (J.has_sink) lsum += __builtin_amdgcn_exp2f(J.sink2 - m);
  const float inv = 1.f / lsum;
  bf16_t* orow = J.O + (size_t)(wave * 32 + r32) * J.op;
#pragma unroll
  for (int g = 0; g < 4; ++g) {
    u32x2 w0, w1; w0.x = pk2(O0[4 * g] * inv, O0[4 * g + 1] * inv); w0.y = pk2(O0[4 * g + 2] * inv, O0[4 * g + 3] * inv);
    w1.x = pk2(O1[4 * g] * inv, O1[4 * g + 1] * inv); w1.y = pk2(O1[4 * g + 2] * inv, O1[4 * g + 3] * inv);
    *(u32x2*)(orow + 8 * g + 4 * h) = w0; *(u32x2*)(orow + 32 + 8 * g + 4 * h) = w1;
  }
}

DI void phase_attn_even(const Params& p, LAS unsigned char* lds) {
  const bf16_t* H = (const bf16_t*)(p.ws + WS_H); const bf16_t* QB = (const bf16_t*)(p.ws + WS_QB); const bf16_t* KVB = (const bf16_t*)(p.ws + WS_KVB); bf16_t* Y = (bf16_t*)(p.ws + WS_Y);
  for (int u = blockIdx.x; u < 2304; u += gridDim.x) {
    AttnJob J; J.win = 0; J.qpos0 = 0; J.s1pos0 = 0; J.sink2 = 0.f; J.has_sink = 0; J.rope_cos = nullptr; J.rope_sin = nullptr;
    int typeB, b, head, qrow0, s1n;
    if (u < 2048) { typeB = u >> 10; const int v = u & 1023; b = v >> 6; head = (v >> 3) & 7; qrow0 = b * SEQ + (v & 7) * 256; s1n = SEQ; J.qpos0 = (v & 7) * 256;
      J.rope_cos = (const float*)(p.ws + WS_TAB) + 2 * 2048 * 32; J.rope_sin = J.rope_cos + 2048 * 16; }
    else { const int v = u - 2048; typeB = v >> 7; b = (v & 127) >> 3; head = v & 7; qrow0 = ML + b * CTX; s1n = 0; }
    J.s0row = ML + b * CTX; J.s0n = CTX; J.s1row = b * SEQ; J.s1n = s1n;
    if (!typeB) {
      J.Q = H + (size_t)qrow0 * EV_PITCH + head * 64; J.qp = EV_PITCH;
      J.K1 = H + 512 + (head >> 2) * 64; J.k1p = EV_PITCH; J.K2 = nullptr; J.k2p = 0;
      J.V = H + 640 + (head >> 2) * 64; J.vp = EV_PITCH;
      J.O = Y + (size_t)qrow0 * DM + head * 64; J.op = DM;
      attn_unit<64>(J, lds);
    } else {
      J.Q = QB + (size_t)qrow0 * 768 + head * 96; J.qp = 768;
      J.K1 = KVB + head * 128; J.k1p = 1024; J.K2 = H + 1152; J.k2p = EV_PITCH;
      J.V = KVB + head * 128 + 64; J.vp = 1024;
      J.O = Y + (size_t)qrow0 * DM + 512 + head * 64; J.op = DM;
      attn_unit<96>(J, lds);
    }
  }
}
DI void phase_attn_odd(const Params& p, LAS unsigned char* lds) {
  const bf16_t* H = (const bf16_t*)(p.ws + WS_H); bf16_t* Y = (bf16_t*)(p.ws + WS_Y);
  for (int u = blockIdx.x; u < 1024; u += gridDim.x) {
    const int b = u >> 6, head = (u >> 3) & 7, q0 = (u & 7) * 256, qrow0 = b * SEQ + q0;
    const int lo = q0 - 128 < 0 ? 0 : q0 - 128, hi = q0 + 384 > SEQ ? SEQ : q0 + 384;
    AttnJob J; J.rope_cos = nullptr; J.rope_sin = nullptr; J.win = 1; J.qpos0 = q0; J.s1pos0 = lo; J.sink2 = p.od_sink[head] * LOG2E; J.has_sink = 1;
    J.s0row = ML + b * CTX; J.s0n = CTX; J.s1row = b * SEQ + lo; J.s1n = hi - lo;
    J.Q = H + (size_t)qrow0 * OD_PITCH + 1024 + head * 64; J.qp = OD_PITCH;
    J.K1 = H + 1536 + (head >> 2) * 64; J.k1p = OD_PITCH; J.K2 = nullptr; J.k2p = 0;
    J.V = H + 1664 + (head >> 2) * 64; J.vp = OD_PITCH;
    J.O = Y + (size_t)qrow0 * DM + 512 + head * 64; J.op = DM;
    attn_unit<64>(J, lds);
  }
}
DI void phase_sgu(const Params& p, LAS unsigned char* lds) {
  constexpr int RP = 1040;
  const bf16_t* H = (const bf16_t*)(p.ws + WS_H); bf16_t* Y = (bf16_t*)(p.ws + WS_Y);
  const int tid = opaque_tid(), lane = tid & 63, g = tid >> 6, r32 = lane & 31, h = lane >> 5;
  const int q4 = (lane & 15) >> 2, p4 = lane & 3, blk = (lane >> 4) & 1;
  for (int u = blockIdx.x; u < 256; u += gridDim.x) {
    const int row0 = (u >> 4) * SEQ + (u & 15) * 128;
    __syncthreads();
    for (int i = tid; i < 128 * 64; i += NT) { const int r = i >> 6, ch = i & 63;
      *(LAS u32x4*)(lds + r * RP + ch * 16) = *(const u32x4*)(H + (size_t)(row0 + r) * OD_PITCH + 512 + ch * 8); }
    __syncthreads();
    f32x16 acc[4][2];
#pragma unroll
    for (int a = 0; a < 4; ++a) { acc[a][0] = (f32x16){}; acc[a][1] = (f32x16){}; }
    const float* wg = p.od_sgu_w + (size_t)g * 128 * 128;
#pragma unroll 1
    for (int s = 0; s < 8; ++s) {
      const LAS unsigned char* vb = lds + (16 * s + 4 * h + q4) * RP + (g * 64 + blk * 16 + 4 * p4) * 2;
      const s16x4 l0 = vtr(vb), h0 = vtr(vb + 8 * RP), l1 = vtr(vb + 64), h1 = vtr(vb + 64 + 8 * RP);
      const bf16x8 vf0 = __builtin_shufflevector(l0, h0, 0, 1, 2, 3, 4, 5, 6, 7), vf1 = __builtin_shufflevector(l1, h1, 0, 1, 2, 3, 4, 5, 6, 7);
#pragma unroll
      for (int pb = 0; pb < 4; ++pb) {
        const float* wp = wg + (size_t)(pb * 32 + r32) * 128 + 16 * s + 4 * h;
        const f32x4 w0 = *(const f32x4*)wp, w1 = *(const f32x4*)(wp + 8);
        u32x4 pw; pw.x = pk2(w0.x, w0.y); pw.y = pk2(w0.z, w0.w); pw.z = pk2(w1.x, w1.y); pw.w = pk2(w1.z, w1.w);
        const bf16x8 wf = __builtin_bit_cast(bf16x8, pw);
        acc[pb][0] = MFMA32(vf0, wf, acc[pb][0]); acc[pb][1] = MFMA32(vf1, wf, acc[pb][1]);
      }
    }
#pragma unroll
    for (int pb = 0; pb < 4; ++pb) {
      const int pp = pb * 32 + r32; const float bs = p.od_sgu_b[g * 128 + pp];
      const bf16_t* ur = H + (size_t)(row0 + pp) * OD_PITCH + g * 64; bf16_t* yr = Y + (size_t)(row0 + pp) * DM + g * 64;
#pragma unroll
      for (int db = 0; db < 2; ++db)
#pragma unroll
        for (int g4 = 0; g4 < 4; ++g4) { const int d0 = db * 32 + 8 * g4 + 4 * h;
          const u32x2 uu = *(const u32x2*)(ur + d0);
          const float y0 = geluf_(bflo(uu.x)) * (acc[pb][db][4 * g4] + bs), y1 = geluf_(bfhi(uu.x)) * (acc[pb][db][4 * g4 + 1] + bs);
          const float y2 = geluf_(bflo(uu.y)) * (acc[pb][db][4 * g4 + 2] + bs), y3 = geluf_(bfhi(uu.y)) * (acc[pb][db][4 * g4 + 3] + bs);
          u32x2 w; w.x = pk2(y0, y1); w.y = pk2(y2, y3); *(u32x2*)(yr + d0) = w; }
    }
  }
  __syncthreads();
}

constexpr int LDS_BYTES = 147456;
#define GSYNC() do { __threadfence(); grid.sync(); } while (0)
template <class Epi> DI void run_gemm(LAS unsigned char* lds, const bf16_t* A, int lda, const bf16_t* Bt, int ldb, int M, int N, int K, const Epi& E) {
  pg8::Gemm g{A, Bt, M, N, K, lda, ldb}; pg8::StaticOrder S; S.init(M, N, (int)gridDim.x, (int)blockIdx.x);
  pg8::gemm_phase<Epi, pg8::StaticOrder, true, true>(lds, g, S, E);
}

typedef const unsigned long long __attribute__((address_space(4)))* kargp_t;
DI Params load_params(kargp_t q) { asm volatile("" : "+s"(q)); Params r; unsigned long long* d = (unsigned long long*)&r;
#pragma unroll
  for (int i = 0; i < 30; ++i) d[i] = q[i];
  return r; }
#define PH_BEGIN { const Params p = load_params(kp); unsigned char* ws = p.ws; (void)ws;
#define PH_END } GSYNC();
#define WSP(T, off) ((T*)(ws + (off)))
typedef pg8::EpiBf16<0> EB;

__global__ void __launch_bounds__(NT, 2) fwd_kernel(Params p_unused) {
  extern __shared__ __attribute__((aligned(16))) unsigned char lds_raw[];
  LAS unsigned char* lds = (LAS unsigned char*)lds_raw;
  cg::grid_group grid = cg::this_grid();
  const kargp_t kp = (kargp_t)__builtin_amdgcn_kernarg_segment_ptr();
  constexpr size_t MOD1 = WS_MOD + (size_t)17 * 6144 * 4;

  PH_BEGIN phase_prologue(p, lds); PH_END
  PH_BEGIN phase_norm_mod(p.x, p.ctx, p.norm1_g, WSP(const float, WS_MOD), 0, 1, WSP(bf16_t, WS_Z), MT); PH_END
  PH_BEGIN run_gemm(lds, WSP(const bf16_t, WS_Z), DM, WSP(const bf16_t, WS_W_EVIN), DM, MT, EV_PITCH, DM, EB{WSP(bf16_t, WS_H), EV_PITCH, nullptr, 0, 0, 1.f}); PH_END
  PH_BEGIN phase_post_even(p); PH_END
  PH_BEGIN run_gemm(lds, WSP(const bf16_t, WS_H) + 768, EV_PITCH, WSP(const bf16_t, WS_W_QUP), 256, MT, 768, 256, EB{WSP(bf16_t, WS_QB), 768, nullptr, 768, 0, 0.10206207261596577f * LOG2E}); }
  PH_BEGIN run_gemm(lds, WSP(const bf16_t, WS_H) + 1024, EV_PITCH, WSP(const bf16_t, WS_W_KVUP), 128, MT, 1024, 128, EB{WSP(bf16_t, WS_KVB), 1024, nullptr, 0, 0, 1.f}); PH_END
  PH_BEGIN phase_attn_even(p, lds); PH_END
  PH_BEGIN run_gemm(lds, WSP(const bf16_t, WS_Y), DM, WSP(const bf16_t, WS_W_EVOUT), DM, MT, DM, DM, EpiRes{p.x, p.ctx, p.out, WSP(float, WS_HC), WSP(const float, WS_MOD) + 2 * 1024, 0}); PH_END
  PH_BEGIN phase_norm_mod(p.out, WSP(const float, WS_HC), p.norm2_g, WSP(const float, WS_MOD), 3, 4, WSP(bf16_t, WS_Z), MT); PH_END
#pragma unroll
  for (int c = 0; c < 2; ++c) {
    const int rb = c * 18432, nr = 18432;
    PH_BEGIN run_gemm(lds, WSP(const bf16_t, WS_Z) + (size_t)rb * DM, DM, WSP(const bf16_t, WS_W_UP), DM, nr, FF2, DM, EB{WSP(bf16_t, WS_HUP), FF2, nullptr, 0, 0, 1.f}); PH_END
    PH_BEGIN phase_conv_act(WSP(const bf16_t, WS_HUP), WSP(bf16_t, WS_ACT), p.ffn_conv_w, p.ffn_conv_b, rb, rb + nr); PH_END
    PH_BEGIN run_gemm(lds, WSP(const bf16_t, WS_ACT), FF, WSP(const bf16_t, WS_W_DOWN), FF, nr, DM, FF, EpiRes{p.out, WSP(const float, WS_HC), p.out, WSP(float, WS_HC), WSP(const float, WS_MOD) + 5 * 1024, rb}); PH_END
  }
  PH_BEGIN phase_norm_mod(p.out, WSP(const float, WS_HC), p.norm1_g + DM, WSP(const float, MOD1), 0, 1, WSP(bf16_t, WS_Z), MT); PH_END
  PH_BEGIN run_gemm(lds, WSP(const bf16_t, WS_Z), DM, WSP(const bf16_t, WS_W_ODIN), DM, ML, OD_PITCH, DM, EB{WSP(bf16_t, WS_H), OD_PITCH, nullptr, 0, 0, 1.f}); }
  PH_BEGIN run_gemm(lds, WSP(const bf16_t, WS_Z) + (size_t)ML * DM, DM, WSP(const bf16_t, WS_W_ODIN) + (size_t)1536 * DM, DM, MC, 256, DM, EB{WSP(bf16_t, WS_H) + (size_t)ML * OD_PITCH + 1536, OD_PITCH, nullptr, 0, 0, 1.f}); PH_END
  PH_BEGIN phase_post_odd(p); PH_END
  PH_BEGIN phase_sgu(p, lds); }
  PH_BEGIN phase_attn_odd(p, lds); PH_END
  PH_BEGIN run_gemm(lds, WSP(const bf16_t, WS_Y), DM, WSP(const bf16_t, WS_W_ODOUT), DM, ML, DM, DM, EpiRes{p.out, WSP(const float, WS_HC), p.out, WSP(float, WS_HC), WSP(const float, MOD1) + 2 * 1024, 0}); PH_END
  PH_BEGIN phase_norm_mod(p.out, WSP(const float, WS_HC), p.norm2_g + DM, WSP(const float, MOD1), 3, 4, WSP(bf16_t, WS_Z), ML); PH_END
#pragma unroll
  for (int c = 0; c < 2; ++c) {
    const int rb = c * 16384, nr = 16384;
    PH_BEGIN run_gemm(lds, WSP(const bf16_t, WS_Z) + (size_t)rb * DM, DM, WSP(const bf16_t, WS_W_UP) + (size_t)FF2 * DM, DM, nr, FF2, DM, EB{WSP(bf16_t, WS_HUP), FF2, nullptr, 0, 0, 1.f}); PH_END
    PH_BEGIN phase_conv_act(WSP(const bf16_t, WS_HUP), WSP(bf16_t, WS_ACT), p.ffn_conv_w + 3 * FF2, p.ffn_conv_b + FF2, rb, rb + nr); PH_END
    PH_BEGIN run_gemm(lds, WSP(const bf16_t, WS_ACT), FF, WSP(const bf16_t, WS_W_DOWN) + (size_t)DM * FF, FF, nr, DM, FF, EpiRes{p.out, WSP(const float, WS_HC), p.out, WSP(float, WS_HC), WSP(const float, MOD1) + 5 * 1024, rb}); PH_END
  }
  { const Params p = load_params(kp); phase_final_norm(p.out, p.final_g); }
}

extern "C" void kernel_launch(void* const* d_in, const int* in_sizes, int n_in, void* d_out, int out_size, void* d_ws, size_t ws_size, hipStream_t stream) {
  static int grid = 0;
  if (grid == 0) {
    int dev = 0, cus = 0, per_cu = 0;
    hipGetDevice(&dev); hipDeviceGetAttribute(&cus, hipDeviceAttributeMultiprocessorCount, dev);
    hipFuncSetAttribute((const void*)fwd_kernel, hipFuncAttributeMaxDynamicSharedMemorySize, LDS_BYTES);
    if (hipOccupancyMaxActiveBlocksPerMultiprocessor(&per_cu, (const void*)fwd_kernel, NT, LDS_BYTES) != hipSuccess || per_cu < 1) per_cu = 1;
    (void)hipGetLastError();
    if (cus <= 0) cus = 256;
    grid = cus;
  }
  Params p{};
  const float** f = (const float**)&p;
  for (int i = 0; i < 28; ++i) f[i] = (const float*)d_in[i];
  p.out = (float*)d_out; p.ws = (unsigned char*)d_ws;
  void* args[] = {&p};
  hipError_t e = hipLaunchCooperativeKernel((const void*)fwd_kernel, dim3(grid), dim3(NT), args, LDS_BYTES, stream);
  if (e != hipSuccess) fprintf(stderr, "cooperative launch failed: %s (grid %d)\n", hipGetErrorString(e), grid);
}
```

```cpp
#include <hip/hip_runtime.h>
#include <hip/hip_cooperative_groups.h>
#include <cstdio>
#include <cstdint>
namespace cg = cooperative_groups;
namespace pg8 {
#define PG8_LAS __attribute__((address_space(3)))
typedef unsigned short bf16_t;
typedef short bf16x8 __attribute__((ext_vector_type(8)));
typedef float f32x4 __attribute__((ext_vector_type(4)));
typedef unsigned u32x4 __attribute__((ext_vector_type(4)));
constexpr int BM = 256, BK = 64, HALF = 128, HTB = HALF * BK * 2  , STAGE_BYTES = 8 * HTB, NXCD = 8, WGM = 8;

__host__ __device__ __forceinline__ int lds_byte(int r, int c) { const int st = (r >> 4) * 2 + (c >> 5), rr = r & 15, cc = c & 31, ob = rr * 64 + cc * 2; return st * 1024 + (ob ^ (((ob >> 9) & 1) << 5)); }
__host__ __device__ __forceinline__ void stage_rc(int b, int& R, int& C) { const int st = b / 1024, sb = b % 1024, swz = sb ^ (((sb >> 9) & 1) << 5); R = (st >> 1) * 16 + swz / 64; C = (st & 1) * 32 + (swz % 64) / 2; }
__host__ __device__ __forceinline__ int perm32(int rho) { const int n = rho >> 4, i = rho & 15; return 8 * (i >> 2) + 4 * n + (i & 3); }

struct Unit { int pm, pn; };
struct Gemm { const bf16_t* A; const bf16_t* Bt; int M, N, K, lda, ldb; };

struct StaticOrder {
    int nM, nN, nwg, G, c;
    __host__ __device__ void init(int M, int N, int G_, int c_) { nM = M / BM; nN = N / BM; nwg = nM * nN; G = G_; c = c_; }
    __host__ __device__ bool next(int i, Unit& u) const {
        const long L = (long)i * G + c; if (L >= nwg) return false;
        int wgid = (int)L; { const int q = nwg / NXCD, r = nwg % NXCD, xcd = wgid % NXCD, off = wgid / NXCD; wgid = (xcd < r ? xcd * (q + 1) : r * (q + 1) + (xcd - r) * q) + off; }
        const int nig = WGM * nN, gid = wgid / nig, fm = gid * WGM, gsz = (nM - fm) < WGM ? (nM - fm) : WGM;
        u.pm = fm + ((wgid % nig) % gsz); u.pn = (wgid % nig) / gsz; return true;
    }
    __device__ __forceinline__ void a_ready(const Unit&) const {}
    __device__ __forceinline__ void done(const Unit&) const {}
};

__device__ __forceinline__ unsigned cvt_pk_bf16(float lo, float hi) { unsigned r; asm volatile("v_cvt_pk_bf16_f32 %0, %1, %2" : "=v"(r) : "v"(lo), "v"(hi)); return r; }
typedef float f32x2 __attribute__((ext_vector_type(2)));
__device__ __forceinline__ f32x2 gelu_pk(f32x2 v) {
    const f32x2 av = __builtin_elementwise_abs(v), d = av * 0.2316418882f + 1.0f;
    f32x2 t; t.x = __builtin_amdgcn_rcpf(d.x); t.y = __builtin_amdgcn_rcpf(d.y);
    f32x2 q = t * 0.5307027145f + (-0.7265760135f); q = q * t + 0.7107068705f; q = q * t + (-0.142248368f); q = q * t + 0.127414796f; q = q * t;
    const f32x2 s = (v * v) * (-0.72134752044f);
    f32x2 e; e.x = __builtin_amdgcn_exp2f(s.x); e.y = __builtin_amdgcn_exp2f(s.y);
    const f32x2 m = v * (q * e), r = v - m;
    f32x2 o; o.x = v.x < 0.f ? m.x : r.x; o.y = v.y < 0.f ? m.y : r.y; return o;
}

template <int ACT  > struct EpiBf16 {
    static constexpr bool PERM = true, AFTER_DRAIN = false; static_assert(ACT == 0 || ACT == 1, "EpiBf16: ACT is 0 (none) or 1 (gelu_pk)");
    bf16_t* O; int ldc; const float* bias; int split_cols; size_t split_stride; float scale0;
    __device__ __forceinline__ void operator()(const f32x4 (&acc)[2][2][4][2], const Unit& u, int wr, int wc, int fr, int fq) const {
        const int row0 = u.pm * BM + wr * 64 + fr; int colt = u.pn * BM; bf16_t* base = O;
        float sc = 1.f; if (split_cols) { const int t = colt / split_cols; base += (size_t)t * split_stride; colt -= t * split_cols; if (t == 0) sc = scale0; }
        const int col0 = colt + wc * 32 + 8 * fq, bcol0 = u.pn * BM + wc * 32 + 8 * fq;
        f32x4 bv[2][2];
#pragma unroll
        for (int bj = 0; bj < 2; ++bj)
#pragma unroll
            for (int n = 0; n < 2; ++n) bv[bj][n] = bias ? *(const f32x4*)(bias + bcol0 + bj * HALF + 4 * n) : (f32x4){0.f, 0.f, 0.f, 0.f};
#pragma unroll
        for (int ai = 0; ai < 2; ++ai)
#pragma unroll
            for (int m = 0; m < 4; ++m) { bf16_t* rowp = base + (size_t)(row0 + ai * HALF + m * 16) * ldc + col0;
#pragma unroll
                for (int bj = 0; bj < 2; ++bj) { f32x4 v0 = acc[ai][bj][m][0] + bv[bj][0], v1 = acc[ai][bj][m][1] + bv[bj][1];
                    if (ACT == 1) { f32x2 a = gelu_pk((f32x2){v0[0], v0[1]}), b = gelu_pk((f32x2){v0[2], v0[3]}), c = gelu_pk((f32x2){v1[0], v1[1]}), d = gelu_pk((f32x2){v1[2], v1[3]});
                        v0 = (f32x4){a.x, a.y, b.x, b.y}; v1 = (f32x4){c.x, c.y, d.x, d.y}; }
                    v0 = v0 * sc; v1 = v1 * sc; u32x4 w; w.x = cvt_pk_bf16(v0[0], v0[1]); w.y = cvt_pk_bf16(v0[2], v0[3]); w.z = cvt_pk_bf16(v1[0], v1[1]); w.w = cvt_pk_bf16(v1[2], v1[3]);
                    *(u32x4*)(rowp + bj * HALF) = w; } }
    }
};
template <class Epi, class Sched, bool ALIGN_EPI = false, bool SP2 = false>
__device__ __forceinline__ void gemm_phase(PG8_LAS unsigned char* lds, const Gemm g, const Sched& S, const Epi& E) {
    int tid_ = threadIdx.x; asm volatile("" : "+v"(tid_));
    const int tid = tid_, wid = __builtin_amdgcn_readfirstlane(tid >> 6), lane = tid & 63, wr = wid >> 2, wc = wid & 3, fr = lane & 15, fq = lane >> 4;
    const int K = g.K, nt = K / BK;
    unsigned voffA[2], voffB[2];
#pragma unroll
    for (int i = 0; i < 2; ++i) { int R, C; stage_rc(tid * 16 + i * 8192, R, C); const int Rb = Epi::PERM ? ((R & ~31) + perm32(R & 31)) : R;
        voffA[i] = (unsigned)(R * g.lda + C) * 2u; voffB[i] = (unsigned)(Rb * g.ldb + C) * 2u; }
    const size_t kstep = (size_t)(BK * 2);
    const size_t hstepA = (size_t)HALF * g.lda * 2, hstepB = (size_t)HALF * g.ldb * 2;
    const size_t tstepA = 2 * hstepA, tstepB = 2 * hstepB;
    const unsigned ldsw = (unsigned)wid * 1024u;
    const int aoff = lds_byte(wr * 64 + fr, fq * 8), boff = lds_byte(wc * 32 + fr, fq * 8);
#define PG8_SA(b, h) (((b) * 2 + (h)) * HTB)
#define PG8_SB(b, h) ((4 + (b) * 2 + (h)) * HTB)
#define PG8_STAGE(bufoff, gbase, voff) do { _Pragma("unroll") for (int _i = 0; _i < 2; ++_i) \
        __builtin_amdgcn_global_load_lds((const unsigned*)((const char*)(gbase) + (voff)[_i]), (PG8_LAS unsigned*)(lds + (bufoff) + ldsw + _i * 8192), 16, 0, 0); } while (0)
#define PG8_LDA(dst, b, h) do { _Pragma("unroll") for (int m = 0; m < 4; ++m) _Pragma("unroll") for (int k = 0; k < 2; ++k) dst[m][k] = *(const PG8_LAS bf16x8*)(lds + PG8_SA(b, h) + aoff + m * 2048 + k * 1024); } while (0)
#define PG8_LDB(dst, b, h) do { _Pragma("unroll") for (int n = 0; n < 2; ++n) _Pragma("unroll") for (int k = 0; k < 2; ++k) dst[n][k] = *(const PG8_LAS bf16x8*)(lds + PG8_SB(b, h) + boff + n * 2048 + k * 1024); } while (0)
#define PG8_MMA(ai, bj, At, Bt) do { __builtin_amdgcn_s_setprio(1); _Pragma("unroll") for (int m = 0; m < 4; ++m) _Pragma("unroll") for (int n = 0; n < 2; ++n) _Pragma("unroll") for (int k = 0; k < 2; ++k) \
        acc[ai][bj][m][n] = __builtin_amdgcn_mfma_f32_16x16x32_bf16(Bt[n][k], At[m][k], acc[ai][bj][m][n], 0, 0, 0); __builtin_amdgcn_s_setprio(0); } while (0)
#define PG8_WAIT_V(n) asm volatile("s_waitcnt vmcnt(" #n ")" ::: "memory")
#define PG8_WAIT_L(n) asm volatile("s_waitcnt lgkmcnt(" #n ")" ::: "memory")
#define PG8_BAR __builtin_amdgcn_s_barrier()
#define PG8_SCHED __builtin_amdgcn_sched_barrier(0)
    Unit cur, nxt; int ui = 0;
    if (!S.next(0, cur)) return;
    f32x4 acc[2][2][4][2];
#pragma unroll
    for (int a = 0; a < 2; ++a)
#pragma unroll
        for (int b = 0; b < 2; ++b)
#pragma unroll
            for (int m = 0; m < 4; ++m)
#pragma unroll
                for (int n = 0; n < 2; ++n) acc[a][b][m][n] = (f32x4){0.f, 0.f, 0.f, 0.f};
    bf16x8 At[4][2], B0[2][2], B1[2][2];
    const char* cA = (const char*)g.A + (size_t)cur.pm * tstepA; const char* cB = (const char*)g.Bt + (size_t)cur.pn * tstepB;
    S.a_ready(cur);
    if constexpr (SP2) {
        PG8_STAGE(PG8_SB(0, 0), cB, voffB); PG8_STAGE(PG8_SB(0, 1), cB + hstepB, voffB); PG8_STAGE(PG8_SA(0, 0), cA, voffA); PG8_STAGE(PG8_SA(0, 1), cA + hstepA, voffA);
        if (wr == 1) PG8_BAR;
        PG8_WAIT_V(2); PG8_BAR;
        PG8_STAGE(PG8_SB(1, 0), cB + kstep, voffB); PG8_STAGE(PG8_SA(1, 0), cA + kstep, voffA); PG8_STAGE(PG8_SB(1, 1), cB + hstepB + kstep, voffB);
        PG8_WAIT_V(6); PG8_BAR;
    } else {
        PG8_STAGE(PG8_SB(0, 0), cB, voffB); PG8_STAGE(PG8_SA(0, 0), cA, voffA); PG8_STAGE(PG8_SB(0, 1), cB + hstepB, voffB); PG8_STAGE(PG8_SA(0, 1), cA + hstepA, voffA);
        if (wr == 1) PG8_BAR;
        PG8_WAIT_V(4); PG8_BAR;
        PG8_STAGE(PG8_SB(1, 0), cB + kstep, voffB); PG8_STAGE(PG8_SA(1, 0), cA + kstep, voffA); PG8_STAGE(PG8_SB(1, 1), cB + hstepB + kstep, voffB);
        PG8_WAIT_V(6); PG8_BAR;
    }
    for (;;) {
        const bool has_next = S.next(ui + 1, nxt);
        const char* nA = has_next ? (const char*)g.A + (size_t)nxt.pm * tstepA : cA; const char* nB = has_next ? (const char*)g.Bt + (size_t)nxt.pn * tstepB : cB;
        for (int t = 0; t < nt; t += 2) {
            const bool last = (t == nt - 2);
            const char* a1 = cA + (size_t)(t + 1) * kstep;
            const char* a2 = last ? nA : cA + (size_t)(t + 2) * kstep; const char* b2 = last ? nB : cB + (size_t)(t + 2) * kstep;
            const char* a3 = a2 + kstep; const char* b3 = b2 + kstep;
            if (last && has_next) S.a_ready(nxt);
            if constexpr (SP2) {
            PG8_LDB(B0, 0, 0); PG8_LDB(B1, 0, 1); PG8_SCHED; PG8_LDA(At, 0, 0); PG8_STAGE(PG8_SA(1, 1), a1 + hstepA, voffA);
            PG8_WAIT_V(8); PG8_WAIT_L(0); PG8_BAR; PG8_MMA(0, 0, At, B0); PG8_MMA(0, 1, At, B1); PG8_BAR; PG8_SCHED;
            PG8_LDA(At, 0, 1); PG8_STAGE(PG8_SB(0, 0), b2, voffB); PG8_STAGE(PG8_SB(0, 1), b2 + hstepB, voffB); PG8_STAGE(PG8_SA(0, 0), a2, voffA);
            PG8_WAIT_V(8); PG8_WAIT_L(0); PG8_BAR; PG8_MMA(1, 0, At, B0); PG8_MMA(1, 1, At, B1); PG8_BAR; PG8_SCHED;
            PG8_LDB(B0, 1, 0); PG8_LDB(B1, 1, 1); PG8_SCHED; PG8_LDA(At, 1, 0); PG8_STAGE(PG8_SA(0, 1), a2 + hstepA, voffA);
            PG8_WAIT_V(8); PG8_WAIT_L(0); PG8_BAR; PG8_MMA(0, 0, At, B0); PG8_MMA(0, 1, At, B1); PG8_BAR; PG8_SCHED;
            PG8_LDA(At, 1, 1); PG8_STAGE(PG8_SB(1, 0), b3, voffB); PG8_STAGE(PG8_SB(1, 1), b3 + hstepB, voffB); PG8_STAGE(PG8_SA(1, 0), a3, voffA);
            PG8_WAIT_V(8); PG8_WAIT_L(0); PG8_BAR; PG8_MMA(1, 0, At, B0); PG8_MMA(1, 1, At, B1); PG8_BAR; PG8_SCHED;
            } else {
            PG8_LDB(B0, 0, 0); PG8_SCHED; PG8_LDA(At, 0, 0); PG8_STAGE(PG8_SA(1, 1), a1 + hstepA, voffA);
            PG8_WAIT_L(8); PG8_BAR; PG8_WAIT_L(0); PG8_MMA(0, 0, At, B0); PG8_BAR; PG8_SCHED;
            PG8_LDB(B1, 0, 1); PG8_STAGE(PG8_SB(0, 0), b2, voffB);
            PG8_BAR; PG8_WAIT_L(0); PG8_MMA(0, 1, At, B1); PG8_BAR;
            PG8_LDA(At, 0, 1); PG8_STAGE(PG8_SA(0, 0), a2, voffA);
            PG8_BAR; PG8_WAIT_L(0); PG8_MMA(1, 0, At, B0); PG8_BAR; PG8_SCHED;
            PG8_STAGE(PG8_SB(0, 1), b2 + hstepB, voffB);
            PG8_WAIT_V(6); PG8_BAR; PG8_MMA(1, 1, At, B1); PG8_BAR;
            PG8_LDB(B0, 1, 0); PG8_SCHED; PG8_LDA(At, 1, 0); PG8_STAGE(PG8_SA(0, 1), a2 + hstepA, voffA);
            PG8_WAIT_L(8); PG8_BAR; PG8_WAIT_L(0); PG8_MMA(0, 0, At, B0); PG8_BAR; PG8_SCHED;
            PG8_LDB(B1, 1, 1); PG8_STAGE(PG8_SB(1, 0), b3, voffB);
            PG8_BAR; PG8_WAIT_L(0); PG8_MMA(0, 1, At, B1); PG8_BAR;
            PG8_LDA(At, 1, 1); PG8_STAGE(PG8_SA(1, 0), a3, voffA);
            PG8_BAR; PG8_WAIT_L(0); PG8_MMA(1, 0, At, B0); PG8_BAR; PG8_SCHED;
            PG8_STAGE(PG8_SB(1, 1), b3 + hstepB, voffB);
            PG8_WAIT_V(6); PG8_BAR; PG8_MMA(1, 1, At, B1); PG8_BAR;
            }
        }
        if constexpr (ALIGN_EPI) { if (wr == 0) PG8_BAR; }
        if constexpr (!Epi::AFTER_DRAIN) { E(acc, cur, wr, wc, fr, fq); S.done(cur); }
        if (!has_next) break;
#pragma unroll
        for (int a = 0; a < 2; ++a)
#pragma unroll
            for (int b = 0; b < 2; ++b)
#pragma unroll
                for (int m = 0; m < 4; ++m)
#pragma unroll
                    for (int n = 0; n < 2; ++n) acc[a][b][m][n] = (f32x4){0.f, 0.f, 0.f, 0.f};
        cur = nxt; cA = nA; cB = nB; ++ui;
        if constexpr (ALIGN_EPI) { if (wr == 1) PG8_BAR; }
    }
    PG8_WAIT_V(0);
    if constexpr (!ALIGN_EPI) { if (wr == 0) PG8_BAR; }
    PG8_BAR;
    if constexpr (Epi::AFTER_DRAIN) { E.fused(acc, cur, wr, wc, fr, fq, lds, wid, lane); S.done(cur); }
#undef PG8_SA
#undef PG8_SB
#undef PG8_STAGE
#undef PG8_LDA
#undef PG8_LDB
#undef PG8_MMA
#undef PG8_WAIT_V
#undef PG8_WAIT_L
#undef PG8_BAR
#undef PG8_SCHED
}
}

#define LAS __attribute__((address_space(3)))
#define DI __device__ __forceinline__
typedef unsigned short bf16_t;
typedef short bf16x8 __attribute__((ext_vector_type(8)));
typedef short s16x4 __attribute__((ext_vector_type(4)));
typedef float f32x4 __attribute__((ext_vector_type(4)));
typedef float f32x16 __attribute__((ext_vector_type(16)));
typedef unsigned u32x4 __attribute__((ext_vector_type(4)));
typedef unsigned u32x2 __attribute__((ext_vector_type(2)));
typedef float f32x2_t __attribute__((ext_vector_type(2)));
typedef __bf16 bf16x2_t __attribute__((ext_vector_type(2)));

constexpr int NB = 16, SEQ = 2048, DM = 1024, CTX = 256;
constexpr int ML = NB * SEQ;
constexpr int MC = NB * CTX;
constexpr int MT = ML + MC;
constexpr int FF = 2816, FF2 = 5632;
constexpr int EV_IN = 1184, EV_PITCH = 1280, OD_PITCH = 1792;
constexpr float EPS = 1e-6f;
constexpr float LOG2E = 1.4426950408889634f;
constexpr int NT = 512;

constexpr size_t MiB = 1u << 20;
constexpr size_t WS_MOD = 0;
constexpr size_t WS_TAB = 1 * MiB;
constexpr size_t WS_W_EVIN = 2 * MiB;
constexpr size_t WS_W_QUP = 5 * MiB;
constexpr size_t WS_W_KVUP = 6 * MiB;
constexpr size_t WS_W_EVOUT = 7 * MiB;
constexpr size_t WS_W_ODIN = 9 * MiB;
constexpr size_t WS_W_ODOUT = 13 * MiB;
constexpr size_t WS_W_UP = 15 * MiB;
constexpr size_t WS_W_DOWN = 37 * MiB;
constexpr size_t WS_HC = 48 * MiB;
constexpr size_t WS_Z = 64 * MiB;
constexpr size_t WS_BIG = 136 * MiB;
constexpr size_t WS_H = WS_BIG;
constexpr size_t WS_QB = WS_BIG + 126 * MiB;
constexpr size_t WS_KVB = WS_BIG + 180 * MiB;
constexpr size_t WS_Y = WS_BIG + 252 * MiB;
constexpr size_t WS_ACT = WS_BIG;
constexpr size_t WS_HALO = WS_BIG + 200 * MiB;

struct Params {
  const float *x, *c, *ctx, *c_ctx, *mod_w, *mod_b, *norm1_g, *norm2_g;
  const float *ev_w_in, *ev_qa_g, *ev_ka_g, *ev_qlat_g, *ev_w_q_up, *ev_kvlat_g, *ev_w_kv_up, *ev_w_out;
  const float *od_w_in, *od_ln_g, *od_ln_b, *od_sgu_w, *od_sgu_b, *od_sink, *od_w_out;
  const float *ffn_up, *ffn_conv_w, *ffn_conv_b, *ffn_down, *final_g;
  float* out; unsigned char* ws;
};

DI float bf2f(unsigned short b) { return __uint_as_float(((unsigned)b) << 16); }
DI float bflo(unsigned w) { return __uint_as_float(w << 16); }
DI float bfhi(unsigned w) { return __uint_as_float(w & 0xffff0000u); }
DI unsigned pk2(float lo, float hi) { f32x2_t v = {lo, hi}; bf16x2_t b = __builtin_convertvector(v, bf16x2_t); return __builtin_bit_cast(unsigned, b); }
DI unsigned short f2bf(float f) { return (unsigned short)(pk2(f, 0.f) & 0xffffu); }
DI float wave_sum(float v) {
#pragma unroll
  for (int o = 1; o < 64; o <<= 1) v += __shfl_xor(v, o);
  return v;
}
DI float sigmoidf_(float x) { return 1.f / (1.f + __expf(-x)); }
DI float siluf_(float x) { return x * sigmoidf_(x); }
DI float geluf_(float x) { const float u = 1.5957691216057308f * (x + 0.044715f * x * x * x); return x * sigmoidf_(u); }
DI int crow(int r, int hi) { return (r & 3) + 8 * (r >> 2) + 4 * hi; }
DI int modrow(int row) { return row < ML ? (row >> 11) : 16; }
DI int opaque_tid() { int t = threadIdx.x; asm volatile("" : "+v"(t)); return t; }

template <bool BF = false> struct EpiResT {
  static constexpr bool PERM = false, AFTER_DRAIN = false;
  const float* baseL; const float* baseC; float* outL; float* outC; const float* gate;    int row0; bf16_t* outB;
  DI void operator()(const pg8::f32x4 (&acc)[2][2][4][2], const pg8::Unit& u, int wr, int wc, int fr, int fq) const {
    const int rt = row0 + u.pm * 256; const bool lat = rt < ML; const int mr = lat ? (rt >> 11) : 16;
    const float* base = lat ? baseL + (size_t)rt * DM + u.pn * 256 : baseC + (size_t)(rt - ML) * DM + u.pn * 256;
    float* out = lat ? outL + (size_t)rt * DM + u.pn * 256 : outC + (size_t)(rt - ML) * DM + u.pn * 256;
    const float* gp = gate + (size_t)mr * 6144 + u.pn * 256;
    const int lo = (wr * 64 + fr) * DM + wc * 32 + 4 * fq;
    const int lc = wc * 32 + 4 * fq;
    pg8::f32x4 gv[2][2];
#pragma unroll
    for (int bj = 0; bj < 2; ++bj)
#pragma unroll
      for (int n = 0; n < 2; ++n) gv[bj][n] = *(const pg8::f32x4*)(gp + bj * 128 + n * 16 + lc);
    pg8::f32x4 cur[2][2], nxt[2][2];
#pragma unroll
    for (int bj = 0; bj < 2; ++bj)
#pragma unroll
      for (int n = 0; n < 2; ++n) cur[bj][n] = *(const pg8::f32x4*)(base + bj * 128 + n * 16 + lo);
#pragma unroll
    for (int g = 0; g < 8; ++g) {
      const int ai = g >> 2, mm = g & 3;
      if (g < 7) { const float* bp = base + (((g + 1) >> 2) * 128 + ((g + 1) & 3) * 16) * DM;
#pragma unroll
        for (int bj = 0; bj < 2; ++bj)
#pragma unroll
          for (int n = 0; n < 2; ++n) nxt[bj][n] = *(const pg8::f32x4*)(bp + bj * 128 + n * 16 + lo); }
      float* op = out + (ai * 128 + mm * 16) * DM;
#pragma unroll
      for (int bj = 0; bj < 2; ++bj)
#pragma unroll
        for (int n = 0; n < 2; ++n) { const pg8::f32x4 val = cur[bj][n] + gv[bj][n] * acc[ai][bj][mm][n];
          if (BF) { u32x2 w; w.x = pk2(val[0], val[1]); w.y = pk2(val[2], val[3]); *(u32x2*)(outB + (size_t)rt * DM + u.pn * 256 + (ai * 128 + mm * 16) * DM + bj * 128 + n * 16 + lo) = w; }
          else *(pg8::f32x4*)(op + bj * 128 + n * 16 + lo) = val; }
      asm volatile("" ::: "memory");
#pragma unroll
      for (int bj = 0; bj < 2; ++bj)
#pragma unroll
        for (int n = 0; n < 2; ++n) cur[bj][n] = nxt[bj][n];
    }
  }
};
typedef EpiResT<false> EpiRes;

DI float dpp_ror1(float v) { return __builtin_bit_cast(float, __builtin_amdgcn_update_dpp(0, __builtin_bit_cast(int, v), 0x121, 0xf, 0xf, true)); }
DI float dpp_rol1(float v) { return __builtin_bit_cast(float, __builtin_amdgcn_update_dpp(0, __builtin_bit_cast(int, v), 0x12F, 0xf, 0xf, true)); }
struct EpiConv {
  static constexpr bool PERM = true, AFTER_DRAIN = false;
  bf16_t* ACT; float* HALO; const float* cw; const float* cb; LAS float* edge;
  DI void operator()(const pg8::f32x4 (&acc)[2][2][4][2], const pg8::Unit& u, int wr, int wc, int fr, int fq) const {
    const int cl = wc * 32 + 8 * fq;
#pragma unroll
    for (int ai = 0; ai < 2; ++ai) {
      const int sl = 2 * ai + wr;
      if (fr == 0) {
#pragma unroll
        for (int bj = 0; bj < 2; ++bj)
#pragma unroll
          for (int n = 0; n < 2; ++n) *(LAS pg8::f32x4*)(edge + ((sl * 2 + 0) * 2 + bj) * 128 + cl + 4 * n) = acc[ai][bj][0][n];
      }
      if (fr == 15) {
#pragma unroll
        for (int bj = 0; bj < 2; ++bj)
#pragma unroll
          for (int n = 0; n < 2; ++n) *(LAS pg8::f32x4*)(edge + ((sl * 2 + 1) * 2 + bj) * 128 + cl + 4 * n) = acc[ai][bj][3][n];
      }
    }
    if (wr == 0 && fr < 2) {
#pragma unroll
      for (int bj = 0; bj < 2; ++bj)
#pragma unroll
        for (int n = 0; n < 2; ++n) *(pg8::f32x4*)(HALO + (size_t)(u.pm * 4 + fr) * FF2 + bj * FF + u.pn * 128 + cl + 4 * n) = acc[0][bj][0][n];
    }
    if (wr == 1 && fr >= 14) {
#pragma unroll
      for (int bj = 0; bj < 2; ++bj)
#pragma unroll
        for (int n = 0; n < 2; ++n) *(pg8::f32x4*)(HALO + (size_t)(u.pm * 4 + fr - 12) * FF2 + bj * FF + u.pn * 128 + cl + 4 * n) = acc[1][bj][3][n];
    }
    asm volatile("s_waitcnt lgkmcnt(0)" ::: "memory"); __builtin_amdgcn_s_barrier(); asm volatile("" ::: "memory");
    const pg8::f32x4 zero4 = {0.f, 0.f, 0.f, 0.f};
#pragma unroll
    for (int n = 0; n < 2; ++n) {
      const int ca = u.pn * 128 + cl + 4 * n;
      const pg8::f32x4 wa0 = *(const pg8::f32x4*)(cw + ca), wa1 = *(const pg8::f32x4*)(cw + FF2 + ca), wa2 = *(const pg8::f32x4*)(cw + 2 * FF2 + ca), ba = *(const pg8::f32x4*)(cb + ca);
      const pg8::f32x4 wg0 = *(const pg8::f32x4*)(cw + FF + ca), wg1 = *(const pg8::f32x4*)(cw + FF2 + FF + ca), wg2 = *(const pg8::f32x4*)(cw + 2 * FF2 + FF + ca), bg = *(const pg8::f32x4*)(cb + FF + ca);
#pragma unroll
      for (int ai = 0; ai < 2; ++ai) {
        const int sl = 2 * ai + wr;
        const pg8::f32x4 ua = sl > 0 ? *(const LAS pg8::f32x4*)(edge + (((sl - 1) * 2 + 1) * 2 + 0) * 128 + cl + 4 * n) : zero4;
        const pg8::f32x4 ug = sl > 0 ? *(const LAS pg8::f32x4*)(edge + (((sl - 1) * 2 + 1) * 2 + 1) * 128 + cl + 4 * n) : zero4;
        const pg8::f32x4 da = sl < 3 ? *(const LAS pg8::f32x4*)(edge + (((sl + 1) * 2 + 0) * 2 + 0) * 128 + cl + 4 * n) : zero4;
        const pg8::f32x4 dg = sl < 3 ? *(const LAS pg8::f32x4*)(edge + (((sl + 1) * 2 + 0) * 2 + 1) * 128 + cl + 4 * n) : zero4;
#pragma unroll
        for (int mm = 0; mm < 4; ++mm) {
          float o[4];
#pragma unroll
          for (int e = 0; e < 4; ++e) {
            const float ca_ = acc[ai][0][mm][n][e], cg_ = acc[ai][1][mm][n][e];
            const float pa = mm > 0 ? dpp_ror1(acc[ai][0][mm > 0 ? mm - 1 : 0][n][e]) : ua[e], pg = mm > 0 ? dpp_ror1(acc[ai][1][mm > 0 ? mm - 1 : 0][n][e]) : ug[e];
            const float na = mm < 3 ? dpp_rol1(acc[ai][0][mm < 3 ? mm + 1 : 3][n][e]) : da[e], ng = mm < 3 ? dpp_rol1(acc[ai][1][mm < 3 ? mm + 1 : 3][n][e]) : dg[e];
            const float rca = dpp_ror1(ca_), rcg = dpp_ror1(cg_), lca = dpp_rol1(ca_), lcg = dpp_rol1(cg_);
            const float upa = fr > 0 ? rca : pa, upg = fr > 0 ? rcg : pg;
            const float dna = fr < 15 ? lca : na, dng = fr < 15 ? lcg : ng;
            const float A = wa0[e] * upa + wa1[e] * ca_ + wa2[e] * dna + ba[e];
            const float G = wg0[e] * upg + wg1[e] * cg_ + wg2[e] * dng + bg[e];
            o[e] = siluf_(G) * A;
          }
          const int row = u.pm * 256 + ai * 128 + wr * 64 + mm * 16 + fr;
          u32x2 w; w.x = pk2(o[0], o[1]); w.y = pk2(o[2], o[3]);
          *(u32x2*)(ACT + (size_t)row * FF + ca) = w;
        }
      }
    }
  }
};
DI void phase_conv_fix(const float* HALO, bf16_t* ACT, const float* cw, const float* cb, int ntiles) {
  const int tid = opaque_tid(); const int total = ntiles * 2 * (FF / 4);
  for (int it = blockIdx.x * NT + tid; it < total; it += gridDim.x * NT) {
    const int j = (it % (FF / 4)) * 4, tr = it / (FF / 4), pm = tr >> 1, bot = tr & 1;
    const bool first = pm < 128 ? (pm & 7) == 0 : true, last = pm < 128 ? (pm & 7) == 7 : true;
    const float* hc = HALO + (size_t)(pm * 4 + (bot ? 3 : 0)) * FF2 + j;
    const float* hu = bot ? HALO + (size_t)(pm * 4 + 2) * FF2 + j : (first ? nullptr : HALO + (size_t)((pm - 1) * 4 + 3) * FF2 + j);
    const float* hd = bot ? (last ? nullptr : HALO + (size_t)((pm + 1) * 4 + 0) * FF2 + j) : HALO + (size_t)(pm * 4 + 1) * FF2 + j;
    const f32x4 z = {0.f, 0.f, 0.f, 0.f};
    const f32x4 ca_ = *(const f32x4*)hc, cg_ = *(const f32x4*)(hc + FF);
    const f32x4 ua = hu ? *(const f32x4*)hu : z, ug = hu ? *(const f32x4*)(hu + FF) : z, da = hd ? *(const f32x4*)hd : z, dg = hd ? *(const f32x4*)(hd + FF) : z;
    const f32x4 A = *(const f32x4*)(cw + j) * ua + *(const f32x4*)(cw + FF2 + j) * ca_ + *(const f32x4*)(cw + 2 * FF2 + j) * da + *(const f32x4*)(cb + j);
    const f32x4 G = *(const f32x4*)(cw + FF + j) * ug + *(const f32x4*)(cw + FF2 + FF + j) * cg_ + *(const f32x4*)(cw + 2 * FF2 + FF + j) * dg + *(const f32x4*)(cb + FF + j);
    u32x2 w; w.x = pk2(siluf_(G.x) * A.x, siluf_(G.y) * A.y); w.y = pk2(siluf_(G.z) * A.z, siluf_(G.w) * A.w);
    *(u32x2*)(ACT + (size_t)(pm * 256 + (bot ? 255 : 0)) * FF + j) = w;
  }
}

DI void conv_fix_tile(const float* HALO, bf16_t* ACT, const float* cw, const float* cb, int pm, int tid) {
  for (int it = tid; it < 2 * (FF / 4); it += NT) {
    const int j = (it % (FF / 4)) * 4, bot = it / (FF / 4);
    const bool first = pm < 128 ? (pm & 7) == 0 : true, last = pm < 128 ? (pm & 7) == 7 : true;
    const float* hc = HALO + (size_t)(pm * 4 + (bot ? 3 : 0)) * FF2 + j;
    const float* hu = bot ? HALO + (size_t)(pm * 4 + 2) * FF2 + j : (first ? nullptr : HALO + (size_t)((pm - 1) * 4 + 3) * FF2 + j);
    const float* hd = bot ? (last ? nullptr : HALO + (size_t)((pm + 1) * 4 + 0) * FF2 + j) : HALO + (size_t)(pm * 4 + 1) * FF2 + j;
    const f32x4 z = {0.f, 0.f, 0.f, 0.f};
    const f32x4 ca_ = *(const f32x4*)hc, cg_ = *(const f32x4*)(hc + FF);
    const f32x4 ua = hu ? *(const f32x4*)hu : z, ug = hu ? *(const f32x4*)(hu + FF) : z, da = hd ? *(const f32x4*)hd : z, dg = hd ? *(const f32x4*)(hd + FF) : z;
    const f32x4 A = *(const f32x4*)(cw + j) * ua + *(const f32x4*)(cw + FF2 + j) * ca_ + *(const f32x4*)(cw + 2 * FF2 + j) * da + *(const f32x4*)(cb + j);
    const f32x4 G = *(const f32x4*)(cw + FF + j) * ug + *(const f32x4*)(cw + FF2 + FF + j) * cg_ + *(const f32x4*)(cw + 2 * FF2 + FF + j) * dg + *(const f32x4*)(cb + FF + j);
    u32x2 w; w.x = pk2(siluf_(G.x) * A.x, siluf_(G.y) * A.y); w.y = pk2(siluf_(G.z) * A.z, siluf_(G.w) * A.w);
    *(u32x2*)(ACT + (size_t)(pm * 256 + (bot ? 255 : 0)) * FF + j) = w;
  }
}
DI void conv_fix_my_tiles(const pg8::StaticOrder& S, int pm_off, const float* HALO, bf16_t* ACT, const float* cw, const float* cb) {
  const int tid = opaque_tid(); pg8::Unit u; int lastpm = -1;
  for (int i = 0; S.next(i, u); ++i) if (u.pm != lastpm) { conv_fix_tile(HALO, ACT, cw, cb, pm_off + u.pm, tid); lastpm = u.pm; }
  asm volatile("s_waitcnt vmcnt(0)" ::: "memory"); __syncthreads();
}

DI void transpose_item(const float* W, int K, int N, bf16_t* WT, int row_off, LAS float* scr, int item, int lane, int ldo, int koff, bool UPPERM) {
  const int nblk = N / 32, kb = item / nblk, nb = item % nblk, k0 = 64 * kb, n0 = 32 * nb;
#pragma unroll 16
  for (int i = 0; i < 32; ++i) { const int kk = 2 * i + (lane >> 5); scr[kk * 33 + (lane & 31)] = W[(size_t)(k0 + kk) * N + n0 + (lane & 31)]; }
  asm volatile("s_waitcnt lgkmcnt(0)" ::: "memory");
  const int c = lane & 7;
#pragma unroll
  for (int j = 0; j < 4; ++j) { const int n = (lane >> 3) + 8 * j; const LAS float* s = scr + (8 * c) * 33 + n;
    u32x4 o; o.x = pk2(s[0 * 33], s[1 * 33]); o.y = pk2(s[2 * 33], s[3 * 33]); o.z = pk2(s[4 * 33], s[5 * 33]); o.w = pk2(s[6 * 33], s[7 * 33]);
    int drow = row_off + n0 + n;
    if (UPPERM) { const int ns = n0 + n, hg = ns >= FF ? 1 : 0, nn = ns - hg * FF; drow = row_off + (nn >> 7) * 256 + hg * 128 + (nn & 127); }
    *(u32x4*)(WT + (size_t)drow * ldo + koff + k0 + 8 * c) = o; }
  asm volatile("s_waitcnt lgkmcnt(0)" ::: "memory");
}

DI void phase_prologue(const Params& p, LAS unsigned char* lds) {
  const int tid = opaque_tid(), lane = tid & 63, wave = __builtin_amdgcn_readfirstlane(tid >> 6), G = gridDim.x;
  unsigned char* ws = p.ws;
  { float* COSH = (float*)(ws + WS_TAB); float* SINH = COSH + 2048 * 32; float* COSR = SINH + 2048 * 32; float* SINR = COSR + 2048 * 16;
    for (int i = blockIdx.x * NT + tid; i < 2048 * 32; i += G * NT) { const int t = i >> 5, f = i & 31; const float pos = (float)((f < 16) ? (t >> 6) : (t & 63));
      const float inv = powf(10000.f, -(float)(f & 15) / 16.f); const float a = pos * inv; COSH[i] = cosf(a); SINH[i] = sinf(a); }
    for (int i = blockIdx.x * NT + tid; i < 2048 * 16; i += G * NT) { const int t = i >> 4, f = i & 15; const float pos = (float)((f < 8) ? (t >> 6) : (t & 63));
      const float inv = powf(10000.f, -(float)(f & 7) / 8.f); const float a = pos * inv; COSR[i] = cosf(a); SINR[i] = sinf(a); }
  }
  constexpr int I1 = 16 * 37, I2 = 4 * 24, I3 = 2 * 32, I4 = 16 * 32, I5 = 16 * 56, I6 = 16 * 32, I7 = 16 * 176, I9 = 44 * 32;
  constexpr int NIT = I1 + I2 + I3 + I4 + I5 + I6 + 2 * I7 + 2 * I9;
  auto do_item = [&](int it, LAS float* scr) {
    int r = it; const float* W; bf16_t* WT; int K, N, ro = 0, ldo, ko = 0; bool up = false;
    if (r < I1) { W = p.ev_w_in; K = 1024; N = EV_IN; WT = (bf16_t*)(ws + WS_W_EVIN); ldo = 1024; }
    else if ((r -= I1) < I2) { W = p.ev_w_q_up; K = 256; N = 768; WT = (bf16_t*)(ws + WS_W_QUP); ldo = 384; }
    else if ((r -= I2) < I3) { W = p.ev_w_kv_up; K = 128; N = 1024; WT = (bf16_t*)(ws + WS_W_QUP); ro = 768; ldo = 384; ko = 256; }
    else if ((r -= I3) < I4) { W = p.ev_w_out; K = 1024; N = 1024; WT = (bf16_t*)(ws + WS_W_EVOUT); ldo = 1024; }
    else if ((r -= I4) < I5) { W = p.od_w_in; K = 1024; N = 1792; WT = (bf16_t*)(ws + WS_W_ODIN); ldo = 1024; }
    else if ((r -= I5) < I6) { W = p.od_w_out; K = 1024; N = 1024; WT = (bf16_t*)(ws + WS_W_ODOUT); ldo = 1024; }
    else if ((r -= I6) < I7) { W = p.ffn_up; K = 1024; N = FF2; WT = (bf16_t*)(ws + WS_W_UP); ldo = 1024; up = true; }
    else if ((r -= I7) < I7) { W = p.ffn_up + (size_t)1024 * FF2; K = 1024; N = FF2; WT = (bf16_t*)(ws + WS_W_UP) + (size_t)FF2 * 1024; ldo = 1024; up = true; }
    else if ((r -= I7) < I9) { W = p.ffn_down; K = FF; N = 1024; WT = (bf16_t*)(ws + WS_W_DOWN); ldo = FF; }
    else { r -= I9; W = p.ffn_down + (size_t)FF * 1024; K = FF; N = 1024; WT = (bf16_t*)(ws + WS_W_DOWN) + (size_t)1024 * FF; ldo = FF; }
    transpose_item(W, K, N, WT, ro, scr, r, lane, ldo, ko, up);
  };
  const int nGB = G < 192 ? G : 192;
  const int nTW = nGB * 4, NA = nTW * 7 < NIT ? nTW * 7 : NIT;
  { LAS float* s = (LAS float*)lds; LAS float* red = s + 17 * 1024; float* MOD = (float*)(ws + WS_MOD);
    for (int it = blockIdx.x; it < 192; it += G) {
      for (int i = tid; i < 17 * 1024; i += NT) { const int r = i >> 10, k = i & 1023; const float v = r < 16 ? p.c[r * 1024 + k] : p.c_ctx[k]; s[i] = siluf_(v); }
      __syncthreads();
      const int layer = it / 96, j0 = (it % 96) * 64, kq = (tid >> 6) & 3, jl = tid & 63;
      if (wave < 4) {
        float acc[17];
#pragma unroll
        for (int r = 0; r < 17; ++r) acc[r] = 0.f;
        const float* w = p.mod_w + (size_t)layer * 1024 * 6144 + j0 + jl;
#pragma unroll 8
        for (int k = kq * 256; k < kq * 256 + 256; ++k) { const float wv = w[(size_t)k * 6144];
#pragma unroll
          for (int r = 0; r < 17; ++r) acc[r] += s[r * 1024 + k] * wv; }
#pragma unroll
        for (int r = 0; r < 17; ++r) red[(kq * 17 + r) * 64 + jl] = acc[r];
      } else if (it == (int)blockIdx.x) {
        LAS float* scr = (LAS float*)(lds + 87040 + (wave - 4) * 8448);
        const int tw = blockIdx.x * 4 + (wave - 4);
        for (int j = 0; j < 7; ++j) { const int item = tw + j * nTW; if (item < NA) do_item(item, scr); }
      }
      __syncthreads();
      for (int o = tid; o < 17 * 64; o += NT) { const int r = o >> 6, j = o & 63; float sum = p.mod_b[layer * 6144 + j0 + j];
#pragma unroll
        for (int q = 0; q < 4; ++q) sum += red[(q * 17 + r) * 64 + j];
        MOD[((size_t)layer * 17 + r) * 6144 + j0 + j] = sum; }
      __syncthreads();
    }
  }
  __syncthreads();
  { LAS float* scr = (LAS float*)(lds + wave * 8448);
    const int gw = blockIdx.x * 8 + wave, NGW = G * 8;
    for (int it = NA + gw; it < NIT; it += NGW) do_item(it, scr);
    { bf16_t* wq = (bf16_t*)(ws + WS_W_QUP);
      for (int i = blockIdx.x * NT + tid; i < 768 * 16; i += G * NT) { const int r_ = i >> 4, c_ = i & 15; *(u32x4*)(wq + (size_t)r_ * 384 + 256 + c_ * 8) = (u32x4){0u, 0u, 0u, 0u}; }
      for (int i = blockIdx.x * NT + tid; i < 1024 * 32; i += G * NT) { const int r_ = 768 + (i >> 5), c_ = i & 31; *(u32x4*)(wq + (size_t)r_ * 384 + c_ * 8) = (u32x4){0u, 0u, 0u, 0u}; } }
    u32x4* z = (u32x4*)((bf16_t*)(ws + WS_W_EVIN) + (size_t)EV_IN * 1024);
    for (int i = blockIdx.x * NT + tid; i < (EV_PITCH - EV_IN) * 1024 / 8; i += G * NT) z[i] = (u32x4){0u, 0u, 0u, 0u};
  }
}

DI void phase_norm_mod(const float* srcL, const float* srcC, const float* g, const float* modl, int shiftIdx, int scaleIdx, bf16_t* Z, int rowBeg, int rowEnd, int blk0 = 0, int nblk = 0) {
  if (nblk == 0) nblk = gridDim.x;
  const int tid = opaque_tid(), lane = tid & 63, gw = ((int)blockIdx.x - blk0) * 8 + (tid >> 6), NGW = nblk * 8;
  for (int row0 = rowBeg + gw; row0 < rowEnd; row0 += 2 * NGW) {
    const int row1 = row0 + NGW; const bool has1 = row1 < rowEnd; const int r1 = has1 ? row1 : row0;
    const float* s0 = row0 < ML ? srcL + (size_t)row0 * DM : srcC + (size_t)(row0 - ML) * DM;
    const float* s1 = r1 < ML ? srcL + (size_t)r1 * DM : srcC + (size_t)(r1 - ML) * DM;
    f32x4 v0[4], v1[4];
#pragma unroll
    for (int j = 0; j < 4; ++j) { v0[j] = *(const f32x4*)(s0 + 4 * (64 * j + lane)); v1[j] = *(const f32x4*)(s1 + 4 * (64 * j + lane)); }
    float ss0 = 0.f, ss1 = 0.f;
#pragma unroll
    for (int j = 0; j < 4; ++j) { ss0 += (v0[j].x * v0[j].x + v0[j].y * v0[j].y) + (v0[j].z * v0[j].z + v0[j].w * v0[j].w); ss1 += (v1[j].x * v1[j].x + v1[j].y * v1[j].y) + (v1[j].z * v1[j].z + v1[j].w * v1[j].w); }
    const float q0 = rsqrtf(wave_sum(ss0) * (1.f / DM) + EPS), q1 = rsqrtf(wave_sum(ss1) * (1.f / DM) + EPS);
    const float* mp0 = modl + (size_t)modrow(row0) * 6144; const float* mp1 = modl + (size_t)modrow(r1) * 6144;
#pragma unroll
    for (int j = 0; j < 4; ++j) { const int k = 4 * (64 * j + lane);
      const f32x4 gg = *(const f32x4*)(g + k);
      { const f32x4 sc = *(const f32x4*)(mp0 + scaleIdx * 1024 + k), sh = *(const f32x4*)(mp0 + shiftIdx * 1024 + k);
        const f32x4 z = (v0[j] * q0) * gg * (sc + 1.f) + sh; u32x2 w; w.x = pk2(z.x, z.y); w.y = pk2(z.z, z.w); *(u32x2*)(Z + (size_t)row0 * DM + k) = w; }
      if (has1) { const f32x4 sc = *(const f32x4*)(mp1 + scaleIdx * 1024 + k), sh = *(const f32x4*)(mp1 + shiftIdx * 1024 + k);
        const f32x4 z = (v1[j] * q1) * gg * (sc + 1.f) + sh; u32x2 w; w.x = pk2(z.x, z.y); w.y = pk2(z.z, z.w); *(u32x2*)(Z + (size_t)row1 * DM + k) = w; }
    }
  }
}
DI void phase_final_norm_bf(const bf16_t* hb, float* out, const float* g) {
  const int tid = opaque_tid(), lane = tid & 63, gw = blockIdx.x * 8 + (tid >> 6), NGW = gridDim.x * 8;
  for (int row = gw; row < ML; row += NGW) {
    const bf16_t* src = hb + (size_t)row * DM; float* dst = out + (size_t)row * DM;
    const u32x4 a = *(const u32x4*)(src + 8 * lane), b = *(const u32x4*)(src + 512 + 8 * lane);
    float x[16] = {bflo(a.x), bfhi(a.x), bflo(a.y), bfhi(a.y), bflo(a.z), bfhi(a.z), bflo(a.w), bfhi(a.w), bflo(b.x), bfhi(b.x), bflo(b.y), bfhi(b.y), bflo(b.z), bfhi(b.z), bflo(b.w), bfhi(b.w)};
    float ss = 0.f;
#pragma unroll
    for (int j = 0; j < 16; ++j) ss += x[j] * x[j];
    const float r = rsqrtf(wave_sum(ss) * (1.f / DM) + EPS);
#pragma unroll
    for (int hh = 0; hh < 2; ++hh)
#pragma unroll
      for (int q = 0; q < 2; ++q) { const int k = hh * 512 + 8 * lane + 4 * q; const f32x4 gg = *(const f32x4*)(g + k);
        f32x4 o; o.x = x[hh * 8 + 4 * q] * r * gg.x; o.y = x[hh * 8 + 4 * q + 1] * r * gg.y; o.z = x[hh * 8 + 4 * q + 2] * r * gg.z; o.w = x[hh * 8 + 4 * q + 3] * r * gg.w;
        *(f32x4*)(dst + k) = o; }
  }
}
DI void phase_final_norm(float* out, const float* g) {
  const int tid = opaque_tid(), lane = tid & 63, gw = blockIdx.x * 8 + (tid >> 6), NGW = gridDim.x * 8;
  for (int row = gw; row < ML; row += NGW) {
    float* src = out + (size_t)row * DM;
    f32x4 v[4]; float ss = 0.f;
#pragma unroll
    for (int j = 0; j < 4; ++j) { v[j] = *(const f32x4*)(src + 4 * (64 * j + lane)); ss += (v[j].x * v[j].x + v[j].y * v[j].y) + (v[j].z * v[j].z + v[j].w * v[j].w); }
    const float r = rsqrtf(wave_sum(ss) * (1.f / DM) + EPS);
#pragma unroll
    for (int j = 0; j < 4; ++j) { const int k = 4 * (64 * j + lane); const f32x4 gg = *(const f32x4*)(g + k); *(f32x4*)(src + k) = (v[j] * r) * gg; }
  }
}
DI void head_fix(bf16_t* base, int sub, const float* gain, bool norm, bool rope, const float* cs, const float* sn, float scale, bool doit) {
  const u32x2 a = *(const u32x2*)(base + 4 * sub), b = *(const u32x2*)(base + 32 + 4 * sub);
  float x1[4] = {bflo(a.x), bfhi(a.x), bflo(a.y), bfhi(a.y)}, x2[4] = {bflo(b.x), bfhi(b.x), bflo(b.y), bfhi(b.y)};
  if (norm) {
    float ss = 0.f;
#pragma unroll
    for (int j = 0; j < 4; ++j) ss += x1[j] * x1[j] + x2[j] * x2[j];
    ss += __shfl_xor(ss, 1); ss += __shfl_xor(ss, 2); ss += __shfl_xor(ss, 4);
    const float r = rsqrtf(ss * (1.f / 64.f) + EPS);
#pragma unroll
    for (int j = 0; j < 4; ++j) { x1[j] = x1[j] * r * gain[4 * sub + j]; x2[j] = x2[j] * r * gain[32 + 4 * sub + j]; }
  }
  if (rope) {
#pragma unroll
    for (int j = 0; j < 4; ++j) { const float c = cs[4 * sub + j], s = sn[4 * sub + j]; const float o1 = x1[j] * c - x2[j] * s, o2 = x1[j] * s + x2[j] * c; x1[j] = o1; x2[j] = o2; }
  }
  if (doit) {
    u32x2 wa, wb; wa.x = pk2(x1[0] * scale, x1[1] * scale); wa.y = pk2(x1[2] * scale, x1[3] * scale); wb.x = pk2(x2[0] * scale, x2[1] * scale); wb.y = pk2(x2[2] * scale, x2[3] * scale);
    *(u32x2*)(base + 4 * sub) = wa; *(u32x2*)(base + 32 + 4 * sub) = wb;
  }
}
DI void phase_post_even(const Params& p) {
  const int tid = opaque_tid(), lane = tid & 63, gw = blockIdx.x * 8 + (tid >> 6), NGW = gridDim.x * 8;
  bf16_t* H = (bf16_t*)(p.ws + WS_H);
  const float* COSH = (const float*)(p.ws + WS_TAB); const float* SINH = COSH + 2048 * 32; const float* COSR = SINH + 2048 * 32; const float* SINR = COSR + 2048 * 16;
  for (int row = gw; row < MT; row += NGW) {
    bf16_t* hr = H + (size_t)row * EV_PITCH; const bool lat = row < ML; const int t = row & (SEQ - 1);
    const int sub = lane & 7;
    head_fix(hr + 512 + ((lane >> 3) & 1) * 64, sub, p.ev_ka_g, true, lat, COSH + t * 32, SINH + t * 32, 1.f, lane < 16);
    {
      const u32x2 a = *(const u32x2*)(hr + 768 + 4 * lane); float x[4] = {bflo(a.x), bfhi(a.x), bflo(a.y), bfhi(a.y)};
      const float r = rsqrtf(wave_sum(x[0] * x[0] + x[1] * x[1] + x[2] * x[2] + x[3] * x[3]) * (1.f / 256.f) + EPS);
      const f32x4 g = *(const f32x4*)(p.ev_qlat_g + 4 * lane);
      u32x2 w; w.x = pk2(x[0] * r * g.x, x[1] * r * g.y); w.y = pk2(x[2] * r * g.z, x[3] * r * g.w); *(u32x2*)(hr + 768 + 4 * lane) = w; }
    {
      const unsigned a = *(const unsigned*)(hr + 1024 + 2 * lane); const float x0 = bflo(a), x1 = bfhi(a);
      const float r = rsqrtf(wave_sum(x0 * x0 + x1 * x1) * (1.f / 128.f) + EPS);
      *(unsigned*)(hr + 1024 + 2 * lane) = pk2(x0 * r * p.ev_kvlat_g[2 * lane], x1 * r * p.ev_kvlat_g[2 * lane + 1]); }
    if (lat && lane < 16) {
      const float x1 = bf2f(hr[1152 + lane]), x2 = bf2f(hr[1152 + 16 + lane]); const float c = COSR[t * 16 + lane], s = SINR[t * 16 + lane];
      hr[1152 + lane] = f2bf(x1 * c - x2 * s); hr[1152 + 16 + lane] = f2bf(x1 * s + x2 * c); }
  }
}
DI void phase_post_odd(const Params& p) {
  const int tid = opaque_tid(), lane = tid & 63, gw = blockIdx.x * 8 + (tid >> 6), NGW = gridDim.x * 8;
  bf16_t* H = (bf16_t*)(p.ws + WS_H);
  const float* COSH = (const float*)(p.ws + WS_TAB); const float* SINH = COSH + 2048 * 32;
  for (int row = gw; row < ML; row += NGW) {
    bf16_t* hr = H + (size_t)row * OD_PITCH; const int t = row & (SEQ - 1); const int sub = lane & 7;
    { const u32x4 a = *(const u32x4*)(hr + 512 + 8 * lane);
      float x[8] = {bflo(a.x), bfhi(a.x), bflo(a.y), bfhi(a.y), bflo(a.z), bfhi(a.z), bflo(a.w), bfhi(a.w)}; float s = 0.f;
#pragma unroll
      for (int j = 0; j < 8; ++j) { x[j] = geluf_(x[j]); s += x[j]; }
      const float mu = wave_sum(s) * (1.f / 512.f); float q = 0.f;
#pragma unroll
      for (int j = 0; j < 8; ++j) { x[j] -= mu; q += x[j] * x[j]; }
      const float r = rsqrtf(wave_sum(q) * (1.f / 512.f) + EPS);
      const f32x4 g0 = *(const f32x4*)(p.od_ln_g + 8 * lane), g1 = *(const f32x4*)(p.od_ln_g + 8 * lane + 4), b0 = *(const f32x4*)(p.od_ln_b + 8 * lane), b1 = *(const f32x4*)(p.od_ln_b + 8 * lane + 4);
      u32x4 w; w.x = pk2(x[0] * r * g0.x + b0.x, x[1] * r * g0.y + b0.y); w.y = pk2(x[2] * r * g0.z + b0.z, x[3] * r * g0.w + b0.w);
      w.z = pk2(x[4] * r * g1.x + b1.x, x[5] * r * g1.y + b1.y); w.w = pk2(x[6] * r * g1.z + b1.z, x[7] * r * g1.w + b1.w);
      *(u32x4*)(hr + 512 + 8 * lane) = w; }
    head_fix(hr + 1536 + ((lane >> 3) & 1) * 64, sub, nullptr, false, true, COSH + t * 32, SINH + t * 32, 1.f, lane < 16);
  }
}
DI void phase_conv_act(const bf16_t* HUP, bf16_t* ACT, const float* cw, const float* cb, int rbeg, int rend) {
  const long total = (long)(rend - rbeg) * 352; const int tid = opaque_tid();
  for (long it = (long)blockIdx.x * NT + tid; it < total; it += (long)gridDim.x * NT) {
    const int lr = (int)(it / 352), ch = (int)(it % 352), row = rbeg + lr, j = ch * 8;
    const int pos = row < ML ? (row & (SEQ - 1)) : ((row - ML) & (CTX - 1)); const int len = row < ML ? SEQ : CTX;
    const bf16_t* h = HUP + (size_t)lr * FF2 + j;
    const u32x4 z4 = {0u, 0u, 0u, 0u};
    const u32x4 a0 = pos > 0 ? *(const u32x4*)(h - FF2) : z4, a1 = *(const u32x4*)h, a2 = pos < len - 1 ? *(const u32x4*)(h + FF2) : z4;
    const u32x4 g0 = pos > 0 ? *(const u32x4*)(h - FF2 + FF) : z4, g1 = *(const u32x4*)(h + FF), g2 = pos < len - 1 ? *(const u32x4*)(h + FF2 + FF) : z4;
    float o[8];
#pragma unroll
    for (int e = 0; e < 8; ++e) {
      const unsigned wa0 = a0[e >> 1], wa1 = a1[e >> 1], wa2 = a2[e >> 1], wg0 = g0[e >> 1], wg1 = g1[e >> 1], wg2 = g2[e >> 1];
      const float xa0 = (e & 1) ? bfhi(wa0) : bflo(wa0), xa1 = (e & 1) ? bfhi(wa1) : bflo(wa1), xa2 = (e & 1) ? bfhi(wa2) : bflo(wa2);
      const float xg0 = (e & 1) ? bfhi(wg0) : bflo(wg0), xg1 = (e & 1) ? bfhi(wg1) : bflo(wg1), xg2 = (e & 1) ? bfhi(wg2) : bflo(wg2);
      const int ja = j + e, jg = FF + j + e;
      const float A = cw[ja] * xa0 + cw[FF2 + ja] * xa1 + cw[2 * FF2 + ja] * xa2 + cb[ja];
      const float Gv = cw[jg] * xg0 + cw[FF2 + jg] * xg1 + cw[2 * FF2 + jg] * xg2 + cb[jg];
      o[e] = siluf_(Gv) * A;
    }
    u32x4 w; w.x = pk2(o[0], o[1]); w.y = pk2(o[2], o[3]); w.z = pk2(o[4], o[5]); w.w = pk2(o[6], o[7]);
    *(u32x4*)(ACT + (size_t)lr * FF + j) = w;
  }
}

struct AttnJob { const bf16_t *Q, *K1, *K2, *V; bf16_t* O; int qp, k1p, k2p, vp, op; int s0row, s0n, s1row, s1n; int win, qpos0, s1pos0; float sink2; int has_sink; const float* rope_cos; const float* rope_sin; const float* qg; const float* cosh; const float* sinh; float qscale; int q_rope; };
DI s16x4 vtr(const LAS unsigned char* pp) { typedef short v4i16_t __attribute__((ext_vector_type(4))); return __builtin_bit_cast(s16x4, __builtin_amdgcn_ds_read_tr16_b64_v4i16((LAS v4i16_t*)pp)); }
#define MFMA32(a, b, c) __builtin_amdgcn_mfma_f32_32x32x16_bf16((a), (b), (c), 0, 0, 0)

DI void q_fix64(bf16x8 (&qf)[4], const AttnJob& J, int pos, int h) {
  float x[4][8];
#pragma unroll
  for (int s = 0; s < 4; ++s)
#pragma unroll
    for (int j = 0; j < 8; ++j) x[s][j] = bf2f((unsigned short)qf[s][j]);
  if (J.qg) {
    float ss = 0.f;
#pragma unroll
    for (int s = 0; s < 4; ++s)
#pragma unroll
      for (int j = 0; j < 8; ++j) ss += x[s][j] * x[s][j];
    ss += __shfl_xor(ss, 32);
    const float r = rsqrtf(ss * (1.f / 64.f) + EPS);
#pragma unroll
    for (int s = 0; s < 4; ++s) { const f32x4 g0 = *(const f32x4*)(J.qg + 16 * s + 8 * h), g1 = *(const f32x4*)(J.qg + 16 * s + 8 * h + 4);
#pragma unroll
      for (int j = 0; j < 4; ++j) { x[s][j] *= r * g0[j]; x[s][4 + j] *= r * g1[j]; } }
  }
  if (J.q_rope) {
#pragma unroll
    for (int s = 0; s < 2; ++s) { const float* cp = J.cosh + pos * 32 + 16 * s + 8 * h; const float* sp = J.sinh + pos * 32 + 16 * s + 8 * h;
      const f32x4 c0 = *(const f32x4*)cp, c1 = *(const f32x4*)(cp + 4), s0 = *(const f32x4*)sp, s1 = *(const f32x4*)(sp + 4);
#pragma unroll
      for (int j = 0; j < 8; ++j) { const float c = j < 4 ? c0[j & 3] : c1[j & 3], sn = j < 4 ? s0[j & 3] : s1[j & 3]; const float x1 = x[s][j], x2 = x[s + 2][j];
        x[s][j] = x1 * c - x2 * sn; x[s + 2][j] = x1 * sn + x2 * c; } }
  }
#pragma unroll
  for (int s = 0; s < 4; ++s) { u32x4 w; w.x = pk2(x[s][0] * J.qscale, x[s][1] * J.qscale); w.y = pk2(x[s][2] * J.qscale, x[s][3] * J.qscale);
    w.z = pk2(x[s][4] * J.qscale, x[s][5] * J.qscale); w.w = pk2(x[s][6] * J.qscale, x[s][7] * J.qscale); qf[s] = __builtin_bit_cast(bf16x8, w); }
}
template <int DK> DI void attn_unit(const AttnJob& J, LAS unsigned char* lds) {
  constexpr int KP = DK * 2 + 16, VP = 144, KBUF = 64 * KP, VBUF = 64 * VP, NS = DK / 16;
  const int tid = opaque_tid(), lane = tid & 63, wave = tid >> 6, r32 = lane & 31, h = lane >> 5;
  LAS unsigned char* Kl = lds; LAS unsigned char* Vl = lds + 2 * KBUF;
  const bf16_t* qrow = J.Q + (size_t)(wave * 32 + r32) * J.qp;
  bf16x8 qf[NS];
#pragma unroll
  for (int s = 0; s < NS; ++s) qf[s] = *(const bf16x8*)(qrow + 16 * s + 8 * h);
  if constexpr (DK == 64) q_fix64(qf, J, J.qpos0 + wave * 32 + r32, h);
  if (DK == 96) { if (J.rope_cos) {
    const float* cs = J.rope_cos + (J.qpos0 + wave * 32 + r32) * 16 + 8 * h; const float* sn = J.rope_sin + (J.qpos0 + wave * 32 + r32) * 16 + 8 * h;
#pragma unroll
    for (int j = 0; j < 8; ++j) { const float x1 = bf2f((unsigned short)qf[NS - 2][j]), x2 = bf2f((unsigned short)qf[NS - 1][j]); const float c = cs[j], s_ = sn[j];
      qf[NS - 2][j] = (short)f2bf(x1 * c - x2 * s_); qf[NS - 1][j] = (short)f2bf(x1 * s_ + x2 * c); } } }
  const int nt0 = J.s0n >> 6, nt = nt0 + (J.s1n >> 6);
  const int srow = tid >> 3, sch = tid & 7;
  const int s2row = (tid >> 2) & 63, s2ch = tid & 3;
  u32x4 rk, rv, rk2;
  auto tile_row = [&](int t) -> int { return t < nt0 ? J.s0row + 64 * t : J.s1row + 64 * (t - nt0); };
  auto gload = [&](int t) { const int kr0 = tile_row(t);
    rk = *(const u32x4*)(J.K1 + (size_t)(kr0 + srow) * J.k1p + sch * 8);
    rv = *(const u32x4*)(J.V + (size_t)(kr0 + srow) * J.vp + sch * 8);
    if (DK == 96) { if (tid < 256) rk2 = *(const u32x4*)(J.K2 + (size_t)(kr0 + s2row) * J.k2p + s2ch * 8); } };
  auto lstore = [&](int b) {
    *(LAS u32x4*)(Kl + b * KBUF + srow * KP + sch * 16) = rk;
    *(LAS u32x4*)(Vl + b * VBUF + srow * VP + sch * 16) = rv;
    if (DK == 96) { if (tid < 256) *(LAS u32x4*)(Kl + b * KBUF + s2row * KP + 128 + s2ch * 16) = rk2; } };
  gload(0); lstore(0); __syncthreads();
  float m = 0.f, lsum = 0.f; f32x16 O0 = {}, O1 = {};
  const int qpos = J.qpos0 + wave * 32 + r32, qmin = J.qpos0 + wave * 32;
  const int q4 = (lane & 15) >> 2, p4 = lane & 3, blk = (lane >> 4) & 1;
  for (int t = 0; t < nt; ++t) {
    if (t + 1 < nt) gload(t + 1);
    const LAS unsigned char* Kb = Kl + (t & 1) * KBUF; const LAS unsigned char* Vb = Vl + (t & 1) * VBUF;
    bool active = true; int kp0 = 0;
    if (J.win && t >= nt0) { kp0 = J.s1pos0 + 64 * (t - nt0); active = (kp0 + 63 >= qmin - 128) && (kp0 <= qmin + 31 + 128); }
    if (active) {
      f32x16 S0, S1;
#pragma unroll
      for (int i = 0; i < 16; ++i) { S0[i] = -m; S1[i] = -m; }
#pragma unroll
      for (int s = 0; s < NS; ++s) {
        const bf16x8 k0 = *(const LAS bf16x8*)(Kb + r32 * KP + (16 * s + 8 * h) * 2);
        const bf16x8 k1 = *(const LAS bf16x8*)(Kb + (32 + r32) * KP + (16 * s + 8 * h) * 2);
        S0 = MFMA32(k0, qf[s], S0); S1 = MFMA32(k1, qf[s], S1);
      }
      if (J.win && t >= nt0) {
#pragma unroll
        for (int i = 0; i < 16; ++i) { const int kpos = kp0 + crow(i, h); const int d0 = qpos - kpos, d1 = d0 - 32;
          if (d0 > 128 || d0 < -128) S0[i] = -1e30f; if (d1 > 128 || d1 < -128) S1[i] = -1e30f; }
      }
      float mx = fmaxf(S0[0], S1[0]);
#pragma unroll
      for (int i = 1; i < 16; ++i) mx = fmaxf(mx, fmaxf(S0[i], S1[i]));
      mx = fmaxf(mx, __shfl_xor(mx, 32));
      if (__any(mx > 6.0f)) {
        const float dl = fmaxf(mx, 0.f); m += dl; const float alpha = __builtin_amdgcn_exp2f(-dl); lsum *= alpha;
#pragma unroll
        for (int i = 0; i < 16; ++i) { S0[i] -= dl; S1[i] -= dl; O0[i] *= alpha; O1[i] *= alpha; }
      }
      float ps = 0.f;
#pragma unroll
      for (int i = 0; i < 16; ++i) { S0[i] = __builtin_amdgcn_exp2f(S0[i]); S1[i] = __builtin_amdgcn_exp2f(S1[i]); ps += S0[i] + S1[i]; }
      lsum += ps;
#pragma unroll
      for (int kb = 0; kb < 2; ++kb)
#pragma unroll
        for (int s2 = 0; s2 < 2; ++s2) {
          u32x4 pw;
          if (kb == 0) { pw.x = pk2(S0[8 * s2 + 0], S0[8 * s2 + 1]); pw.y = pk2(S0[8 * s2 + 2], S0[8 * s2 + 3]); pw.z = pk2(S0[8 * s2 + 4], S0[8 * s2 + 5]); pw.w = pk2(S0[8 * s2 + 6], S0[8 * s2 + 7]); }
          else         { pw.x = pk2(S1[8 * s2 + 0], S1[8 * s2 + 1]); pw.y = pk2(S1[8 * s2 + 2], S1[8 * s2 + 3]); pw.z = pk2(S1[8 * s2 + 4], S1[8 * s2 + 5]); pw.w = pk2(S1[8 * s2 + 6], S1[8 * s2 + 7]); }
          const bf16x8 pf = __builtin_bit_cast(bf16x8, pw);
          const LAS unsigned char* vb = Vb + (kb * 32 + 16 * s2 + 4 * h + q4) * VP + (blk * 16 + 4 * p4) * 2;
          { const s16x4 lo = vtr(vb), hi = vtr(vb + 8 * VP); const bf16x8 vf = __builtin_shufflevector(lo, hi, 0, 1, 2, 3, 4, 5, 6, 7); O0 = MFMA32(vf, pf, O0); }
          { const s16x4 lo = vtr(vb + 64), hi = vtr(vb + 64 + 8 * VP); const bf16x8 vf = __builtin_shufflevector(lo, hi, 0, 1, 2, 3, 4, 5, 6, 7); O1 = MFMA32(vf, pf, O1); }
        }
    }
    if (t + 1 < nt) lstore((t + 1) & 1);
    __syncthreads();
  }
  lsum += __shfl_xor(lsum, 32);
  if (J.has_sink) lsum += __builtin_amdgcn_exp2f(J.sink2 - m);
  const float inv = 1.f / lsum;
  bf16_t* orow = J.O + (size_t)(wave * 32 + r32) * J.op;
#pragma unroll
  for (int g = 0; g < 4; ++g) {
    u32x2 w0, w1; w0.x = pk2(O0[4 * g] * inv, O0[4 * g + 1] * inv); w0.y = pk2(O0[4 * g + 2] * inv, O0[4 * g + 3] * inv);
    w1.x = pk2(O1[4 * g] * inv, O1[4 * g + 1] * inv); w1.y = pk2(O1[4 * g + 2] * inv, O1[4 * g + 3] * inv);
    *(u32x2*)(orow + 8 * g + 4 * h) = w0; *(u32x2*)(orow + 32 + 8 * g + 4 * h) = w1;
  }
}

template <int DK> DI void attn_unit2(const AttnJob& J, LAS unsigned char* lds) {
  constexpr int KP = DK * 2 + 16, VP = 144, KBUF = 64 * KP, VBUF = 64 * VP, NS = DK / 16;
  const int tid = opaque_tid(), lane = tid & 63, wave = tid >> 6, r32 = lane & 31, h = lane >> 5;
  LAS unsigned char* Kl = lds; LAS unsigned char* Vl = lds + 2 * KBUF;
  bf16x8 qf[2][NS];
#pragma unroll
  for (int qb = 0; qb < 2; ++qb) {
    const bf16_t* qrow = J.Q + (size_t)(wave * 64 + qb * 32 + r32) * J.qp;
#pragma unroll
    for (int s = 0; s < NS; ++s) qf[qb][s] = *(const bf16x8*)(qrow + 16 * s + 8 * h);
    if constexpr (DK == 64) q_fix64(qf[qb], J, J.qpos0 + wave * 64 + qb * 32 + r32, h);
    if (DK == 96) { if (J.rope_cos) {
      const float* cs = J.rope_cos + (J.qpos0 + wave * 64 + qb * 32 + r32) * 16 + 8 * h; const float* sn = J.rope_sin + (J.qpos0 + wave * 64 + qb * 32 + r32) * 16 + 8 * h;
#pragma unroll
      for (int j = 0; j < 8; ++j) { const float x1 = bf2f((unsigned short)qf[qb][NS - 2][j]), x2 = bf2f((unsigned short)qf[qb][NS - 1][j]); const float c = cs[j], s_ = sn[j];
        qf[qb][NS - 2][j] = (short)f2bf(x1 * c - x2 * s_); qf[qb][NS - 1][j] = (short)f2bf(x1 * s_ + x2 * c); } } }
  }
  const int nt0 = J.s0n >> 6, nt = nt0 + (J.s1n >> 6);
  const int srow = tid >> 3, sch = tid & 7; const int s2row = (tid >> 2) & 63, s2ch = tid & 3;
  u32x4 rk, rv, rk2;
  auto tile_row = [&](int t) -> int { return t < nt0 ? J.s0row + 64 * t : J.s1row + 64 * (t - nt0); };
  auto gload = [&](int t) { const int kr0 = tile_row(t);
    rk = *(const u32x4*)(J.K1 + (size_t)(kr0 + srow) * J.k1p + sch * 8);
    rv = *(const u32x4*)(J.V + (size_t)(kr0 + srow) * J.vp + sch * 8);
    if (DK == 96) { if (tid < 256) rk2 = *(const u32x4*)(J.K2 + (size_t)(kr0 + s2row) * J.k2p + s2ch * 8); } };
  auto lstore = [&](int b) {
    *(LAS u32x4*)(Kl + b * KBUF + srow * KP + sch * 16) = rk;
    *(LAS u32x4*)(Vl + b * VBUF + srow * VP + sch * 16) = rv;
    if (DK == 96) { if (tid < 256) *(LAS u32x4*)(Kl + b * KBUF + s2row * KP + 128 + s2ch * 16) = rk2; } };
  gload(0); lstore(0); __syncthreads();
  float m[2] = {0.f, 0.f}, lsum[2] = {0.f, 0.f}; f32x16 O[2][2];
#pragma unroll
  for (int qb = 0; qb < 2; ++qb) { O[qb][0] = (f32x16){}; O[qb][1] = (f32x16){}; }
  const int q4 = (lane & 15) >> 2, p4 = lane & 3, blk = (lane >> 4) & 1;
  const int qmin = J.qpos0 + wave * 64;
  for (int t = 0; t < nt; ++t) {
    if (t + 1 < nt) gload(t + 1);
    const LAS unsigned char* Kb = Kl + (t & 1) * KBUF; const LAS unsigned char* Vb = Vl + (t & 1) * VBUF;
    bool active = true; int kp0 = 0;
    if (J.win && t >= nt0) { kp0 = J.s1pos0 + 64 * (t - nt0); active = (kp0 + 63 >= qmin - 128) && (kp0 <= qmin + 63 + 128); }
    if (active) {
    f32x16 S[2][2];
#pragma unroll
    for (int qb = 0; qb < 2; ++qb)
#pragma unroll
      for (int i = 0; i < 16; ++i) { S[qb][0][i] = -m[qb]; S[qb][1][i] = -m[qb]; }
#pragma unroll
    for (int s = 0; s < NS; ++s) {
      const bf16x8 k0 = *(const LAS bf16x8*)(Kb + r32 * KP + (16 * s + 8 * h) * 2);
      const bf16x8 k1 = *(const LAS bf16x8*)(Kb + (32 + r32) * KP + (16 * s + 8 * h) * 2);
#pragma unroll
      for (int qb = 0; qb < 2; ++qb) { S[qb][0] = MFMA32(k0, qf[qb][s], S[qb][0]); S[qb][1] = MFMA32(k1, qf[qb][s], S[qb][1]); }
    }
    if (J.win && t >= nt0) {
#pragma unroll
      for (int qb = 0; qb < 2; ++qb) { const int qpos = qmin + qb * 32 + r32;
#pragma unroll
        for (int i = 0; i < 16; ++i) { const int kpos = kp0 + crow(i, h); const int d0 = qpos - kpos, d1 = d0 - 32;
          if (d0 > 128 || d0 < -128) S[qb][0][i] = -1e30f; if (d1 > 128 || d1 < -128) S[qb][1][i] = -1e30f; } }
    }
#pragma unroll
    for (int qb = 0; qb < 2; ++qb) {
      float mx = fmaxf(S[qb][0][0], S[qb][1][0]);
#pragma unroll
      for (int i = 1; i < 16; ++i) mx = fmaxf(mx, fmaxf(S[qb][0][i], S[qb][1][i]));
      mx = fmaxf(mx, __shfl_xor(mx, 32));
      if (__any(mx > 6.0f)) {
        const float dl = fmaxf(mx, 0.f); m[qb] += dl; const float alpha = __builtin_amdgcn_exp2f(-dl); lsum[qb] *= alpha;
#pragma unroll
        for (int i = 0; i < 16; ++i) { S[qb][0][i] -= dl; S[qb][1][i] -= dl; O[qb][0][i] *= alpha; O[qb][1][i] *= alpha; }
      }
      float ps = 0.f;
#pragma unroll
      for (int i = 0; i < 16; ++i) { S[qb][0][i] = __builtin_amdgcn_exp2f(S[qb][0][i]); S[qb][1][i] = __builtin_amdgcn_exp2f(S[qb][1][i]); ps += S[qb][0][i] + S[qb][1][i]; }
      lsum[qb] += ps;
    }
#pragma unroll
    for (int kb = 0; kb < 2; ++kb)
#pragma unroll
      for (int s2 = 0; s2 < 2; ++s2) {
        const LAS unsigned char* vb = Vb + (kb * 32 + 16 * s2 + 4 * h + q4) * VP + (blk * 16 + 4 * p4) * 2;
        const s16x4 lo0 = vtr(vb), hi0 = vtr(vb + 8 * VP), lo1 = vtr(vb + 64), hi1 = vtr(vb + 64 + 8 * VP);
        const bf16x8 vf0 = __builtin_shufflevector(lo0, hi0, 0, 1, 2, 3, 4, 5, 6, 7), vf1 = __builtin_shufflevector(lo1, hi1, 0, 1, 2, 3, 4, 5, 6, 7);
#pragma unroll
        for (int qb = 0; qb < 2; ++qb) {
          u32x4 pw; pw.x = pk2(S[qb][kb][8 * s2 + 0], S[qb][kb][8 * s2 + 1]); pw.y = pk2(S[qb][kb][8 * s2 + 2], S[qb][kb][8 * s2 + 3]);
          pw.z = pk2(S[qb][kb][8 * s2 + 4], S[qb][kb][8 * s2 + 5]); pw.w = pk2(S[qb][kb][8 * s2 + 6], S[qb][kb][8 * s2 + 7]);
          const bf16x8 pf = __builtin_bit_cast(bf16x8, pw);
          O[qb][0] = MFMA32(vf0, pf, O[qb][0]); O[qb][1] = MFMA32(vf1, pf, O[qb][1]);
        }
      }
    }
    if (t + 1 < nt) lstore((t + 1) & 1);
    __syncthreads();
  }
#pragma unroll
  for (int qb = 0; qb < 2; ++qb) {
    float l = lsum[qb]; l += __shfl_xor(l, 32); if (J.has_sink) l += __builtin_amdgcn_exp2f(J.sink2 - m[qb]); const float inv = 1.f / l;
    bf16_t* orow = J.O + (size_t)(wave * 64 + qb * 32 + r32) * J.op;
#pragma unroll
    for (int g = 0; g < 4; ++g) {
      u32x2 w0, w1; w0.x = pk2(O[qb][0][4 * g] * inv, O[qb][0][4 * g + 1] * inv); w0.y = pk2(O[qb][0][4 * g + 2] * inv, O[qb][0][4 * g + 3] * inv);
      w1.x = pk2(O[qb][1][4 * g] * inv, O[qb][1][4 * g + 1] * inv); w1.y = pk2(O[qb][1][4 * g + 2] * inv, O[qb][1][4 * g + 3] * inv);
      *(u32x2*)(orow + 8 * g + 4 * h) = w0; *(u32x2*)(orow + 32 + 8 * g + 4 * h) = w1;
    }
  }
}

DI void phase_attn_even(const Params& p, LAS unsigned char* lds) {
  const bf16_t* H = (const bf16_t*)(p.ws + WS_H); const bf16_t* QB = (const bf16_t*)(p.ws + WS_QB); const bf16_t* KVB = (const bf16_t*)(p.ws + WS_KVB); bf16_t* Y = (bf16_t*)(p.ws + WS_Y);
  for (int u = blockIdx.x; u < 1280; u += gridDim.x) {
    AttnJob J; J.win = 0; J.qpos0 = 0; J.s1pos0 = 0; J.sink2 = 0.f; J.has_sink = 0; J.rope_cos = nullptr; J.rope_sin = nullptr;
    J.qg = p.ev_qa_g; J.cosh = (const float*)(p.ws + WS_TAB); J.sinh = J.cosh + 2048 * 32; J.qscale = 0.125f * LOG2E; J.q_rope = 0;
    int typeB, b, head, qrow0, s1n; const bool big = u < 1024; J.q_rope = big ? 1 : 0;
    if (big) { typeB = u >> 9; const int v = u & 511; b = v >> 5; head = (v >> 2) & 7; qrow0 = b * SEQ + (v & 3) * 512; s1n = SEQ; J.qpos0 = (v & 3) * 512;
      J.rope_cos = (const float*)(p.ws + WS_TAB) + 2 * 2048 * 32; J.rope_sin = J.rope_cos + 2048 * 16; }
    else { const int v = u - 1024; typeB = v >> 7; b = (v & 127) >> 3; head = v & 7; qrow0 = ML + b * CTX; s1n = 0; }
    J.s0row = ML + b * CTX; J.s0n = CTX; J.s1row = b * SEQ; J.s1n = s1n;
    if (!typeB) {
      J.Q = H + (size_t)qrow0 * EV_PITCH + head * 64; J.qp = EV_PITCH;
      J.K1 = H + 512 + (head >> 2) * 64; J.k1p = EV_PITCH; J.K2 = nullptr; J.k2p = 0;
      J.V = H + 640 + (head >> 2) * 64; J.vp = EV_PITCH;
      J.O = Y + (size_t)qrow0 * DM + head * 64; J.op = DM;
      if (big) attn_unit2<64>(J, lds); else attn_unit<64>(J, lds);
    } else {
      J.Q = QB + (size_t)qrow0 * 1792 + head * 96; J.qp = 1792;
      J.K1 = QB + 768 + head * 128; J.k1p = 1792; J.K2 = H + 1152; J.k2p = EV_PITCH;
      J.V = QB + 768 + head * 128 + 64; J.vp = 1792;
      J.O = Y + (size_t)qrow0 * DM + 512 + head * 64; J.op = DM;
      if (big) attn_unit2<96>(J, lds); else attn_unit<96>(J, lds);
    }
  }
}
DI void phase_attn_odd(const Params& p, LAS unsigned char* lds) {
  const bf16_t* H = (const bf16_t*)(p.ws + WS_H); bf16_t* Y = (bf16_t*)(p.ws + WS_Y);
  for (int u = blockIdx.x; u < 512; u += gridDim.x) {
    const int b = u >> 5, head = (u >> 2) & 7, q0 = (u & 3) * 512, qrow0 = b * SEQ + q0;
    const int lo = q0 - 128 < 0 ? 0 : q0 - 128, hi = q0 + 640 > SEQ ? SEQ : q0 + 640;
    AttnJob J; J.rope_cos = nullptr; J.rope_sin = nullptr; J.qg = nullptr; J.cosh = (const float*)(p.ws + WS_TAB); J.sinh = J.cosh + 2048 * 32; J.qscale = 0.125f * LOG2E; J.q_rope = 1; J.win = 1; J.qpos0 = q0; J.s1pos0 = lo; J.sink2 = p.od_sink[head] * LOG2E; J.has_sink = 1;
    J.s0row = ML + b * CTX; J.s0n = CTX; J.s1row = b * SEQ + lo; J.s1n = hi - lo;
    J.Q = H + (size_t)qrow0 * OD_PITCH + 1024 + head * 64; J.qp = OD_PITCH;
    J.K1 = H + 1536 + (head >> 2) * 64; J.k1p = OD_PITCH; J.K2 = nullptr; J.k2p = 0;
    J.V = H + 1664 + (head >> 2) * 64; J.vp = OD_PITCH;
    J.O = Y + (size_t)qrow0 * DM + 512 + head * 64; J.op = DM;
    attn_unit2<64>(J, lds);
  }
}
DI void phase_sgu(const Params& p, LAS unsigned char* lds) {
  constexpr int RP = 1040;
  const bf16_t* H = (const bf16_t*)(p.ws + WS_H); bf16_t* Y = (bf16_t*)(p.ws + WS_Y);
  const int tid = opaque_tid(), lane = tid & 63, g = tid >> 6, r32 = lane & 31, h = lane >> 5;
  const int q4 = (lane & 15) >> 2, p4 = lane & 3, blk = (lane >> 4) & 1;
  for (int u = blockIdx.x; u < 256; u += gridDim.x) {
    const int row0 = (u >> 4) * SEQ + (u & 15) * 128;
    __syncthreads();
    for (int i = tid; i < 128 * 64; i += NT) { const int r = i >> 6, ch = i & 63;
      *(LAS u32x4*)(lds + r * RP + ch * 16) = *(const u32x4*)(H + (size_t)(row0 + r) * OD_PITCH + 512 + ch * 8); }
    __syncthreads();
    f32x16 acc[4][2];
#pragma unroll
    for (int a = 0; a < 4; ++a) { acc[a][0] = (f32x16){}; acc[a][1] = (f32x16){}; }
    const float* wg = p.od_sgu_w + (size_t)g * 128 * 128;
#pragma unroll 1
    for (int s = 0; s < 8; ++s) {
      const LAS unsigned char* vb = lds + (16 * s + 4 * h + q4) * RP + (g * 64 + blk * 16 + 4 * p4) * 2;
      const s16x4 l0 = vtr(vb), h0 = vtr(vb + 8 * RP), l1 = vtr(vb + 64), h1 = vtr(vb + 64 + 8 * RP);
      const bf16x8 vf0 = __builtin_shufflevector(l0, h0, 0, 1, 2, 3, 4, 5, 6, 7), vf1 = __builtin_shufflevector(l1, h1, 0, 1, 2, 3, 4, 5, 6, 7);
#pragma unroll
      for (int pb = 0; pb < 4; ++pb) {
        const float* wp = wg + (size_t)(pb * 32 + r32) * 128 + 16 * s + 4 * h;
        const f32x4 w0 = *(const f32x4*)wp, w1 = *(const f32x4*)(wp + 8);
        u32x4 pw; pw.x = pk2(w0.x, w0.y); pw.y = pk2(w0.z, w0.w); pw.z = pk2(w1.x, w1.y); pw.w = pk2(w1.z, w1.w);
        const bf16x8 wf = __builtin_bit_cast(bf16x8, pw);
        acc[pb][0] = MFMA32(vf0, wf, acc[pb][0]); acc[pb][1] = MFMA32(vf1, wf, acc[pb][1]);
      }
    }
#pragma unroll
    for (int pb = 0; pb < 4; ++pb) {
      const int pp = pb * 32 + r32; const float bs = p.od_sgu_b[g * 128 + pp];
      const bf16_t* ur = H + (size_t)(row0 + pp) * OD_PITCH + g * 64; bf16_t* yr = Y + (size_t)(row0 + pp) * DM + g * 64;
#pragma unroll
      for (int db = 0; db < 2; ++db)
#pragma unroll
        for (int g4 = 0; g4 < 4; ++g4) { const int d0 = db * 32 + 8 * g4 + 4 * h;
          const u32x2 uu = *(const u32x2*)(ur + d0);
          const float y0 = geluf_(bflo(uu.x)) * (acc[pb][db][4 * g4] + bs), y1 = geluf_(bfhi(uu.x)) * (acc[pb][db][4 * g4 + 1] + bs);
          const float y2 = geluf_(bflo(uu.y)) * (acc[pb][db][4 * g4 + 2] + bs), y3 = geluf_(bfhi(uu.y)) * (acc[pb][db][4 * g4 + 3] + bs);
          u32x2 w; w.x = pk2(y0, y1); w.y = pk2(y2, y3); *(u32x2*)(yr + d0) = w; }
    }
  }
  __syncthreads();
}

#define GAS __attribute__((address_space(1)))
#define XB_TMO      128
#define XB_XCNT(j)  (256  + 64 * (j))
#define XB_XSUB(j)  (1280 + 64 * (j))
#define XB_XGEN(j)  (2304 + 64 * (j))
#define XB_TOP      3328
#define XB_TOPGEN   3392
#define XCD_BAR_WORDS 3456
#define XB_SPIN_CAP (1u << 18)

__device__ __forceinline__ unsigned xb_ld(unsigned* p)              { return __hip_atomic_load(p, __ATOMIC_RELAXED, __HIP_MEMORY_SCOPE_AGENT); }
__device__ __forceinline__ unsigned xb_add(unsigned* p, unsigned v) { return __hip_atomic_fetch_add(p, v, __ATOMIC_RELAXED, __HIP_MEMORY_SCOPE_AGENT); }
__device__ __forceinline__ unsigned xb_xcc_id() { return (unsigned)__builtin_amdgcn_s_getreg((3 << 11) | 20) & 0xFu; }
#define XB_SPIN(cond, bar) do { unsigned _sp = 0; while (cond) { __builtin_amdgcn_s_sleep(1); \
    if ((++_sp & 255u) == 0u) { if (xb_ld(&(bar)[XB_TMO])) break; if (_sp > XB_SPIN_CAP) { atomicAdd(&(bar)[XB_TMO], 1u); break; } } } } while (0)

struct XcdBarrier {
    unsigned* bar; unsigned x;
    volatile LAS unsigned* st;
};

__device__ __forceinline__ XcdBarrier xcd_barrier_post(unsigned* bar, volatile LAS unsigned* st) {
    XcdBarrier b; b.bar = bar; b.x = xb_xcc_id(); b.st = st;
    if (threadIdx.x == 0) (void)xb_add(&bar[XB_XCNT(b.x)], 1u);
    return b;
}
__device__ __forceinline__ void xcd_barrier_complete(unsigned* bar, unsigned x, unsigned& nloc, unsigned& nx) {
    const unsigned G = gridDim.x * gridDim.y * gridDim.z;
    unsigned sum, cnt, mine, sp = 0u;
    for (;;) {
        sum = 0u; cnt = 0u; mine = 0u;
#pragma unroll
        for (unsigned j = 0; j < 16; ++j) { const unsigned c = xb_ld(&bar[XB_XCNT(j)]); sum += c; cnt += (c > 0u) ? 1u : 0u; mine = (j == x) ? c : mine; }
        if (sum == G) break;
        __builtin_amdgcn_s_sleep(1);
        if ((++sp & 255u) == 0u) { if (xb_ld(&bar[XB_TMO])) break; if (sp > XB_SPIN_CAP) { atomicAdd(&bar[XB_TMO], 1u); break; } }
    }
    nloc = mine > 0u ? mine : 1u; nx = cnt > 0u ? cnt : 1u;
}

__device__ __forceinline__ void xcd_barrier(const XcdBarrier& b) {
    asm volatile("s_waitcnt vmcnt(0)" ::: "memory");
    __syncthreads();
    if (threadIdx.x == 0) {
        unsigned* bar = b.bar;
        __builtin_amdgcn_s_waitcnt(0);
        unsigned nloc = b.st[0], nx = b.st[1];
        if (nloc == 0u) { xcd_barrier_complete(bar, b.x, nloc, nx); b.st[0] = nloc; b.st[1] = nx; }
        const unsigned old = xb_add(&bar[XB_XSUB(b.x)], 1u);
        const unsigned gen = old / nloc;
        if (old + 1u == (gen + 1u) * nloc) {
            __builtin_amdgcn_fence(__ATOMIC_RELEASE, "agent");
            asm volatile("s_waitcnt vmcnt(0)" ::: "memory");
            const unsigned og = xb_add(&bar[XB_TOP], 1u);
            const unsigned tg = og / nx;
            if (og + 1u == (tg + 1u) * nx) xb_add(&bar[XB_TOPGEN], 1u);
            else XB_SPIN(xb_ld(&bar[XB_TOPGEN]) == tg, bar);
            __builtin_amdgcn_fence(__ATOMIC_ACQUIRE, "agent");
            xb_add(&bar[XB_XGEN(b.x)], 1u);
            asm volatile("s_waitcnt vmcnt(0)" ::: "memory");
        } else {
            XB_SPIN(xb_ld(&bar[XB_XGEN(b.x)]) == gen, bar);
            __builtin_amdgcn_fence(__ATOMIC_ACQUIRE, "agent");
            asm volatile("s_waitcnt vmcnt(0)" ::: "memory");
        }
    }
    __syncthreads();
}

constexpr size_t WS_BAR = 1 * MiB + 832 * 1024;
constexpr int LDS_BARST = 143360;

constexpr int LDS_BYTES = 147456;
#define GSYNC() do { XcdBarrier xb_; xb_.bar = (unsigned*)(ws_bar); xb_.x = xb_xcc_id(); xb_.st = (volatile LAS unsigned*)(lds + LDS_BARST); xcd_barrier(xb_); } while (0)
struct OdinOrder {
  pg8::StaticOrder S; int G, c;
  DI void init(int G_, int c_) { S.init(ML, OD_PITCH, G_, c_); G = G_; c = c_; }
  DI bool next(int i, pg8::Unit& u) const { const int L = i * G + c; if (L < 896) return S.next(i, u); if (L >= 912) return false; u.pm = 128 + (L - 896); u.pn = 6; return true; }
  DI void a_ready(const pg8::Unit&) const {}
  DI void done(const pg8::Unit&) const {}
};
template <class Epi> DI void run_gemm(LAS unsigned char* lds, const bf16_t* A, int lda, const bf16_t* Bt, int ldb, int M, int N, int K, const Epi& E) {
  pg8::Gemm g{A, Bt, M, N, K, lda, ldb}; pg8::StaticOrder S; S.init(M, N, (int)gridDim.x, (int)blockIdx.x);
  pg8::gemm_phase<Epi, pg8::StaticOrder, true, true>(lds, g, S, E);
}

typedef const unsigned long long __attribute__((address_space(4)))* kargp_t;
DI Params load_params(kargp_t q) { asm volatile("" : "+s"(q)); Params r; unsigned long long* d = (unsigned long long*)&r;
#pragma unroll
  for (int i = 0; i < 30; ++i) d[i] = q[i];
  return r; }
#define PH_BEGIN { const Params p = load_params(kp); unsigned char* ws = p.ws; (void)ws;
#ifdef PROBE_A
#define TSL ((LAS unsigned long long*)(lds + 143360))
#define PH_END } GSYNC(); if (blockIdx.x == 0 && threadIdx.x == 0) { const unsigned long long now_ = __builtin_amdgcn_s_memrealtime(); if (ph_id == PROBE_A) TSL[0] = now_; if (ph_id == PROBE_B) TSL[1] = now_; if (ph_id == PROBE_C) TSL[2] = now_; if (ph_id == PROBE_D) TSL[3] = now_; } ++ph_id;
#else
#define PH_END } GSYNC();
#endif
#define WSP(T, off) ((T*)(ws + (off)))
typedef pg8::EpiBf16<0> EB;

__global__ void __launch_bounds__(NT, 2) fwd_kernel(Params p_unused) {
  extern __shared__ __attribute__((aligned(16))) unsigned char lds_raw[];
  LAS unsigned char* lds = (LAS unsigned char*)lds_raw;
  cg::grid_group grid = cg::this_grid();
  const kargp_t kp = (kargp_t)__builtin_amdgcn_kernarg_segment_ptr();
  constexpr size_t MOD1 = WS_MOD + (size_t)17 * 6144 * 4;
#ifdef PROBE_A
  int ph_id = 0; if (blockIdx.x == 0 && threadIdx.x == 0) { const unsigned long long now_ = __builtin_amdgcn_s_memrealtime(); TSL[0] = now_; TSL[1] = now_; TSL[2] = now_; TSL[3] = now_; }
#endif

  unsigned* ws_bar;
  { const Params p = load_params(kp); ws_bar = (unsigned*)(p.ws + WS_BAR);
    if (threadIdx.x < 2) ((LAS unsigned*)(lds + LDS_BARST))[threadIdx.x] = 0u;
    __syncthreads();
    (void)xcd_barrier_post(ws_bar, (volatile LAS unsigned*)(lds + LDS_BARST));
    phase_prologue(p, lds); }
  grid.sync();
  PH_BEGIN phase_norm_mod(p.x, p.ctx, p.norm1_g, WSP(const float, WS_MOD), 0, 1, WSP(bf16_t, WS_Z), 0, MT); PH_END
  PH_BEGIN run_gemm(lds, WSP(const bf16_t, WS_Z), DM, WSP(const bf16_t, WS_W_EVIN), DM, MT, EV_PITCH, DM, EB{WSP(bf16_t, WS_H), EV_PITCH, nullptr, 0, 0, 1.f}); PH_END
  PH_BEGIN phase_post_even(p); PH_END
  PH_BEGIN run_gemm(lds, WSP(const bf16_t, WS_H) + 768, EV_PITCH, WSP(const bf16_t, WS_W_QUP), 384, MT, 1792, 384, EB{WSP(bf16_t, WS_QB), 1792, nullptr, 768, 768, 0.10206207261596577f * LOG2E}); PH_END
  PH_BEGIN phase_attn_even(p, lds); PH_END
  PH_BEGIN run_gemm(lds, WSP(const bf16_t, WS_Y), DM, WSP(const bf16_t, WS_W_EVOUT), DM, ML, DM, DM, EpiRes{p.x, p.ctx, p.out, WSP(float, WS_HC), WSP(const float, WS_MOD) + 2 * 1024, 0, nullptr}); PH_END
  PH_BEGIN
    if (blockIdx.x < 64) { pg8::Gemm g{WSP(const bf16_t, WS_Y) + (size_t)ML * DM, WSP(const bf16_t, WS_W_EVOUT), MC, DM, DM, DM, DM}; pg8::StaticOrder S; S.init(MC, DM, 64, (int)blockIdx.x);
      pg8::gemm_phase<EpiRes, pg8::StaticOrder, true, true>(lds, g, S, EpiRes{p.x, p.ctx, p.out, WSP(float, WS_HC), WSP(const float, WS_MOD) + 2 * 1024, ML, nullptr}); }
    else phase_norm_mod(p.out, WSP(const float, WS_HC), p.norm2_g, WSP(const float, WS_MOD), 3, 4, WSP(bf16_t, WS_Z), 0, ML, 64, (int)gridDim.x - 64);
  PH_END
  PH_BEGIN phase_norm_mod(p.out, WSP(const float, WS_HC), p.norm2_g, WSP(const float, WS_MOD), 3, 4, WSP(bf16_t, WS_Z), ML, MT); PH_END
  PH_BEGIN run_gemm(lds, WSP(const bf16_t, WS_Z), DM, WSP(const bf16_t, WS_W_UP), DM, MT, FF2, DM, EpiConv{WSP(bf16_t, WS_ACT), WSP(float, WS_HALO), p.ffn_conv_w, p.ffn_conv_b, (LAS float*)(lds + 131072)}); PH_END
  PH_BEGIN { pg8::StaticOrder S; S.init(ML, DM, (int)gridDim.x, (int)blockIdx.x); conv_fix_my_tiles(S, 0, WSP(const float, WS_HALO), WSP(bf16_t, WS_ACT), p.ffn_conv_w, p.ffn_conv_b); }
    run_gemm(lds, WSP(const bf16_t, WS_ACT), FF, WSP(const bf16_t, WS_W_DOWN), FF, ML, DM, FF, EpiRes{p.out, WSP(const float, WS_HC), p.out, WSP(float, WS_HC), WSP(const float, WS_MOD) + 5 * 1024, 0, nullptr}); PH_END
  PH_BEGIN
    if (blockIdx.x < 64) { pg8::Gemm g{WSP(const bf16_t, WS_ACT) + (size_t)ML * FF, WSP(const bf16_t, WS_W_DOWN), MC, DM, FF, FF, FF}; pg8::StaticOrder S; S.init(MC, DM, 64, (int)blockIdx.x);
      conv_fix_my_tiles(S, 128, WSP(const float, WS_HALO), WSP(bf16_t, WS_ACT), p.ffn_conv_w, p.ffn_conv_b);
      pg8::gemm_phase<EpiRes, pg8::StaticOrder, true, true>(lds, g, S, EpiRes{p.out, WSP(const float, WS_HC), p.out, WSP(float, WS_HC), WSP(const float, WS_MOD) + 5 * 1024, ML, nullptr}); }
    else phase_norm_mod(p.out, WSP(const float, WS_HC), p.norm1_g + DM, WSP(const float, MOD1), 0, 1, WSP(bf16_t, WS_Z), 0, ML, 64, (int)gridDim.x - 64);
  PH_END
  PH_BEGIN phase_norm_mod(p.out, WSP(const float, WS_HC), p.norm1_g + DM, WSP(const float, MOD1), 0, 1, WSP(bf16_t, WS_Z), ML, MT); PH_END
  PH_BEGIN { pg8::Gemm g{WSP(const bf16_t, WS_Z), WSP(const bf16_t, WS_W_ODIN), MT, OD_PITCH, DM, DM, DM}; OdinOrder S; S.init((int)gridDim.x, (int)blockIdx.x);
    pg8::gemm_phase<EB, OdinOrder, true, true>(lds, g, S, EB{WSP(bf16_t, WS_H), OD_PITCH, nullptr, 0, 0, 1.f}); } PH_END
  PH_BEGIN phase_post_odd(p); PH_END
  PH_BEGIN phase_sgu(p, lds); }
  PH_BEGIN phase_attn_odd(p, lds); PH_END
  PH_BEGIN run_gemm(lds, WSP(const bf16_t, WS_Y), DM, WSP(const bf16_t, WS_W_ODOUT), DM, ML, DM, DM, EpiRes{p.out, WSP(const float, WS_HC), p.out, WSP(float, WS_HC), WSP(const float, MOD1) + 2 * 1024, 0, nullptr}); PH_END
  PH_BEGIN phase_norm_mod(p.out, WSP(const float, WS_HC), p.norm2_g + DM, WSP(const float, MOD1), 3, 4, WSP(bf16_t, WS_Z), 0, ML); PH_END
  PH_BEGIN run_gemm(lds, WSP(const bf16_t, WS_Z), DM, WSP(const bf16_t, WS_W_UP) + (size_t)FF2 * DM, DM, ML, FF2, DM, EpiConv{WSP(bf16_t, WS_ACT), WSP(float, WS_HALO), p.ffn_conv_w + 3 * FF2, p.ffn_conv_b + FF2, (LAS float*)(lds + 131072)}); PH_END
  PH_BEGIN { pg8::StaticOrder S; S.init(ML, DM, (int)gridDim.x, (int)blockIdx.x); conv_fix_my_tiles(S, 0, WSP(const float, WS_HALO), WSP(bf16_t, WS_ACT), p.ffn_conv_w + 3 * FF2, p.ffn_conv_b + FF2); }
    run_gemm(lds, WSP(const bf16_t, WS_ACT), FF, WSP(const bf16_t, WS_W_DOWN) + (size_t)DM * FF, FF, ML, DM, FF, EpiResT<true>{p.out, WSP(const float, WS_HC), p.out, WSP(float, WS_HC), WSP(const float, MOD1) + 5 * 1024, 0, WSP(bf16_t, WS_Z)}); PH_END
  { const Params p = load_params(kp); phase_final_norm_bf((const bf16_t*)(p.ws + WS_Z), p.out, p.final_g); }
#ifdef PROBE_A
  { const Params p = load_params(kp); float* slot = (float*)(p.ws + WS_TAB + 900 * 1024);
    if (blockIdx.x == 0 && threadIdx.x == 0) { slot[0] = (float)(TSL[3] - TSL[2]) * 1e-4f; slot[1] = (float)(TSL[1] - TSL[0]) * 1e-4f; }
    GSYNC();
    const float d = *slot;
    for (int i = blockIdx.x * NT + threadIdx.x; i < (1 << 20); i += gridDim.x * NT) p.out[i] += (i == 0) ? slot[1] : d; }
#endif
}

extern "C" void kernel_launch(void* const* d_in, const int* in_sizes, int n_in, void* d_out, int out_size, void* d_ws, size_t ws_size, hipStream_t stream) {
  static int grid = 0;
  if (grid == 0) {
    int dev = 0, cus = 0, per_cu = 0;
    hipGetDevice(&dev); hipDeviceGetAttribute(&cus, hipDeviceAttributeMultiprocessorCount, dev);
    hipFuncSetAttribute((const void*)fwd_kernel, hipFuncAttributeMaxDynamicSharedMemorySize, LDS_BYTES);
    if (hipOccupancyMaxActiveBlocksPerMultiprocessor(&per_cu, (const void*)fwd_kernel, NT, LDS_BYTES) != hipSuccess || per_cu < 1) per_cu = 1;
    (void)hipGetLastError();
    if (cus <= 0) cus = 256;
    grid = cus;
  }
  Params p{};
  const float** f = (const float**)&p;
  for (int i = 0; i < 28; ++i) f[i] = (const float*)d_in[i];
  p.out = (float*)d_out; p.ws = (unsigned char*)d_ws;
  (void)hipMemsetAsync((unsigned char*)d_ws + WS_BAR, 0, XCD_BAR_WORDS * 4, stream);
  void* args[] = {&p};
  hipError_t e = hipLaunchCooperativeKernel((const void*)fwd_kernel, dim3(grid), dim3(NT), args, LDS_BYTES, stream);
  if (e != hipSuccess) fprintf(stderr, "cooperative launch failed: %s (grid %d)\n", hipGetErrorString(e), grid);
}
```

```cpp
#include <hip/hip_runtime.h>
#include <hip/hip_cooperative_groups.h>
#include <cstdio>
#include <cstdint>
namespace cg = cooperative_groups;
namespace pg8 {
#define PG8_LAS __attribute__((address_space(3)))
typedef unsigned short bf16_t;
typedef short bf16x8 __attribute__((ext_vector_type(8)));
typedef float f32x4 __attribute__((ext_vector_type(4)));
typedef unsigned u32x4 __attribute__((ext_vector_type(4)));
constexpr int BM = 256, BK = 64, HALF = 128, HTB = HALF * BK * 2  , STAGE_BYTES = 8 * HTB, NXCD = 8, WGM = 8;

__host__ __device__ __forceinline__ int lds_byte(int r, int c) { const int st = (r >> 4) * 2 + (c >> 5), rr = r & 15, cc = c & 31, ob = rr * 64 + cc * 2; return st * 1024 + (ob ^ (((ob >> 9) & 1) << 5)); }
__host__ __device__ __forceinline__ void stage_rc(int b, int& R, int& C) { const int st = b / 1024, sb = b % 1024, swz = sb ^ (((sb >> 9) & 1) << 5); R = (st >> 1) * 16 + swz / 64; C = (st & 1) * 32 + (swz % 64) / 2; }
__host__ __device__ __forceinline__ int perm32(int rho) { const int n = rho >> 4, i = rho & 15; return 8 * (i >> 2) + 4 * n + (i & 3); }

struct Unit { int pm, pn; };
struct Gemm { const bf16_t* A; const bf16_t* Bt; int M, N, K, lda, ldb; };

struct StaticOrder {
    int nM, nN, nwg, G, c;
    __host__ __device__ void init(int M, int N, int G_, int c_) { nM = M / BM; nN = N / BM; nwg = nM * nN; G = G_; c = c_; }
    __host__ __device__ bool next(int i, Unit& u) const {
        const long L = (long)i * G + c; if (L >= nwg) return false;
        int wgid = (int)L; { const int q = nwg / NXCD, r = nwg % NXCD, xcd = wgid % NXCD, off = wgid / NXCD; wgid = (xcd < r ? xcd * (q + 1) : r * (q + 1) + (xcd - r) * q) + off; }
        const int nig = WGM * nN, gid = wgid / nig, fm = gid * WGM, gsz = (nM - fm) < WGM ? (nM - fm) : WGM;
        u.pm = fm + ((wgid % nig) % gsz); u.pn = (wgid % nig) / gsz; return true;
    }
    __device__ __forceinline__ void a_ready(const Unit&) const {}
    __device__ __forceinline__ void done(const Unit&) const {}
};

__device__ __forceinline__ unsigned cvt_pk_bf16(float lo, float hi) { unsigned r; asm volatile("v_cvt_pk_bf16_f32 %0, %1, %2" : "=v"(r) : "v"(lo), "v"(hi)); return r; }
typedef float f32x2 __attribute__((ext_vector_type(2)));
__device__ __forceinline__ f32x2 gelu_pk(f32x2 v) {
    const f32x2 av = __builtin_elementwise_abs(v), d = av * 0.2316418882f + 1.0f;
    f32x2 t; t.x = __builtin_amdgcn_rcpf(d.x); t.y = __builtin_amdgcn_rcpf(d.y);
    f32x2 q = t * 0.5307027145f + (-0.7265760135f); q = q * t + 0.7107068705f; q = q * t + (-0.142248368f); q = q * t + 0.127414796f; q = q * t;
    const f32x2 s = (v * v) * (-0.72134752044f);
    f32x2 e; e.x = __builtin_amdgcn_exp2f(s.x); e.y = __builtin_amdgcn_exp2f(s.y);
    const f32x2 m = v * (q * e), r = v - m;
    f32x2 o; o.x = v.x < 0.f ? m.x : r.x; o.y = v.y < 0.f ? m.y : r.y; return o;
}

template <int ACT  > struct EpiBf16 {
    static constexpr bool PERM = true, AFTER_DRAIN = false; static_assert(ACT == 0 || ACT == 1, "EpiBf16: ACT is 0 (none) or 1 (gelu_pk)");
    bf16_t* O; int ldc; const float* bias; int split_cols; size_t split_stride; float scale0;
    __device__ __forceinline__ void operator()(const f32x4 (&acc)[2][2][4][2], const Unit& u, int wr, int wc, int fr, int fq) const {
        const int row0 = u.pm * BM + wr * 64 + fr; int colt = u.pn * BM; bf16_t* base = O;
        float sc = 1.f; if (split_cols) { const int t = colt / split_cols; base += (size_t)t * split_stride; colt -= t * split_cols; if (t == 0) sc = scale0; }
        const int col0 = colt + wc * 32 + 8 * fq, bcol0 = u.pn * BM + wc * 32 + 8 * fq;
        f32x4 bv[2][2];
#pragma unroll
        for (int bj = 0; bj < 2; ++bj)
#pragma unroll
            for (int n = 0; n < 2; ++n) bv[bj][n] = bias ? *(const f32x4*)(bias + bcol0 + bj * HALF + 4 * n) : (f32x4){0.f, 0.f, 0.f, 0.f};
#pragma unroll
        for (int ai = 0; ai < 2; ++ai)
#pragma unroll
            for (int m = 0; m < 4; ++m) { bf16_t* rowp = base + (size_t)(row0 + ai * HALF + m * 16) * ldc + col0;
#pragma unroll
                for (int bj = 0; bj < 2; ++bj) { f32x4 v0 = acc[ai][bj][m][0] + bv[bj][0], v1 = acc[ai][bj][m][1] + bv[bj][1];
                    if (ACT == 1) { f32x2 a = gelu_pk((f32x2){v0[0], v0[1]}), b = gelu_pk((f32x2){v0[2], v0[3]}), c = gelu_pk((f32x2){v1[0], v1[1]}), d = gelu_pk((f32x2){v1[2], v1[3]});
                        v0 = (f32x4){a.x, a.y, b.x, b.y}; v1 = (f32x4){c.x, c.y, d.x, d.y}; }
                    v0 = v0 * sc; v1 = v1 * sc; u32x4 w; w.x = cvt_pk_bf16(v0[0], v0[1]); w.y = cvt_pk_bf16(v0[2], v0[3]); w.z = cvt_pk_bf16(v1[0], v1[1]); w.w = cvt_pk_bf16(v1[2], v1[3]);
                    *(u32x4*)(rowp + bj * HALF) = w; } }
    }
};
template <class Epi, class Sched, bool ALIGN_EPI = false, bool SP2 = false>
__device__ __forceinline__ void gemm_phase(PG8_LAS unsigned char* lds, const Gemm g, const Sched& S, const Epi& E) {
    int tid_ = threadIdx.x; asm volatile("" : "+v"(tid_));
    const int tid = tid_, wid = __builtin_amdgcn_readfirstlane(tid >> 6), lane = tid & 63, wr = wid >> 2, wc = wid & 3, fr = lane & 15, fq = lane >> 4;
    const int K = g.K, nt = K / BK;
    unsigned voffA[2], voffB[2];
#pragma unroll
    for (int i = 0; i < 2; ++i) { int R, C; stage_rc(tid * 16 + i * 8192, R, C); const int Rb = Epi::PERM ? ((R & ~31) + perm32(R & 31)) : R;
        voffA[i] = (unsigned)(R * g.lda + C) * 2u; voffB[i] = (unsigned)(Rb * g.ldb + C) * 2u; }
    const size_t kstep = (size_t)(BK * 2);
    const size_t hstepA = (size_t)HALF * g.lda * 2, hstepB = (size_t)HALF * g.ldb * 2;
    const size_t tstepA = 2 * hstepA, tstepB = 2 * hstepB;
    const unsigned ldsw = (unsigned)wid * 1024u;
    const int aoff = lds_byte(wr * 64 + fr, fq * 8), boff = lds_byte(wc * 32 + fr, fq * 8);
#define PG8_SA(b, h) (((b) * 2 + (h)) * HTB)
#define PG8_SB(b, h) ((4 + (b) * 2 + (h)) * HTB)
#define PG8_STAGE(bufoff, gbase, voff) do { _Pragma("unroll") for (int _i = 0; _i < 2; ++_i) \
        __builtin_amdgcn_global_load_lds((const unsigned*)((const char*)(gbase) + (voff)[_i]), (PG8_LAS unsigned*)(lds + (bufoff) + ldsw + _i * 8192), 16, 0, 0); } while (0)
#define PG8_LDA(dst, b, h) do { _Pragma("unroll") for (int m = 0; m < 4; ++m) _Pragma("unroll") for (int k = 0; k < 2; ++k) dst[m][k] = *(const PG8_LAS bf16x8*)(lds + PG8_SA(b, h) + aoff + m * 2048 + k * 1024); } while (0)
#define PG8_LDB(dst, b, h) do { _Pragma("unroll") for (int n = 0; n < 2; ++n) _Pragma("unroll") for (int k = 0; k < 2; ++k) dst[n][k] = *(const PG8_LAS bf16x8*)(lds + PG8_SB(b, h) + boff + n * 2048 + k * 1024); } while (0)
#define PG8_MMA(ai, bj, At, Bt) do { __builtin_amdgcn_s_setprio(1); _Pragma("unroll") for (int m = 0; m < 4; ++m) _Pragma("unroll") for (int n = 0; n < 2; ++n) _Pragma("unroll") for (int k = 0; k < 2; ++k) \
        acc[ai][bj][m][n] = __builtin_amdgcn_mfma_f32_16x16x32_bf16(Bt[n][k], At[m][k], acc[ai][bj][m][n], 0, 0, 0); __builtin_amdgcn_s_setprio(0); } while (0)
#define PG8_WAIT_V(n) asm volatile("s_waitcnt vmcnt(" #n ")" ::: "memory")
#define PG8_WAIT_L(n) asm volatile("s_waitcnt lgkmcnt(" #n ")" ::: "memory")
#define PG8_BAR __builtin_amdgcn_s_barrier()
#define PG8_SCHED __builtin_amdgcn_sched_barrier(0)
    Unit cur, nxt; int ui = 0;
    if (!S.next(0, cur)) return;
    f32x4 acc[2][2][4][2];
#pragma unroll
    for (int a = 0; a < 2; ++a)
#pragma unroll
        for (int b = 0; b < 2; ++b)
#pragma unroll
            for (int m = 0; m < 4; ++m)
#pragma unroll
                for (int n = 0; n < 2; ++n) acc[a][b][m][n] = (f32x4){0.f, 0.f, 0.f, 0.f};
    bf16x8 At[4][2], B0[2][2], B1[2][2];
    const char* cA = (const char*)g.A + (size_t)cur.pm * tstepA; const char* cB = (const char*)g.Bt + (size_t)cur.pn * tstepB;
    S.a_ready(cur);
    if constexpr (SP2) {
        PG8_STAGE(PG8_SB(0, 0), cB, voffB); PG8_STAGE(PG8_SB(0, 1), cB + hstepB, voffB); PG8_STAGE(PG8_SA(0, 0), cA, voffA); PG8_STAGE(PG8_SA(0, 1), cA + hstepA, voffA);
        if (wr == 1) PG8_BAR;
        PG8_WAIT_V(2); PG8_BAR;
        PG8_STAGE(PG8_SB(1, 0), cB + kstep, voffB); PG8_STAGE(PG8_SA(1, 0), cA + kstep, voffA); PG8_STAGE(PG8_SB(1, 1), cB + hstepB + kstep, voffB);
        PG8_WAIT_V(6); PG8_BAR;
    } else {
        PG8_STAGE(PG8_SB(0, 0), cB, voffB); PG8_STAGE(PG8_SA(0, 0), cA, voffA); PG8_STAGE(PG8_SB(0, 1), cB + hstepB, voffB); PG8_STAGE(PG8_SA(0, 1), cA + hstepA, voffA);
        if (wr == 1) PG8_BAR;
        PG8_WAIT_V(4); PG8_BAR;
        PG8_STAGE(PG8_SB(1, 0), cB + kstep, voffB); PG8_STAGE(PG8_SA(1, 0), cA + kstep, voffA); PG8_STAGE(PG8_SB(1, 1), cB + hstepB + kstep, voffB);
        PG8_WAIT_V(6); PG8_BAR;
    }
    for (;;) {
        const bool has_next = S.next(ui + 1, nxt);
        const char* nA = has_next ? (const char*)g.A + (size_t)nxt.pm * tstepA : cA; const char* nB = has_next ? (const char*)g.Bt + (size_t)nxt.pn * tstepB : cB;
        for (int t = 0; t < nt; t += 2) {
            const bool last = (t == nt - 2);
            const char* a1 = cA + (size_t)(t + 1) * kstep;
            const char* a2 = last ? nA : cA + (size_t)(t + 2) * kstep; const char* b2 = last ? nB : cB + (size_t)(t + 2) * kstep;
            const char* a3 = a2 + kstep; const char* b3 = b2 + kstep;
            if (last && has_next) S.a_ready(nxt);
            if constexpr (SP2) {
            PG8_LDB(B0, 0, 0); PG8_LDB(B1, 0, 1); PG8_SCHED; PG8_LDA(At, 0, 0); PG8_STAGE(PG8_SA(1, 1), a1 + hstepA, voffA);
            PG8_WAIT_V(8); PG8_WAIT_L(0); PG8_BAR; PG8_MMA(0, 0, At, B0); PG8_MMA(0, 1, At, B1); PG8_BAR; PG8_SCHED;
            PG8_LDA(At, 0, 1); PG8_STAGE(PG8_SB(0, 0), b2, voffB); PG8_STAGE(PG8_SB(0, 1), b2 + hstepB, voffB); PG8_STAGE(PG8_SA(0, 0), a2, voffA);
            PG8_WAIT_V(8); PG8_WAIT_L(0); PG8_BAR; PG8_MMA(1, 0, At, B0); PG8_MMA(1, 1, At, B1); PG8_BAR; PG8_SCHED;
            PG8_LDB(B0, 1, 0); PG8_LDB(B1, 1, 1); PG8_SCHED; PG8_LDA(At, 1, 0); PG8_STAGE(PG8_SA(0, 1), a2 + hstepA, voffA);
            PG8_WAIT_V(8); PG8_WAIT_L(0); PG8_BAR; PG8_MMA(0, 0, At, B0); PG8_MMA(0, 1, At, B1); PG8_BAR; PG8_SCHED;
            PG8_LDA(At, 1, 1); PG8_STAGE(PG8_SB(1, 0), b3, voffB); PG8_STAGE(PG8_SB(1, 1), b3 + hstepB, voffB); PG8_STAGE(PG8_SA(1, 0), a3, voffA);
            PG8_WAIT_V(8); PG8_WAIT_L(0); PG8_BAR; PG8_MMA(1, 0, At, B0); PG8_MMA(1, 1, At, B1); PG8_BAR; PG8_SCHED;
            } else {
            PG8_LDB(B0, 0, 0); PG8_SCHED; PG8_LDA(At, 0, 0); PG8_STAGE(PG8_SA(1, 1), a1 + hstepA, voffA);
            PG8_WAIT_L(8); PG8_BAR; PG8_WAIT_L(0); PG8_MMA(0, 0, At, B0); PG8_BAR; PG8_SCHED;
            PG8_LDB(B1, 0, 1); PG8_STAGE(PG8_SB(0, 0), b2, voffB);
            PG8_BAR; PG8_WAIT_L(0); PG8_MMA(0, 1, At, B1); PG8_BAR;
            PG8_LDA(At, 0, 1); PG8_STAGE(PG8_SA(0, 0), a2, voffA);
            PG8_BAR; PG8_WAIT_L(0); PG8_MMA(1, 0, At, B0); PG8_BAR; PG8_SCHED;
            PG8_STAGE(PG8_SB(0, 1), b2 + hstepB, voffB);
            PG8_WAIT_V(6); PG8_BAR; PG8_MMA(1, 1, At, B1); PG8_BAR;
            PG8_LDB(B0, 1, 0); PG8_SCHED; PG8_LDA(At, 1, 0); PG8_STAGE(PG8_SA(0, 1), a2 + hstepA, voffA);
            PG8_WAIT_L(8); PG8_BAR; PG8_WAIT_L(0); PG8_MMA(0, 0, At, B0); PG8_BAR; PG8_SCHED;
            PG8_LDB(B1, 1, 1); PG8_STAGE(PG8_SB(1, 0), b3, voffB);
            PG8_BAR; PG8_WAIT_L(0); PG8_MMA(0, 1, At, B1); PG8_BAR;
            PG8_LDA(At, 1, 1); PG8_STAGE(PG8_SA(1, 0), a3, voffA);
            PG8_BAR; PG8_WAIT_L(0); PG8_MMA(1, 0, At, B0); PG8_BAR; PG8_SCHED;
            PG8_STAGE(PG8_SB(1, 1), b3 + hstepB, voffB);
            PG8_WAIT_V(6); PG8_BAR; PG8_MMA(1, 1, At, B1); PG8_BAR;
            }
        }
        if constexpr (ALIGN_EPI) { if (wr == 0) PG8_BAR; }
        if constexpr (!Epi::AFTER_DRAIN) { E(acc, cur, wr, wc, fr, fq); S.done(cur); }
        if (!has_next) break;
#pragma unroll
        for (int a = 0; a < 2; ++a)
#pragma unroll
            for (int b = 0; b < 2; ++b)
#pragma unroll
                for (int m = 0; m < 4; ++m)
#pragma unroll
                    for (int n = 0; n < 2; ++n) acc[a][b][m][n] = (f32x4){0.f, 0.f, 0.f, 0.f};
        cur = nxt; cA = nA; cB = nB; ++ui;
        if constexpr (ALIGN_EPI) { if (wr == 1) PG8_BAR; }
    }
    PG8_WAIT_V(0);
    if constexpr (!ALIGN_EPI) { if (wr == 0) PG8_BAR; }
    PG8_BAR;
    if constexpr (Epi::AFTER_DRAIN) { E.fused(acc, cur, wr, wc, fr, fq, lds, wid, lane); S.done(cur); }
#undef PG8_SA
#undef PG8_SB
#undef PG8_STAGE
#undef PG8_LDA
#undef PG8_LDB
#undef PG8_MMA
#undef PG8_WAIT_V
#undef PG8_WAIT_L
#undef PG8_BAR
#undef PG8_SCHED
}
}

#define LAS __attribute__((address_space(3)))
#define DI __device__ __forceinline__
typedef unsigned short bf16_t;
typedef short bf16x8 __attribute__((ext_vector_type(8)));
typedef short s16x4 __attribute__((ext_vector_type(4)));
typedef float f32x4 __attribute__((ext_vector_type(4)));
typedef float f32x16 __attribute__((ext_vector_type(16)));
typedef unsigned u32x4 __attribute__((ext_vector_type(4)));
typedef unsigned u32x2 __attribute__((ext_vector_type(2)));
typedef float f32x2_t __attribute__((ext_vector_type(2)));
typedef __bf16 bf16x2_t __attribute__((ext_vector_type(2)));

constexpr int NB = 16, SEQ = 2048, DM = 1024, CTX = 256;
constexpr int ML = NB * SEQ;
constexpr int MC = NB * CTX;
constexpr int MT = ML + MC;
constexpr int FF = 2816, FF2 = 5632;
constexpr int EV_IN = 1184, EV_PITCH = 1280, OD_PITCH = 1792;
constexpr float EPS = 1e-6f;
constexpr float LOG2E = 1.4426950408889634f;
constexpr int NT = 512;

constexpr size_t MiB = 1u << 20;
constexpr size_t WS_MOD = 0;
constexpr size_t WS_TAB = 1 * MiB;
constexpr size_t WS_W_EVIN = 2 * MiB;
constexpr size_t WS_W_QUP = 5 * MiB;
constexpr size_t WS_W_KVUP = 6 * MiB;
constexpr size_t WS_W_EVOUT = 7 * MiB;
constexpr size_t WS_W_ODIN = 9 * MiB;
constexpr size_t WS_W_ODOUT = 13 * MiB;
constexpr size_t WS_W_UP = 15 * MiB;
constexpr size_t WS_W_DOWN = 37 * MiB;
constexpr size_t WS_HC = 48 * MiB;
constexpr size_t WS_Z = 64 * MiB;
constexpr size_t WS_BIG = 136 * MiB;
constexpr size_t WS_H = WS_BIG;
constexpr size_t WS_QB = WS_BIG + 126 * MiB;
constexpr size_t WS_KVB = WS_BIG + 180 * MiB;
constexpr size_t WS_Y = WS_BIG + 252 * MiB;
constexpr size_t WS_ACT = WS_BIG;
constexpr size_t WS_HALO = WS_BIG + 200 * MiB;

struct Params {
  const float *x, *c, *ctx, *c_ctx, *mod_w, *mod_b, *norm1_g, *norm2_g;
  const float *ev_w_in, *ev_qa_g, *ev_ka_g, *ev_qlat_g, *ev_w_q_up, *ev_kvlat_g, *ev_w_kv_up, *ev_w_out;
  const float *od_w_in, *od_ln_g, *od_ln_b, *od_sgu_w, *od_sgu_b, *od_sink, *od_w_out;
  const float *ffn_up, *ffn_conv_w, *ffn_conv_b, *ffn_down, *final_g;
  float* out; unsigned char* ws;
};

DI float bf2f(unsigned short b) { return __uint_as_float(((unsigned)b) << 16); }
DI float bflo(unsigned w) { return __uint_as_float(w << 16); }
DI float bfhi(unsigned w) { return __uint_as_float(w & 0xffff0000u); }
DI unsigned pk2(float lo, float hi) { f32x2_t v = {lo, hi}; bf16x2_t b = __builtin_convertvector(v, bf16x2_t); return __builtin_bit_cast(unsigned, b); }
DI unsigned short f2bf(float f) { return (unsigned short)(pk2(f, 0.f) & 0xffffu); }
DI float wave_sum(float v) {
#pragma unroll
  for (int o = 1; o < 64; o <<= 1) v += __shfl_xor(v, o);
  return v;
}
DI float sigmoidf_(float x) { return 1.f / (1.f + __expf(-x)); }
DI float siluf_(float x) { return x * sigmoidf_(x); }
DI float geluf_(float x) { const float u = 1.5957691216057308f * (x + 0.044715f * x * x * x); return x * sigmoidf_(u); }
DI int crow(int r, int hi) { return (r & 3) + 8 * (r >> 2) + 4 * hi; }
DI int modrow(int row) { return row < ML ? (row >> 11) : 16; }
DI int opaque_tid() { int t = threadIdx.x; asm volatile("" : "+v"(t)); return t; }

struct EpiRes {
  static constexpr bool PERM = false, AFTER_DRAIN = false;
  const float* baseL; const float* baseC; float* outL; float* outC; const float* gate;    int row0;
  DI void operator()(const pg8::f32x4 (&acc)[2][2][4][2], const pg8::Unit& u, int wr, int wc, int fr, int fq) const {
    const int rt = row0 + u.pm * 256; const bool lat = rt < ML; const int mr = lat ? (rt >> 11) : 16;
    const float* base = lat ? baseL + (size_t)rt * DM + u.pn * 256 : baseC + (size_t)(rt - ML) * DM + u.pn * 256;
    float* out = lat ? outL + (size_t)rt * DM + u.pn * 256 : outC + (size_t)(rt - ML) * DM + u.pn * 256;
    const float* gp = gate + (size_t)mr * 6144 + u.pn * 256;
    const int lo = (wr * 64 + fr) * DM + wc * 32 + 4 * fq;
    const int lc = wc * 32 + 4 * fq;
    pg8::f32x4 gv[2][2];
#pragma unroll
    for (int bj = 0; bj < 2; ++bj)
#pragma unroll
      for (int n = 0; n < 2; ++n) gv[bj][n] = *(const pg8::f32x4*)(gp + bj * 128 + n * 16 + lc);
    pg8::f32x4 cur[2][2], nxt[2][2];
#pragma unroll
    for (int bj = 0; bj < 2; ++bj)
#pragma unroll
      for (int n = 0; n < 2; ++n) cur[bj][n] = *(const pg8::f32x4*)(base + bj * 128 + n * 16 + lo);
#pragma unroll
    for (int g = 0; g < 8; ++g) {
      const int ai = g >> 2, mm = g & 3;
      if (g < 7) { const float* bp = base + (((g + 1) >> 2) * 128 + ((g + 1) & 3) * 16) * DM;
#pragma unroll
        for (int bj = 0; bj < 2; ++bj)
#pragma unroll
          for (int n = 0; n < 2; ++n) nxt[bj][n] = *(const pg8::f32x4*)(bp + bj * 128 + n * 16 + lo); }
      float* op = out + (ai * 128 + mm * 16) * DM;
#pragma unroll
      for (int bj = 0; bj < 2; ++bj)
#pragma unroll
        for (int n = 0; n < 2; ++n) *(pg8::f32x4*)(op + bj * 128 + n * 16 + lo) = cur[bj][n] + gv[bj][n] * acc[ai][bj][mm][n];
      asm volatile("" ::: "memory");
#pragma unroll
      for (int bj = 0; bj < 2; ++bj)
#pragma unroll
        for (int n = 0; n < 2; ++n) cur[bj][n] = nxt[bj][n];
    }
  }
};

DI float dpp_ror1(float v) { return __builtin_bit_cast(float, __builtin_amdgcn_update_dpp(0, __builtin_bit_cast(int, v), 0x121, 0xf, 0xf, true)); }
DI float dpp_rol1(float v) { return __builtin_bit_cast(float, __builtin_amdgcn_update_dpp(0, __builtin_bit_cast(int, v), 0x12F, 0xf, 0xf, true)); }
struct EpiConv {
  static constexpr bool PERM = true, AFTER_DRAIN = false;
  bf16_t* ACT; float* HALO; const float* cw; const float* cb; LAS float* edge;
  DI void operator()(const pg8::f32x4 (&acc)[2][2][4][2], const pg8::Unit& u, int wr, int wc, int fr, int fq) const {
    const int cl = wc * 32 + 8 * fq;
#pragma unroll
    for (int ai = 0; ai < 2; ++ai) {
      const int sl = 2 * ai + wr;
      if (fr == 0) {
#pragma unroll
        for (int bj = 0; bj < 2; ++bj)
#pragma unroll
          for (int n = 0; n < 2; ++n) *(LAS pg8::f32x4*)(edge + ((sl * 2 + 0) * 2 + bj) * 128 + cl + 4 * n) = acc[ai][bj][0][n];
      }
      if (fr == 15) {
#pragma unroll
        for (int bj = 0; bj < 2; ++bj)
#pragma unroll
          for (int n = 0; n < 2; ++n) *(LAS pg8::f32x4*)(edge + ((sl * 2 + 1) * 2 + bj) * 128 + cl + 4 * n) = acc[ai][bj][3][n];
      }
    }
    if (wr == 0 && fr < 2) {
#pragma unroll
      for (int bj = 0; bj < 2; ++bj)
#pragma unroll
        for (int n = 0; n < 2; ++n) *(pg8::f32x4*)(HALO + (size_t)(u.pm * 4 + fr) * FF2 + bj * FF + u.pn * 128 + cl + 4 * n) = acc[0][bj][0][n];
    }
    if (wr == 1 && fr >= 14) {
#pragma unroll
      for (int bj = 0; bj < 2; ++bj)
#pragma unroll
        for (int n = 0; n < 2; ++n) *(pg8::f32x4*)(HALO + (size_t)(u.pm * 4 + fr - 12) * FF2 + bj * FF + u.pn * 128 + cl + 4 * n) = acc[1][bj][3][n];
    }
    asm volatile("s_waitcnt lgkmcnt(0)" ::: "memory"); __builtin_amdgcn_s_barrier(); asm volatile("" ::: "memory");
    const pg8::f32x4 zero4 = {0.f, 0.f, 0.f, 0.f};
#pragma unroll
    for (int n = 0; n < 2; ++n) {
      const int ca = u.pn * 128 + cl + 4 * n;
      const pg8::f32x4 wa0 = *(const pg8::f32x4*)(cw + ca), wa1 = *(const pg8::f32x4*)(cw + FF2 + ca), wa2 = *(const pg8::f32x4*)(cw + 2 * FF2 + ca), ba = *(const pg8::f32x4*)(cb + ca);
      const pg8::f32x4 wg0 = *(const pg8::f32x4*)(cw + FF + ca), wg1 = *(const pg8::f32x4*)(cw + FF2 + FF + ca), wg2 = *(const pg8::f32x4*)(cw + 2 * FF2 + FF + ca), bg = *(const pg8::f32x4*)(cb + FF + ca);
#pragma unroll
      for (int ai = 0; ai < 2; ++ai) {
        const int sl = 2 * ai + wr;
        const pg8::f32x4 ua = sl > 0 ? *(const LAS pg8::f32x4*)(edge + (((sl - 1) * 2 + 1) * 2 + 0) * 128 + cl + 4 * n) : zero4;
        const pg8::f32x4 ug = sl > 0 ? *(const LAS pg8::f32x4*)(edge + (((sl - 1) * 2 + 1) * 2 + 1) * 128 + cl + 4 * n) : zero4;
        const pg8::f32x4 da = sl < 3 ? *(const LAS pg8::f32x4*)(edge + (((sl + 1) * 2 + 0) * 2 + 0) * 128 + cl + 4 * n) : zero4;
        const pg8::f32x4 dg = sl < 3 ? *(const LAS pg8::f32x4*)(edge + (((sl + 1) * 2 + 0) * 2 + 1) * 128 + cl + 4 * n) : zero4;
#pragma unroll
        for (int mm = 0; mm < 4; ++mm) {
          float o[4];
#pragma unroll
          for (int e = 0; e < 4; ++e) {
            const float ca_ = acc[ai][0][mm][n][e], cg_ = acc[ai][1][mm][n][e];
            const float pa = mm > 0 ? dpp_ror1(acc[ai][0][mm > 0 ? mm - 1 : 0][n][e]) : ua[e], pg = mm > 0 ? dpp_ror1(acc[ai][1][mm > 0 ? mm - 1 : 0][n][e]) : ug[e];
            const float na = mm < 3 ? dpp_rol1(acc[ai][0][mm < 3 ? mm + 1 : 3][n][e]) : da[e], ng = mm < 3 ? dpp_rol1(acc[ai][1][mm < 3 ? mm + 1 : 3][n][e]) : dg[e];
            const float rca = dpp_ror1(ca_), rcg = dpp_ror1(cg_), lca = dpp_rol1(ca_), lcg = dpp_rol1(cg_);
            const float upa = fr > 0 ? rca : pa, upg = fr > 0 ? rcg : pg;
            const float dna = fr < 15 ? lca : na, dng = fr < 15 ? lcg : ng;
            const float A = wa0[e] * upa + wa1[e] * ca_ + wa2[e] * dna + ba[e];
            const float G = wg0[e] * upg + wg1[e] * cg_ + wg2[e] * dng + bg[e];
            o[e] = siluf_(G) * A;
          }
          const int row = u.pm * 256 + ai * 128 + wr * 64 + mm * 16 + fr;
          u32x2 w; w.x = pk2(o[0], o[1]); w.y = pk2(o[2], o[3]);
          *(u32x2*)(ACT + (size_t)row * FF + ca) = w;
        }
      }
    }
  }
};
DI void phase_conv_fix(const float* HALO, bf16_t* ACT, const float* cw, const float* cb, int ntiles) {
  const int tid = opaque_tid(); const int total = ntiles * 2 * (FF / 4);
  for (int it = blockIdx.x * NT + tid; it < total; it += gridDim.x * NT) {
    const int j = (it % (FF / 4)) * 4, tr = it / (FF / 4), pm = tr >> 1, bot = tr & 1;
    const bool first = pm < 128 ? (pm & 7) == 0 : true, last = pm < 128 ? (pm & 7) == 7 : true;
    const float* hc = HALO + (size_t)(pm * 4 + (bot ? 3 : 0)) * FF2 + j;
    const float* hu = bot ? HALO + (size_t)(pm * 4 + 2) * FF2 + j : (first ? nullptr : HALO + (size_t)((pm - 1) * 4 + 3) * FF2 + j);
    const float* hd = bot ? (last ? nullptr : HALO + (size_t)((pm + 1) * 4 + 0) * FF2 + j) : HALO + (size_t)(pm * 4 + 1) * FF2 + j;
    const f32x4 z = {0.f, 0.f, 0.f, 0.f};
    const f32x4 ca_ = *(const f32x4*)hc, cg_ = *(const f32x4*)(hc + FF);
    const f32x4 ua = hu ? *(const f32x4*)hu : z, ug = hu ? *(const f32x4*)(hu + FF) : z, da = hd ? *(const f32x4*)hd : z, dg = hd ? *(const f32x4*)(hd + FF) : z;
    const f32x4 A = *(const f32x4*)(cw + j) * ua + *(const f32x4*)(cw + FF2 + j) * ca_ + *(const f32x4*)(cw + 2 * FF2 + j) * da + *(const f32x4*)(cb + j);
    const f32x4 G = *(const f32x4*)(cw + FF + j) * ug + *(const f32x4*)(cw + FF2 + FF + j) * cg_ + *(const f32x4*)(cw + 2 * FF2 + FF + j) * dg + *(const f32x4*)(cb + FF + j);
    u32x2 w; w.x = pk2(siluf_(G.x) * A.x, siluf_(G.y) * A.y); w.y = pk2(siluf_(G.z) * A.z, siluf_(G.w) * A.w);
    *(u32x2*)(ACT + (size_t)(pm * 256 + (bot ? 255 : 0)) * FF + j) = w;
  }
}

DI void conv_fix_tile(const float* HALO, bf16_t* ACT, const float* cw, const float* cb, int pm, int tid) {
  for (int it = tid; it < 2 * (FF / 4); it += NT) {
    const int j = (it % (FF / 4)) * 4, bot = it / (FF / 4);
    const bool first = pm < 128 ? (pm & 7) == 0 : true, last = pm < 128 ? (pm & 7) == 7 : true;
    const float* hc = HALO + (size_t)(pm * 4 + (bot ? 3 : 0)) * FF2 + j;
    const float* hu = bot ? HALO + (size_t)(pm * 4 + 2) * FF2 + j : (first ? nullptr : HALO + (size_t)((pm - 1) * 4 + 3) * FF2 + j);
    const float* hd = bot ? (last ? nullptr : HALO + (size_t)((pm + 1) * 4 + 0) * FF2 + j) : HALO + (size_t)(pm * 4 + 1) * FF2 + j;
    const f32x4 z = {0.f, 0.f, 0.f, 0.f};
    const f32x4 ca_ = *(const f32x4*)hc, cg_ = *(const f32x4*)(hc + FF);
    const f32x4 ua = hu ? *(const f32x4*)hu : z, ug = hu ? *(const f32x4*)(hu + FF) : z, da = hd ? *(const f32x4*)hd : z, dg = hd ? *(const f32x4*)(hd + FF) : z;
    const f32x4 A = *(const f32x4*)(cw + j) * ua + *(const f32x4*)(cw + FF2 + j) * ca_ + *(const f32x4*)(cw + 2 * FF2 + j) * da + *(const f32x4*)(cb + j);
    const f32x4 G = *(const f32x4*)(cw + FF + j) * ug + *(const f32x4*)(cw + FF2 + FF + j) * cg_ + *(const f32x4*)(cw + 2 * FF2 + FF + j) * dg + *(const f32x4*)(cb + FF + j);
    u32x2 w; w.x = pk2(siluf_(G.x) * A.x, siluf_(G.y) * A.y); w.y = pk2(siluf_(G.z) * A.z, siluf_(G.w) * A.w);
    *(u32x2*)(ACT + (size_t)(pm * 256 + (bot ? 255 : 0)) * FF + j) = w;
  }
}
DI void conv_fix_my_tiles(const pg8::StaticOrder& S, int pm_off, const float* HALO, bf16_t* ACT, const float* cw, const float* cb) {
  const int tid = opaque_tid(); pg8::Unit u; int lastpm = -1;
  for (int i = 0; S.next(i, u); ++i) if (u.pm != lastpm) { conv_fix_tile(HALO, ACT, cw, cb, pm_off + u.pm, tid); lastpm = u.pm; }
  asm volatile("s_waitcnt vmcnt(0)" ::: "memory"); __syncthreads();
}

DI void transpose_item(const float* W, int K, int N, bf16_t* WT, int row_off, LAS float* scr, int item, int lane, int ldo, int koff, bool UPPERM) {
  const int nblk = N / 32, kb = item / nblk, nb = item % nblk, k0 = 64 * kb, n0 = 32 * nb;
#pragma unroll 16
  for (int i = 0; i < 32; ++i) { const int kk = 2 * i + (lane >> 5); scr[kk * 33 + (lane & 31)] = W[(size_t)(k0 + kk) * N + n0 + (lane & 31)]; }
  asm volatile("s_waitcnt lgkmcnt(0)" ::: "memory");
  const int c = lane & 7;
#pragma unroll
  for (int j = 0; j < 4; ++j) { const int n = (lane >> 3) + 8 * j; const LAS float* s = scr + (8 * c) * 33 + n;
    u32x4 o; o.x = pk2(s[0 * 33], s[1 * 33]); o.y = pk2(s[2 * 33], s[3 * 33]); o.z = pk2(s[4 * 33], s[5 * 33]); o.w = pk2(s[6 * 33], s[7 * 33]);
    int drow = row_off + n0 + n;
    if (UPPERM) { const int ns = n0 + n, hg = ns >= FF ? 1 : 0, nn = ns - hg * FF; drow = row_off + (nn >> 7) * 256 + hg * 128 + (nn & 127); }
    *(u32x4*)(WT + (size_t)drow * ldo + koff + k0 + 8 * c) = o; }
  asm volatile("s_waitcnt lgkmcnt(0)" ::: "memory");
}

DI void phase_prologue(const Params& p, LAS unsigned char* lds) {
  const int tid = opaque_tid(), lane = tid & 63, wave = __builtin_amdgcn_readfirstlane(tid >> 6), G = gridDim.x;
  unsigned char* ws = p.ws;
  { float* COSH = (float*)(ws + WS_TAB); float* SINH = COSH + 2048 * 32; float* COSR = SINH + 2048 * 32; float* SINR = COSR + 2048 * 16;
    for (int i = blockIdx.x * NT + tid; i < 2048 * 32; i += G * NT) { const int t = i >> 5, f = i & 31; const float pos = (float)((f < 16) ? (t >> 6) : (t & 63));
      const float inv = powf(10000.f, -(float)(f & 15) / 16.f); const float a = pos * inv; COSH[i] = cosf(a); SINH[i] = sinf(a); }
    for (int i = blockIdx.x * NT + tid; i < 2048 * 16; i += G * NT) { const int t = i >> 4, f = i & 15; const float pos = (float)((f < 8) ? (t >> 6) : (t & 63));
      const float inv = powf(10000.f, -(float)(f & 7) / 8.f); const float a = pos * inv; COSR[i] = cosf(a); SINR[i] = sinf(a); }
  }
  constexpr int I1 = 16 * 37, I2 = 4 * 24, I3 = 2 * 32, I4 = 16 * 32, I5 = 16 * 56, I6 = 16 * 32, I7 = 16 * 176, I9 = 44 * 32;
  constexpr int NIT = I1 + I2 + I3 + I4 + I5 + I6 + 2 * I7 + 2 * I9;
  auto do_item = [&](int it, LAS float* scr) {
    int r = it; const float* W; bf16_t* WT; int K, N, ro = 0, ldo, ko = 0; bool up = false;
    if (r < I1) { W = p.ev_w_in; K = 1024; N = EV_IN; WT = (bf16_t*)(ws + WS_W_EVIN); ldo = 1024; }
    else if ((r -= I1) < I2) { W = p.ev_w_q_up; K = 256; N = 768; WT = (bf16_t*)(ws + WS_W_QUP); ldo = 384; }
    else if ((r -= I2) < I3) { W = p.ev_w_kv_up; K = 128; N = 1024; WT = (bf16_t*)(ws + WS_W_QUP); ro = 768; ldo = 384; ko = 256; }
    else if ((r -= I3) < I4) { W = p.ev_w_out; K = 1024; N = 1024; WT = (bf16_t*)(ws + WS_W_EVOUT); ldo = 1024; }
    else if ((r -= I4) < I5) { W = p.od_w_in; K = 1024; N = 1792; WT = (bf16_t*)(ws + WS_W_ODIN); ldo = 1024; }
    else if ((r -= I5) < I6) { W = p.od_w_out; K = 1024; N = 1024; WT = (bf16_t*)(ws + WS_W_ODOUT); ldo = 1024; }
    else if ((r -= I6) < I7) { W = p.ffn_up; K = 1024; N = FF2; WT = (bf16_t*)(ws + WS_W_UP); ldo = 1024; up = true; }
    else if ((r -= I7) < I7) { W = p.ffn_up + (size_t)1024 * FF2; K = 1024; N = FF2; WT = (bf16_t*)(ws + WS_W_UP) + (size_t)FF2 * 1024; ldo = 1024; up = true; }
    else if ((r -= I7) < I9) { W = p.ffn_down; K = FF; N = 1024; WT = (bf16_t*)(ws + WS_W_DOWN); ldo = FF; }
    else { r -= I9; W = p.ffn_down + (size_t)FF * 1024; K = FF; N = 1024; WT = (bf16_t*)(ws + WS_W_DOWN) + (size_t)1024 * FF; ldo = FF; }
    transpose_item(W, K, N, WT, ro, scr, r, lane, ldo, ko, up);
  };
  const int nGB = G < 192 ? G : 192;
  const int nTW = nGB * 4, NA = nTW * 7 < NIT ? nTW * 7 : NIT;
  { LAS float* s = (LAS float*)lds; LAS float* red = s + 17 * 1024; float* MOD = (float*)(ws + WS_MOD);
    for (int it = blockIdx.x; it < 192; it += G) {
      for (int i = tid; i < 17 * 1024; i += NT) { const int r = i >> 10, k = i & 1023; const float v = r < 16 ? p.c[r * 1024 + k] : p.c_ctx[k]; s[i] = siluf_(v); }
      __syncthreads();
      const int layer = it / 96, j0 = (it % 96) * 64;
      if (wave < 4) {
        const int cq = tid & 15, kg = tid >> 4;
        f32x4 acc[17];
#pragma unroll
        for (int r = 0; r < 17; ++r) acc[r] = (f32x4){0.f, 0.f, 0.f, 0.f};
        const float* w = p.mod_w + (size_t)layer * 1024 * 6144 + j0 + 4 * cq;
#pragma unroll 8
        for (int k = kg * 64; k < kg * 64 + 64; ++k) { const f32x4 wv = *(const f32x4*)(w + (size_t)k * 6144);
#pragma unroll
          for (int r = 0; r < 17; ++r) acc[r] += wv * s[r * 1024 + k]; }
#pragma unroll
        for (int r = 0; r < 17; ++r) {
#pragma unroll
          for (int e = 0; e < 4; ++e) { float v = acc[r][e]; v += __shfl_xor(v, 16); v += __shfl_xor(v, 32); acc[r][e] = v; }
          if ((lane >> 4) == 0) *(LAS f32x4*)(red + (wave * 17 + r) * 64 + 4 * cq) = acc[r]; }
      } else if (it == (int)blockIdx.x) {
        LAS float* scr = (LAS float*)(lds + 87040 + (wave - 4) * 8448);
        const int tw = blockIdx.x * 4 + (wave - 4);
        for (int j = 0; j < 7; ++j) { const int item = tw + j * nTW; if (item < NA) do_item(item, scr); }
      }
      __syncthreads();
      for (int o = tid; o < 17 * 64; o += NT) { const int r = o >> 6, j = o & 63; float sum = p.mod_b[layer * 6144 + j0 + j];
#pragma unroll
        for (int q = 0; q < 4; ++q) sum += red[(q * 17 + r) * 64 + j];
        MOD[((size_t)layer * 17 + r) * 6144 + j0 + j] = sum; }
      __syncthreads();
    }
  }
  __syncthreads();
  { LAS float* scr = (LAS float*)(lds + wave * 8448);
    const int gw = blockIdx.x * 8 + wave, NGW = G * 8;
    for (int it = NA + gw; it < NIT; it += NGW) do_item(it, scr);
    { bf16_t* wq = (bf16_t*)(ws + WS_W_QUP);
      for (int i = blockIdx.x * NT + tid; i < 768 * 16; i += G * NT) { const int r_ = i >> 4, c_ = i & 15; *(u32x4*)(wq + (size_t)r_ * 384 + 256 + c_ * 8) = (u32x4){0u, 0u, 0u, 0u}; }
      for (int i = blockIdx.x * NT + tid; i < 1024 * 32; i += G * NT) { const int r_ = 768 + (i >> 5), c_ = i & 31; *(u32x4*)(wq + (size_t)r_ * 384 + c_ * 8) = (u32x4){0u, 0u, 0u, 0u}; } }
    u32x4* z = (u32x4*)((bf16_t*)(ws + WS_W_EVIN) + (size_t)EV_IN * 1024);
    for (int i = blockIdx.x * NT + tid; i < (EV_PITCH - EV_IN) * 1024 / 8; i += G * NT) z[i] = (u32x4){0u, 0u, 0u, 0u};
  }
}

DI void phase_norm_mod(const float* srcL, const float* srcC, const float* g, const float* modl, int shiftIdx, int scaleIdx, bf16_t* Z, int rowBeg, int rowEnd, int blk0 = 0, int nblk = 0) {
  if (nblk == 0) nblk = gridDim.x;
  const int tid = opaque_tid(), lane = tid & 63, gw = ((int)blockIdx.x - blk0) * 8 + (tid >> 6), NGW = nblk * 8;
  for (int row0 = rowBeg + gw; row0 < rowEnd; row0 += 2 * NGW) {
    const int row1 = row0 + NGW; const bool has1 = row1 < rowEnd; const int r1 = has1 ? row1 : row0;
    const float* s0 = row0 < ML ? srcL + (size_t)row0 * DM : srcC + (size_t)(row0 - ML) * DM;
    const float* s1 = r1 < ML ? srcL + (size_t)r1 * DM : srcC + (size_t)(r1 - ML) * DM;
    f32x4 v0[4], v1[4];
#pragma unroll
    for (int j = 0; j < 4; ++j) { v0[j] = *(const f32x4*)(s0 + 4 * (64 * j + lane)); v1[j] = *(const f32x4*)(s1 + 4 * (64 * j + lane)); }
    float ss0 = 0.f, ss1 = 0.f;
#pragma unroll
    for (int j = 0; j < 4; ++j) { ss0 += (v0[j].x * v0[j].x + v0[j].y * v0[j].y) + (v0[j].z * v0[j].z + v0[j].w * v0[j].w); ss1 += (v1[j].x * v1[j].x + v1[j].y * v1[j].y) + (v1[j].z * v1[j].z + v1[j].w * v1[j].w); }
    const float q0 = rsqrtf(wave_sum(ss0) * (1.f / DM) + EPS), q1 = rsqrtf(wave_sum(ss1) * (1.f / DM) + EPS);
    const float* mp0 = modl + (size_t)modrow(row0) * 6144; const float* mp1 = modl + (size_t)modrow(r1) * 6144;
#pragma unroll
    for (int j = 0; j < 4; ++j) { const int k = 4 * (64 * j + lane);
      const f32x4 gg = *(const f32x4*)(g + k);
      { const f32x4 sc = *(const f32x4*)(mp0 + scaleIdx * 1024 + k), sh = *(const f32x4*)(mp0 + shiftIdx * 1024 + k);
        const f32x4 z = (v0[j] * q0) * gg * (sc + 1.f) + sh; u32x2 w; w.x = pk2(z.x, z.y); w.y = pk2(z.z, z.w); *(u32x2*)(Z + (size_t)row0 * DM + k) = w; }
      if (has1) { const f32x4 sc = *(const f32x4*)(mp1 + scaleIdx * 1024 + k), sh = *(const f32x4*)(mp1 + shiftIdx * 1024 + k);
        const f32x4 z = (v1[j] * q1) * gg * (sc + 1.f) + sh; u32x2 w; w.x = pk2(z.x, z.y); w.y = pk2(z.z, z.w); *(u32x2*)(Z + (size_t)row1 * DM + k) = w; }
    }
  }
}
DI void phase_final_norm(float* out, const float* g) {
  const int tid = opaque_tid(), lane = tid & 63, gw = blockIdx.x * 8 + (tid >> 6), NGW = gridDim.x * 8;
  for (int row = gw; row < ML; row += NGW) {
    float* src = out + (size_t)row * DM;
    f32x4 v[4]; float ss = 0.f;
#pragma unroll
    for (int j = 0; j < 4; ++j) { v[j] = *(const f32x4*)(src + 4 * (64 * j + lane)); ss += (v[j].x * v[j].x + v[j].y * v[j].y) + (v[j].z * v[j].z + v[j].w * v[j].w); }
    const float r = rsqrtf(wave_sum(ss) * (1.f / DM) + EPS);
#pragma unroll
    for (int j = 0; j < 4; ++j) { const int k = 4 * (64 * j + lane); const f32x4 gg = *(const f32x4*)(g + k); *(f32x4*)(src + k) = (v[j] * r) * gg; }
  }
}
DI void head_fix(bf16_t* base, int sub, const float* gain, bool norm, bool rope, const float* cs, const float* sn, float scale, bool doit) {
  const u32x2 a = *(const u32x2*)(base + 4 * sub), b = *(const u32x2*)(base + 32 + 4 * sub);
  float x1[4] = {bflo(a.x), bfhi(a.x), bflo(a.y), bfhi(a.y)}, x2[4] = {bflo(b.x), bfhi(b.x), bflo(b.y), bfhi(b.y)};
  if (norm) {
    float ss = 0.f;
#pragma unroll
    for (int j = 0; j < 4; ++j) ss += x1[j] * x1[j] + x2[j] * x2[j];
    ss += __shfl_xor(ss, 1); ss += __shfl_xor(ss, 2); ss += __shfl_xor(ss, 4);
    const float r = rsqrtf(ss * (1.f / 64.f) + EPS);
#pragma unroll
    for (int j = 0; j < 4; ++j) { x1[j] = x1[j] * r * gain[4 * sub + j]; x2[j] = x2[j] * r * gain[32 + 4 * sub + j]; }
  }
  if (rope) {
#pragma unroll
    for (int j = 0; j < 4; ++j) { const float c = cs[4 * sub + j], s = sn[4 * sub + j]; const float o1 = x1[j] * c - x2[j] * s, o2 = x1[j] * s + x2[j] * c; x1[j] = o1; x2[j] = o2; }
  }
  if (doit) {
    u32x2 wa, wb; wa.x = pk2(x1[0] * scale, x1[1] * scale); wa.y = pk2(x1[2] * scale, x1[3] * scale); wb.x = pk2(x2[0] * scale, x2[1] * scale); wb.y = pk2(x2[2] * scale, x2[3] * scale);
    *(u32x2*)(base + 4 * sub) = wa; *(u32x2*)(base + 32 + 4 * sub) = wb;
  }
}
DI void phase_post_even(const Params& p) {
  const int tid = opaque_tid(), lane = tid & 63, gw = blockIdx.x * 8 + (tid >> 6), NGW = gridDim.x * 8;
  bf16_t* H = (bf16_t*)(p.ws + WS_H);
  const float* COSH = (const float*)(p.ws + WS_TAB); const float* SINH = COSH + 2048 * 32; const float* COSR = SINH + 2048 * 32; const float* SINR = COSR + 2048 * 16;
  for (int row = gw; row < MT; row += NGW) {
    bf16_t* hr = H + (size_t)row * EV_PITCH; const bool lat = row < ML; const int t = row & (SEQ - 1);
    const int sub = lane & 7;
    head_fix(hr + 512 + ((lane >> 3) & 1) * 64, sub, p.ev_ka_g, true, lat, COSH + t * 32, SINH + t * 32, 1.f, lane < 16);
    {
      const u32x2 a = *(const u32x2*)(hr + 768 + 4 * lane); float x[4] = {bflo(a.x), bfhi(a.x), bflo(a.y), bfhi(a.y)};
      const float r = rsqrtf(wave_sum(x[0] * x[0] + x[1] * x[1] + x[2] * x[2] + x[3] * x[3]) * (1.f / 256.f) + EPS);
      const f32x4 g = *(const f32x4*)(p.ev_qlat_g + 4 * lane);
      u32x2 w; w.x = pk2(x[0] * r * g.x, x[1] * r * g.y); w.y = pk2(x[2] * r * g.z, x[3] * r * g.w); *(u32x2*)(hr + 768 + 4 * lane) = w; }
    {
      const unsigned a = *(const unsigned*)(hr + 1024 + 2 * lane); const float x0 = bflo(a), x1 = bfhi(a);
      const float r = rsqrtf(wave_sum(x0 * x0 + x1 * x1) * (1.f / 128.f) + EPS);
      *(unsigned*)(hr + 1024 + 2 * lane) = pk2(x0 * r * p.ev_kvlat_g[2 * lane], x1 * r * p.ev_kvlat_g[2 * lane + 1]); }
    if (lat && lane < 16) {
      const float x1 = bf2f(hr[1152 + lane]), x2 = bf2f(hr[1152 + 16 + lane]); const float c = COSR[t * 16 + lane], s = SINR[t * 16 + lane];
      hr[1152 + lane] = f2bf(x1 * c - x2 * s); hr[1152 + 16 + lane] = f2bf(x1 * s + x2 * c); }
  }
}
DI void phase_post_odd(const Params& p) {
  const int tid = opaque_tid(), lane = tid & 63, gw = blockIdx.x * 8 + (tid >> 6), NGW = gridDim.x * 8;
  bf16_t* H = (bf16_t*)(p.ws + WS_H);
  const float* COSH = (const float*)(p.ws + WS_TAB); const float* SINH = COSH + 2048 * 32;
  for (int row = gw; row < ML; row += NGW) {
    bf16_t* hr = H + (size_t)row * OD_PITCH; const int t = row & (SEQ - 1); const int sub = lane & 7;
    { const u32x4 a = *(const u32x4*)(hr + 512 + 8 * lane);
      float x[8] = {bflo(a.x), bfhi(a.x), bflo(a.y), bfhi(a.y), bflo(a.z), bfhi(a.z), bflo(a.w), bfhi(a.w)}; float s = 0.f;
#pragma unroll
      for (int j = 0; j < 8; ++j) { x[j] = geluf_(x[j]); s += x[j]; }
      const float mu = wave_sum(s) * (1.f / 512.f); float q = 0.f;
#pragma unroll
      for (int j = 0; j < 8; ++j) { x[j] -= mu; q += x[j] * x[j]; }
      const float r = rsqrtf(wave_sum(q) * (1.f / 512.f) + EPS);
      const f32x4 g0 = *(const f32x4*)(p.od_ln_g + 8 * lane), g1 = *(const f32x4*)(p.od_ln_g + 8 * lane + 4), b0 = *(const f32x4*)(p.od_ln_b + 8 * lane), b1 = *(const f32x4*)(p.od_ln_b + 8 * lane + 4);
      u32x4 w; w.x = pk2(x[0] * r * g0.x + b0.x, x[1] * r * g0.y + b0.y); w.y = pk2(x[2] * r * g0.z + b0.z, x[3] * r * g0.w + b0.w);
      w.z = pk2(x[4] * r * g1.x + b1.x, x[5] * r * g1.y + b1.y); w.w = pk2(x[6] * r * g1.z + b1.z, x[7] * r * g1.w + b1.w);
      *(u32x4*)(hr + 512 + 8 * lane) = w; }
    head_fix(hr + 1536 + ((lane >> 3) & 1) * 64, sub, nullptr, false, true, COSH + t * 32, SINH + t * 32, 1.f, lane < 16);
  }
}
DI void phase_conv_act(const bf16_t* HUP, bf16_t* ACT, const float* cw, const float* cb, int rbeg, int rend) {
  const long total = (long)(rend - rbeg) * 352; const int tid = opaque_tid();
  for (long it = (long)blockIdx.x * NT + tid; it < total; it += (long)gridDim.x * NT) {
    const int lr = (int)(it / 352), ch = (int)(it % 352), row = rbeg + lr, j = ch * 8;
    const int pos = row < ML ? (row & (SEQ - 1)) : ((row - ML) & (CTX - 1)); const int len = row < ML ? SEQ : CTX;
    const bf16_t* h = HUP + (size_t)lr * FF2 + j;
    const u32x4 z4 = {0u, 0u, 0u, 0u};
    const u32x4 a0 = pos > 0 ? *(const u32x4*)(h - FF2) : z4, a1 = *(const u32x4*)h, a2 = pos < len - 1 ? *(const u32x4*)(h + FF2) : z4;
    const u32x4 g0 = pos > 0 ? *(const u32x4*)(h - FF2 + FF) : z4, g1 = *(const u32x4*)(h + FF), g2 = pos < len - 1 ? *(const u32x4*)(h + FF2 + FF) : z4;
    float o[8];
#pragma unroll
    for (int e = 0; e < 8; ++e) {
      const unsigned wa0 = a0[e >> 1], wa1 = a1[e >> 1], wa2 = a2[e >> 1], wg0 = g0[e >> 1], wg1 = g1[e >> 1], wg2 = g2[e >> 1];
      const float xa0 = (e & 1) ? bfhi(wa0) : bflo(wa0), xa1 = (e & 1) ? bfhi(wa1) : bflo(wa1), xa2 = (e & 1) ? bfhi(wa2) : bflo(wa2);
      const float xg0 = (e & 1) ? bfhi(wg0) : bflo(wg0), xg1 = (e & 1) ? bfhi(wg1) : bflo(wg1), xg2 = (e & 1) ? bfhi(wg2) : bflo(wg2);
      const int ja = j + e, jg = FF + j + e;
      const float A = cw[ja] * xa0 + cw[FF2 + ja] * xa1 + cw[2 * FF2 + ja] * xa2 + cb[ja];
      const float Gv = cw[jg] * xg0 + cw[FF2 + jg] * xg1 + cw[2 * FF2 + jg] * xg2 + cb[jg];
      o[e] = siluf_(Gv) * A;
    }
    u32x4 w; w.x = pk2(o[0], o[1]); w.y = pk2(o[2], o[3]); w.z = pk2(o[4], o[5]); w.w = pk2(o[6], o[7]);
    *(u32x4*)(ACT + (size_t)lr * FF + j) = w;
  }
}

struct AttnJob { const bf16_t *Q, *K1, *K2, *V; bf16_t* O; int qp, k1p, k2p, vp, op; int s0row, s0n, s1row, s1n; int win, qpos0, s1pos0; float sink2; int has_sink; const float* rope_cos; const float* rope_sin; const float* qg; const float* cosh; const float* sinh; float qscale; int q_rope; };
DI s16x4 vtr(const LAS unsigned char* pp) { typedef short v4i16_t __attribute__((ext_vector_type(4))); return __builtin_bit_cast(s16x4, __builtin_amdgcn_ds_read_tr16_b64_v4i16((LAS v4i16_t*)pp)); }
#define MFMA32(a, b, c) __builtin_amdgcn_mfma_f32_32x32x16_bf16((a), (b), (c), 0, 0, 0)

DI void q_fix64(bf16x8 (&qf)[4], const AttnJob& J, int pos, int h) {
  float x[4][8];
#pragma unroll
  for (int s = 0; s < 4; ++s)
#pragma unroll
    for (int j = 0; j < 8; ++j) x[s][j] = bf2f((unsigned short)qf[s][j]);
  if (J.qg) {
    float ss = 0.f;
#pragma unroll
    for (int s = 0; s < 4; ++s)
#pragma unroll
      for (int j = 0; j < 8; ++j) ss += x[s][j] * x[s][j];
    ss += __shfl_xor(ss, 32);
    const float r = rsqrtf(ss * (1.f / 64.f) + EPS);
#pragma unroll
    for (int s = 0; s < 4; ++s) { const f32x4 g0 = *(const f32x4*)(J.qg + 16 * s + 8 * h), g1 = *(const f32x4*)(J.qg + 16 * s + 8 * h + 4);
#pragma unroll
      for (int j = 0; j < 4; ++j) { x[s][j] *= r * g0[j]; x[s][4 + j] *= r * g1[j]; } }
  }
  if (J.q_rope) {
#pragma unroll
    for (int s = 0; s < 2; ++s) { const float* cp = J.cosh + pos * 32 + 16 * s + 8 * h; const float* sp = J.sinh + pos * 32 + 16 * s + 8 * h;
      const f32x4 c0 = *(const f32x4*)cp, c1 = *(const f32x4*)(cp + 4), s0 = *(const f32x4*)sp, s1 = *(const f32x4*)(sp + 4);
#pragma unroll
      for (int j = 0; j < 8; ++j) { const float c = j < 4 ? c0[j & 3] : c1[j & 3], sn = j < 4 ? s0[j & 3] : s1[j & 3]; const float x1 = x[s][j], x2 = x[s + 2][j];
        x[s][j] = x1 * c - x2 * sn; x[s + 2][j] = x1 * sn + x2 * c; } }
  }
#pragma unroll
  for (int s = 0; s < 4; ++s) { u32x4 w; w.x = pk2(x[s][0] * J.qscale, x[s][1] * J.qscale); w.y = pk2(x[s][2] * J.qscale, x[s][3] * J.qscale);
    w.z = pk2(x[s][4] * J.qscale, x[s][5] * J.qscale); w.w = pk2(x[s][6] * J.qscale, x[s][7] * J.qscale); qf[s] = __builtin_bit_cast(bf16x8, w); }
}
template <int DK> DI void attn_unit(const AttnJob& J, LAS unsigned char* lds) {
  constexpr int KP = DK * 2 + 16, VP = 144, KBUF = 64 * KP, VBUF = 64 * VP, NS = DK / 16;
  const int tid = opaque_tid(), lane = tid & 63, wave = tid >> 6, r32 = lane & 31, h = lane >> 5;
  LAS unsigned char* Kl = lds; LAS unsigned char* Vl = lds + 2 * KBUF;
  const bf16_t* qrow = J.Q + (size_t)(wave * 32 + r32) * J.qp;
  bf16x8 qf[NS];
#pragma unroll
  for (int s = 0; s < NS; ++s) qf[s] = *(const bf16x8*)(qrow + 16 * s + 8 * h);
  if constexpr (DK == 64) q_fix64(qf, J, J.qpos0 + wave * 32 + r32, h);
  if (DK == 96) { if (J.rope_cos) {
    const float* cs = J.rope_cos + (J.qpos0 + wave * 32 + r32) * 16 + 8 * h; const float* sn = J.rope_sin + (J.qpos0 + wave * 32 + r32) * 16 + 8 * h;
#pragma unroll
    for (int j = 0; j < 8; ++j) { const float x1 = bf2f((unsigned short)qf[NS - 2][j]), x2 = bf2f((unsigned short)qf[NS - 1][j]); const float c = cs[j], s_ = sn[j];
      qf[NS - 2][j] = (short)f2bf(x1 * c - x2 * s_); qf[NS - 1][j] = (short)f2bf(x1 * s_ + x2 * c); } } }
  const int nt0 = J.s0n >> 6, nt = nt0 + (J.s1n >> 6);
  const int srow = tid >> 3, sch = tid & 7;
  const int s2row = (tid >> 2) & 63, s2ch = tid & 3;
  u32x4 rk, rv, rk2;
  auto tile_row = [&](int t) -> int { return t < nt0 ? J.s0row + 64 * t : J.s1row + 64 * (t - nt0); };
  auto gload = [&](int t) { const int kr0 = tile_row(t);
    rk = *(const u32x4*)(J.K1 + (size_t)(kr0 + srow) * J.k1p + sch * 8);
    rv = *(const u32x4*)(J.V + (size_t)(kr0 + srow) * J.vp + sch * 8);
    if (DK == 96) { if (tid < 256) rk2 = *(const u32x4*)(J.K2 + (size_t)(kr0 + s2row) * J.k2p + s2ch * 8); } };
  auto lstore = [&](int b) {
    *(LAS u32x4*)(Kl + b * KBUF + srow * KP + sch * 16) = rk;
    *(LAS u32x4*)(Vl + b * VBUF + srow * VP + sch * 16) = rv;
    if (DK == 96) { if (tid < 256) *(LAS u32x4*)(Kl + b * KBUF + s2row * KP + 128 + s2ch * 16) = rk2; } };
  gload(0); lstore(0); __syncthreads();
  float m = 0.f, lsum = 0.f; f32x16 O0 = {}, O1 = {};
  const int qpos = J.qpos0 + wave * 32 + r32, qmin = J.qpos0 + wave * 32;
  const int q4 = (lane & 15) >> 2, p4 = lane & 3, blk = (lane >> 4) & 1;
  for (int t = 0; t < nt; ++t) {
    if (t + 1 < nt) gload(t + 1);
    const LAS unsigned char* Kb = Kl + (t & 1) * KBUF; const LAS unsigned char* Vb = Vl + (t & 1) * VBUF;
    bool active = true; int kp0 = 0;
    if (J.win && t >= nt0) { kp0 = J.s1pos0 + 64 * (t - nt0); active = (kp0 + 63 >= qmin - 128) && (kp0 <= qmin + 31 + 128); }
    if (active) {
      f32x16 S0, S1;
#pragma unroll
      for (int i = 0; i < 16; ++i) { S0[i] = -m; S1[i] = -m; }
#pragma unroll
      for (int s = 0; s < NS; ++s) {
        const bf16x8 k0 = *(const LAS bf16x8*)(Kb + r32 * KP + (16 * s + 8 * h) * 2);
        const bf16x8 k1 = *(const LAS bf16x8*)(Kb + (32 + r32) * KP + (16 * s + 8 * h) * 2);
        S0 = MFMA32(k0, qf[s], S0); S1 = MFMA32(k1, qf[s], S1);
      }
      if (J.win && t >= nt0) {
#pragma unroll
        for (int i = 0; i < 16; ++i) { const int kpos = kp0 + crow(i, h); const int d0 = qpos - kpos, d1 = d0 - 32;
          if (d0 > 128 || d0 < -128) S0[i] = -1e30f; if (d1 > 128 || d1 < -128) S1[i] = -1e30f; }
      }
      float mx = fmaxf(S0[0], S1[0]);
#pragma unroll
      for (int i = 1; i < 16; ++i) mx = fmaxf(mx, fmaxf(S0[i], S1[i]));
      mx = fmaxf(mx, __shfl_xor(mx, 32));
      if (__any(mx > 6.0f)) {
        const float dl = fmaxf(mx, 0.f); m += dl; const float alpha = __builtin_amdgcn_exp2f(-dl); lsum *= alpha;
#pragma unroll
        for (int i = 0; i < 16; ++i) { S0[i] -= dl; S1[i] -= dl; O0[i] *= alpha; O1[i] *= alpha; }
      }
      float ps = 0.f;
#pragma unroll
      for (int i = 0; i < 16; ++i) { S0[i] = __builtin_amdgcn_exp2f(S0[i]); S1[i] = __builtin_amdgcn_exp2f(S1[i]); ps += S0[i] + S1[i]; }
      lsum += ps;
#pragma unroll
      for (int kb = 0; kb < 2; ++kb)
#pragma unroll
        for (int s2 = 0; s2 < 2; ++s2) {
          u32x4 pw;
          if (kb == 0) { pw.x = pk2(S0[8 * s2 + 0], S0[8 * s2 + 1]); pw.y = pk2(S0[8 * s2 + 2], S0[8 * s2 + 3]); pw.z = pk2(S0[8 * s2 + 4], S0[8 * s2 + 5]); pw.w = pk2(S0[8 * s2 + 6], S0[8 * s2 + 7]); }
          else         { pw.x = pk2(S1[8 * s2 + 0], S1[8 * s2 + 1]); pw.y = pk2(S1[8 * s2 + 2], S1[8 * s2 + 3]); pw.z = pk2(S1[8 * s2 + 4], S1[8 * s2 + 5]); pw.w = pk2(S1[8 * s2 + 6], S1[8 * s2 + 7]); }
          const bf16x8 pf = __builtin_bit_cast(bf16x8, pw);
          const LAS unsigned char* vb = Vb + (kb * 32 + 16 * s2 + 4 * h + q4) * VP + (blk * 16 + 4 * p4) * 2;
          { const s16x4 lo = vtr(vb), hi = vtr(vb + 8 * VP); const bf16x8 vf = __builtin_shufflevector(lo, hi, 0, 1, 2, 3, 4, 5, 6, 7); O0 = MFMA32(vf, pf, O0); }
          { const s16x4 lo = vtr(vb + 64), hi = vtr(vb + 64 + 8 * VP); const bf16x8 vf = __builtin_shufflevector(lo, hi, 0, 1, 2, 3, 4, 5, 6, 7); O1 = MFMA32(vf, pf, O1); }
        }
    }
    if (t + 1 < nt) lstore((t + 1) & 1);
    __syncthreads();
  }
  lsum += __shfl_xor(lsum, 32);
  if (J.has_sink) lsum += __builtin_amdgcn_exp2f(J.sink2 - m);
  const float inv = 1.f / lsum;
  bf16_t* orow = J.O + (size_t)(wave * 32 + r32) * J.op;
#pragma unroll
  for (int g = 0; g < 4; ++g) {
    u32x2 w0, w1; w0.x = pk2(O0[4 * g] * inv, O0[4 * g + 1] * inv); w0.y = pk2(O0[4 * g + 2] * inv, O0[4 * g + 3] * inv);
    w1.x = pk2(O1[4 * g] * inv, O1[4 * g + 1] * inv); w1.y = pk2(O1[4 * g + 2] * inv, O1[4 * g + 3] * inv);
    *(u32x2*)(orow + 8 * g + 4 * h) = w0; *(u32x2*)(orow + 32 + 8 * g + 4 * h) = w1;
  }
}

template <int DK> DI void attn_unit2(const AttnJob& J, LAS unsigned char* lds) {
  constexpr int KP = DK * 2 + 16, VP = 144, KBUF = 64 * KP, VBUF = 64 * VP, NS = DK / 16;
  const int tid = opaque_tid(), lane = tid & 63, wave = tid >> 6, r32 = lane & 31, h = lane >> 5;
  LAS unsigned char* Kl = lds; LAS unsigned char* Vl = lds + 2 * KBUF;
  bf16x8 qf[2][NS];
#pragma unroll
  for (int qb = 0; qb < 2; ++qb) {
    const bf16_t* qrow = J.Q + (size_t)(wave * 64 + qb * 32 + r32) * J.qp;
#pragma unroll
    for (int s = 0; s < NS; ++s) qf[qb][s] = *(const bf16x8*)(qrow + 16 * s + 8 * h);
    if constexpr (DK == 64) q_fix64(qf[qb], J, J.qpos0 + wave * 64 + qb * 32 + r32, h);
    if (DK == 96) { if (J.rope_cos) {
      const float* cs = J.rope_cos + (J.qpos0 + wave * 64 + qb * 32 + r32) * 16 + 8 * h; const float* sn = J.rope_sin + (J.qpos0 + wave * 64 + qb * 32 + r32) * 16 + 8 * h;
#pragma unroll
      for (int j = 0; j < 8; ++j) { const float x1 = bf2f((unsigned short)qf[qb][NS - 2][j]), x2 = bf2f((unsigned short)qf[qb][NS - 1][j]); const float c = cs[j], s_ = sn[j];
        qf[qb][NS - 2][j] = (short)f2bf(x1 * c - x2 * s_); qf[qb][NS - 1][j] = (short)f2bf(x1 * s_ + x2 * c); } } }
  }
  const int nt0 = J.s0n >> 6, nt = nt0 + (J.s1n >> 6);
  const int srow = tid >> 3, sch = tid & 7; const int s2row = (tid >> 2) & 63, s2ch = tid & 3;
  u32x4 rk, rv, rk2;
  auto tile_row = [&](int t) -> int { return t < nt0 ? J.s0row + 64 * t : J.s1row + 64 * (t - nt0); };
  auto gload = [&](int t) { const int kr0 = tile_row(t);
    rk = *(const u32x4*)(J.K1 + (size_t)(kr0 + srow) * J.k1p + sch * 8);
    rv = *(const u32x4*)(J.V + (size_t)(kr0 + srow) * J.vp + sch * 8);
    if (DK == 96) { if (tid < 256) rk2 = *(const u32x4*)(J.K2 + (size_t)(kr0 + s2row) * J.k2p + s2ch * 8); } };
  auto lstore = [&](int b) {
    *(LAS u32x4*)(Kl + b * KBUF + srow * KP + sch * 16) = rk;
    *(LAS u32x4*)(Vl + b * VBUF + srow * VP + sch * 16) = rv;
    if (DK == 96) { if (tid < 256) *(LAS u32x4*)(Kl + b * KBUF + s2row * KP + 128 + s2ch * 16) = rk2; } };
  gload(0); lstore(0); __syncthreads();
  float m[2] = {0.f, 0.f}, lsum[2] = {0.f, 0.f}; f32x16 O[2][2];
#pragma unroll
  for (int qb = 0; qb < 2; ++qb) { O[qb][0] = (f32x16){}; O[qb][1] = (f32x16){}; }
  const int q4 = (lane & 15) >> 2, p4 = lane & 3, blk = (lane >> 4) & 1;
  const int qmin = J.qpos0 + wave * 64;
  for (int t = 0; t < nt; ++t) {
    if (t + 1 < nt) gload(t + 1);
    const LAS unsigned char* Kb = Kl + (t & 1) * KBUF; const LAS unsigned char* Vb = Vl + (t & 1) * VBUF;
    bool active = true; int kp0 = 0;
    if (J.win && t >= nt0) { kp0 = J.s1pos0 + 64 * (t - nt0); active = (kp0 + 63 >= qmin - 128) && (kp0 <= qmin + 63 + 128); }
    if (active) {
    f32x16 S[2][2];
#pragma unroll
    for (int qb = 0; qb < 2; ++qb)
#pragma unroll
      for (int i = 0; i < 16; ++i) { S[qb][0][i] = -m[qb]; S[qb][1][i] = -m[qb]; }
#pragma unroll
    for (int s = 0; s < NS; ++s) {
      const bf16x8 k0 = *(const LAS bf16x8*)(Kb + r32 * KP + (16 * s + 8 * h) * 2);
      const bf16x8 k1 = *(const LAS bf16x8*)(Kb + (32 + r32) * KP + (16 * s + 8 * h) * 2);
#pragma unroll
      for (int qb = 0; qb < 2; ++qb) { S[qb][0] = MFMA32(k0, qf[qb][s], S[qb][0]); S[qb][1] = MFMA32(k1, qf[qb][s], S[qb][1]); }
    }
    if (J.win && t >= nt0) {
#pragma unroll
      for (int qb = 0; qb < 2; ++qb) { const int qpos = qmin + qb * 32 + r32;
#pragma unroll
        for (int i = 0; i < 16; ++i) { const int kpos = kp0 + crow(i, h); const int d0 = qpos - kpos, d1 = d0 - 32;
          if (d0 > 128 || d0 < -128) S[qb][0][i] = -1e30f; if (d1 > 128 || d1 < -128) S[qb][1][i] = -1e30f; } }
    }
#pragma unroll
    for (int qb = 0; qb < 2; ++qb) {
      float mx = fmaxf(S[qb][0][0], S[qb][1][0]);
#pragma unroll
      for (int i = 1; i < 16; ++i) mx = fmaxf(mx, fmaxf(S[qb][0][i], S[qb][1][i]));
      mx = fmaxf(mx, __shfl_xor(mx, 32));
      if (__any(mx > 6.0f)) {
        const float dl = fmaxf(mx, 0.f); m[qb] += dl; const float alpha = __builtin_amdgcn_exp2f(-dl); lsum[qb] *= alpha;
#pragma unroll
        for (int i = 0; i < 16; ++i) { S[qb][0][i] -= dl; S[qb][1][i] -= dl; O[qb][0][i] *= alpha; O[qb][1][i] *= alpha; }
      }
      float ps = 0.f;
#pragma unroll
      for (int i = 0; i < 16; ++i) { S[qb][0][i] = __builtin_amdgcn_exp2f(S[qb][0][i]); S[qb][1][i] = __builtin_amdgcn_exp2f(S[qb][1][i]); ps += S[qb][0][i] + S[qb][1][i]; }
      lsum[qb] += ps;
    }
#pragma unroll
    for (int kb = 0; kb < 2; ++kb)
#pragma unroll
      for (int s2 = 0; s2 < 2; ++s2) {
        const LAS unsigned char* vb = Vb + (kb * 32 + 16 * s2 + 4 * h + q4) * VP + (blk * 16 + 4 * p4) * 2;
        const s16x4 lo0 = vtr(vb), hi0 = vtr(vb + 8 * VP), lo1 = vtr(vb + 64), hi1 = vtr(vb + 64 + 8 * VP);
        const bf16x8 vf0 = __builtin_shufflevector(lo0, hi0, 0, 1, 2, 3, 4, 5, 6, 7), vf1 = __builtin_shufflevector(lo1, hi1, 0, 1, 2, 3, 4, 5, 6, 7);
#pragma unroll
        for (int qb = 0; qb < 2; ++qb) {
          u32x4 pw; pw.x = pk2(S[qb][kb][8 * s2 + 0], S[qb][kb][8 * s2 + 1]); pw.y = pk2(S[qb][kb][8 * s2 + 2], S[qb][kb][8 * s2 + 3]);
          pw.z = pk2(S[qb][kb][8 * s2 + 4], S[qb][kb][8 * s2 + 5]); pw.w = pk2(S[qb][kb][8 * s2 + 6], S[qb][kb][8 * s2 + 7]);
          const bf16x8 pf = __builtin_bit_cast(bf16x8, pw);
          O[qb][0] = MFMA32(vf0, pf, O[qb][0]); O[qb][1] = MFMA32(vf1, pf, O[qb][1]);
        }
      }
    }
    if (t + 1 < nt) lstore((t + 1) & 1);
    __syncthreads();
  }
#pragma unroll
  for (int qb = 0; qb < 2; ++qb) {
    float l = lsum[qb]; l += __shfl_xor(l, 32); if (J.has_sink) l += __builtin_amdgcn_exp2f(J.sink2 - m[qb]); const float inv = 1.f / l;
    bf16_t* orow = J.O + (size_t)(wave * 64 + qb * 32 + r32) * J.op;
#pragma unroll
    for (int g = 0; g < 4; ++g) {
      u32x2 w0, w1; w0.x = pk2(O[qb][0][4 * g] * inv, O[qb][0][4 * g + 1] * inv); w0.y = pk2(O[qb][0][4 * g + 2] * inv, O[qb][0][4 * g + 3] * inv);
      w1.x = pk2(O[qb][1][4 * g] * inv, O[qb][1][4 * g + 1] * inv); w1.y = pk2(O[qb][1][4 * g + 2] * inv, O[qb][1][4 * g + 3] * inv);
      *(u32x2*)(orow + 8 * g + 4 * h) = w0; *(u32x2*)(orow + 32 + 8 * g + 4 * h) = w1;
    }
  }
}

DI void phase_attn_even(const Params& p, LAS unsigned char* lds) {
  const bf16_t* H = (const bf16_t*)(p.ws + WS_H); const bf16_t* QB = (const bf16_t*)(p.ws + WS_QB); const bf16_t* KVB = (const bf16_t*)(p.ws + WS_KVB); bf16_t* Y = (bf16_t*)(p.ws + WS_Y);
  for (int u = blockIdx.x; u < 1280; u += gridDim.x) {
    AttnJob J; J.win = 0; J.qpos0 = 0; J.s1pos0 = 0; J.sink2 = 0.f; J.has_sink = 0; J.rope_cos = nullptr; J.rope_sin = nullptr;
    J.qg = p.ev_qa_g; J.cosh = (const float*)(p.ws + WS_TAB); J.sinh = J.cosh + 2048 * 32; J.qscale = 0.125f * LOG2E; J.q_rope = 0;
    int typeB, b, head, qrow0, s1n; const bool big = u < 1024; J.q_rope = big ? 1 : 0;
    if (big) { typeB = u >> 9; const int v = u & 511; b = v >> 5; head = (v >> 2) & 7; qrow0 = b * SEQ + (v & 3) * 512; s1n = SEQ; J.qpos0 = (v & 3) * 512;
      J.rope_cos = (const float*)(p.ws + WS_TAB) + 2 * 2048 * 32; J.rope_sin = J.rope_cos + 2048 * 16; }
    else { const int v = u - 1024; typeB = v >> 7; b = (v & 127) >> 3; head = v & 7; qrow0 = ML + b * CTX; s1n = 0; }
    J.s0row = ML + b * CTX; J.s0n = CTX; J.s1row = b * SEQ; J.s1n = s1n;
    if (!typeB) {
      J.Q = H + (size_t)qrow0 * EV_PITCH + head * 64; J.qp = EV_PITCH;
      J.K1 = H + 512 + (head >> 2) * 64; J.k1p = EV_PITCH; J.K2 = nullptr; J.k2p = 0;
      J.V = H + 640 + (head >> 2) * 64; J.vp = EV_PITCH;
      J.O = Y + (size_t)qrow0 * DM + head * 64; J.op = DM;
      if (big) attn_unit2<64>(J, lds); else attn_unit<64>(J, lds);
    } else {
      J.Q = QB + (size_t)qrow0 * 1792 + head * 96; J.qp = 1792;
      J.K1 = QB + 768 + head * 128; J.k1p = 1792; J.K2 = H + 1152; J.k2p = EV_PITCH;
      J.V = QB + 768 + head * 128 + 64; J.vp = 1792;
      J.O = Y + (size_t)qrow0 * DM + 512 + head * 64; J.op = DM;
      if (big) attn_unit2<96>(J, lds); else attn_unit<96>(J, lds);
    }
  }
}
DI void phase_attn_odd(const Params& p, LAS unsigned char* lds) {
  const bf16_t* H = (const bf16_t*)(p.ws + WS_H); bf16_t* Y = (bf16_t*)(p.ws + WS_Y);
  for (int u = blockIdx.x; u < 512; u += gridDim.x) {
    const int b = u >> 5, head = (u >> 2) & 7, q0 = (u & 3) * 512, qrow0 = b * SEQ + q0;
    const int lo = q0 - 128 < 0 ? 0 : q0 - 128, hi = q0 + 640 > SEQ ? SEQ : q0 + 640;
    AttnJob J; J.rope_cos = nullptr; J.rope_sin = nullptr; J.qg = nullptr; J.cosh = (const float*)(p.ws + WS_TAB); J.sinh = J.cosh + 2048 * 32; J.qscale = 0.125f * LOG2E; J.q_rope = 1; J.win = 1; J.qpos0 = q0; J.s1pos0 = lo; J.sink2 = p.od_sink[head] * LOG2E; J.has_sink = 1;
    J.s0row = ML + b * CTX; J.s0n = CTX; J.s1row = b * SEQ + lo; J.s1n = hi - lo;
    J.Q = H + (size_t)qrow0 * OD_PITCH + 1024 + head * 64; J.qp = OD_PITCH;
    J.K1 = H + 1536 + (head >> 2) * 64; J.k1p = OD_PITCH; J.K2 = nullptr; J.k2p = 0;
    J.V = H + 1664 + (head >> 2) * 64; J.vp = OD_PITCH;
    J.O = Y + (size_t)qrow0 * DM + 512 + head * 64; J.op = DM;
    attn_unit2<64>(J, lds);
  }
}
DI void phase_sgu(const Params& p, LAS unsigned char* lds) {
  constexpr int RP = 1040;
  const bf16_t* H = (const bf16_t*)(p.ws + WS_H); bf16_t* Y = (bf16_t*)(p.ws + WS_Y);
  const int tid = opaque_tid(), lane = tid & 63, g = tid >> 6, r32 = lane & 31, h = lane >> 5;
  const int q4 = (lane & 15) >> 2, p4 = lane & 3, blk = (lane >> 4) & 1;
  for (int u = blockIdx.x; u < 256; u += gridDim.x) {
    const int row0 = (u >> 4) * SEQ + (u & 15) * 128;
    __syncthreads();
    for (int i = tid; i < 128 * 64; i += NT) { const int r = i >> 6, ch = i & 63;
      *(LAS u32x4*)(lds + r * RP + ch * 16) = *(const u32x4*)(H + (size_t)(row0 + r) * OD_PITCH + 512 + ch * 8); }
    __syncthreads();
    f32x16 acc[4][2];
#pragma unroll
    for (int a = 0; a < 4; ++a) { acc[a][0] = (f32x16){}; acc[a][1] = (f32x16){}; }
    const float* wg = p.od_sgu_w + (size_t)g * 128 * 128;
#pragma unroll 1
    for (int s = 0; s < 8; ++s) {
      const LAS unsigned char* vb = lds + (16 * s + 4 * h + q4) * RP + (g * 64 + blk * 16 + 4 * p4) * 2;
      const s16x4 l0 = vtr(vb), h0 = vtr(vb + 8 * RP), l1 = vtr(vb + 64), h1 = vtr(vb + 64 + 8 * RP);
      const bf16x8 vf0 = __builtin_shufflevector(l0, h0, 0, 1, 2, 3, 4, 5, 6, 7), vf1 = __builtin_shufflevector(l1, h1, 0, 1, 2, 3, 4, 5, 6, 7);
#pragma unroll
      for (int pb = 0; pb < 4; ++pb) {
        const float* wp = wg + (size_t)(pb * 32 + r32) * 128 + 16 * s + 4 * h;
        const f32x4 w0 = *(const f32x4*)wp, w1 = *(const f32x4*)(wp + 8);
        u32x4 pw; pw.x = pk2(w0.x, w0.y); pw.y = pk2(w0.z, w0.w); pw.z = pk2(w1.x, w1.y); pw.w = pk2(w1.z, w1.w);
        const bf16x8 wf = __builtin_bit_cast(bf16x8, pw);
        acc[pb][0] = MFMA32(vf0, wf, acc[pb][0]); acc[pb][1] = MFMA32(vf1, wf, acc[pb][1]);
      }
    }
#pragma unroll
    for (int pb = 0; pb < 4; ++pb) {
      const int pp = pb * 32 + r32; const float bs = p.od_sgu_b[g * 128 + pp];
      const bf16_t* ur = H + (size_t)(row0 + pp) * OD_PITCH + g * 64; bf16_t* yr = Y + (size_t)(row0 + pp) * DM + g * 64;
#pragma unroll
      for (int db = 0; db < 2; ++db)
#pragma unroll
        for (int g4 = 0; g4 < 4; ++g4) { const int d0 = db * 32 + 8 * g4 + 4 * h;
          const u32x2 uu = *(const u32x2*)(ur + d0);
          const float y0 = geluf_(bflo(uu.x)) * (acc[pb][db][4 * g4] + bs), y1 = geluf_(bfhi(uu.x)) * (acc[pb][db][4 * g4 + 1] + bs);
          const float y2 = geluf_(bflo(uu.y)) * (acc[pb][db][4 * g4 + 2] + bs), y3 = geluf_(bfhi(uu.y)) * (acc[pb][db][4 * g4 + 3] + bs);
          u32x2 w; w.x = pk2(y0, y1); w.y = pk2(y2, y3); *(u32x2*)(yr + d0) = w; }
    }
  }
  __syncthreads();
}

#define GAS __attribute__((address_space(1)))
#define XB_TMO      128
#define XB_XCNT(j)  (256  + 64 * (j))
#define XB_XSUB(j)  (1280 + 64 * (j))
#define XB_XGEN(j)  (2304 + 64 * (j))
#define XB_TOP      3328
#define XB_TOPGEN   3392
#define XCD_BAR_WORDS 3456
#define XB_SPIN_CAP (1u << 18)

__device__ __forceinline__ unsigned xb_ld(unsigned* p)              { return __hip_atomic_load(p, __ATOMIC_RELAXED, __HIP_MEMORY_SCOPE_AGENT); }
__device__ __forceinline__ unsigned xb_add(unsigned* p, unsigned v) { return __hip_atomic_fetch_add(p, v, __ATOMIC_RELAXED, __HIP_MEMORY_SCOPE_AGENT); }
__device__ __forceinline__ unsigned xb_xcc_id() { return (unsigned)__builtin_amdgcn_s_getreg((3 << 11) | 20) & 0xFu; }
#define XB_SPIN(cond, bar) do { unsigned _sp = 0; while (cond) { __builtin_amdgcn_s_sleep(1); \
    if ((++_sp & 255u) == 0u) { if (xb_ld(&(bar)[XB_TMO])) break; if (_sp > XB_SPIN_CAP) { atomicAdd(&(bar)[XB_TMO], 1u); break; } } } } while (0)

struct XcdBarrier {
    unsigned* bar; unsigned x;
    volatile LAS unsigned* st;
};

__device__ __forceinline__ XcdBarrier xcd_barrier_post(unsigned* bar, volatile LAS unsigned* st) {
    XcdBarrier b; b.bar = bar; b.x = xb_xcc_id(); b.st = st;
    if (threadIdx.x == 0) (void)xb_add(&bar[XB_XCNT(b.x)], 1u);
    return b;
}
__device__ __forceinline__ void xcd_barrier_complete(unsigned* bar, unsigned x, unsigned& nloc, unsigned& nx) {
    const unsigned G = gridDim.x * gridDim.y * gridDim.z;
    unsigned sum, cnt, mine, sp = 0u;
    for (;;) {
        sum = 0u; cnt = 0u; mine = 0u;
#pragma unroll
        for (unsigned j = 0; j < 16; ++j) { const unsigned c = xb_ld(&bar[XB_XCNT(j)]); sum += c; cnt += (c > 0u) ? 1u : 0u; mine = (j == x) ? c : mine; }
        if (sum == G) break;
        __builtin_amdgcn_s_sleep(1);
        if ((++sp & 255u) == 0u) { if (xb_ld(&bar[XB_TMO])) break; if (sp > XB_SPIN_CAP) { atomicAdd(&bar[XB_TMO], 1u); break; } }
    }
    nloc = mine > 0u ? mine : 1u; nx = cnt > 0u ? cnt : 1u;
}

__device__ __forceinline__ void xcd_barrier(const XcdBarrier& b) {
    asm volatile("s_waitcnt vmcnt(0)" ::: "memory");
    __syncthreads();
    if (threadIdx.x == 0) {
        unsigned* bar = b.bar;
        __builtin_amdgcn_s_waitcnt(0);
        unsigned nloc = b.st[0], nx = b.st[1];
        if (nloc == 0u) { xcd_barrier_complete(bar, b.x, nloc, nx); b.st[0] = nloc; b.st[1] = nx; }
        const unsigned old = xb_add(&bar[XB_XSUB(b.x)], 1u);
        const unsigned gen = old / nloc;
        if (old + 1u == (gen + 1u) * nloc) {
            __builtin_amdgcn_fence(__ATOMIC_RELEASE, "agent");
            asm volatile("s_waitcnt vmcnt(0)" ::: "memory");
            const unsigned og = xb_add(&bar[XB_TOP], 1u);
            const unsigned tg = og / nx;
            if (og + 1u == (tg + 1u) * nx) xb_add(&bar[XB_TOPGEN], 1u);
            else XB_SPIN(xb_ld(&bar[XB_TOPGEN]) == tg, bar);
            __builtin_amdgcn_fence(__ATOMIC_ACQUIRE, "agent");
            xb_add(&bar[XB_XGEN(b.x)], 1u);
            asm volatile("s_waitcnt vmcnt(0)" ::: "memory");
        } else {
            XB_SPIN(xb_ld(&bar[XB_XGEN(b.x)]) == gen, bar);
            __builtin_amdgcn_fence(__ATOMIC_ACQUIRE, "agent");
            asm volatile("s_waitcnt vmcnt(0)" ::: "memory");
        }
    }
    __syncthreads();
}

constexpr size_t WS_BAR = 1 * MiB + 832 * 1024;
constexpr int LDS_BARST = 143360;

constexpr int LDS_BYTES = 147456;
#define GSYNC() do { XcdBarrier xb_; xb_.bar = (unsigned*)(ws_bar); xb_.x = xb_xcc_id(); xb_.st = (volatile LAS unsigned*)(lds + LDS_BARST); xcd_barrier(xb_); } while (0)
struct OdinOrder {
  pg8::StaticOrder S; int G, c;
  DI void init(int G_, int c_) { S.init(ML, OD_PITCH, G_, c_); G = G_; c = c_; }
  DI bool next(int i, pg8::Unit& u) const { const int L = i * G + c; if (L < 896) return S.next(i, u); if (L >= 912) return false; u.pm = 128 + (L - 896); u.pn = 6; return true; }
  DI void a_ready(const pg8::Unit&) const {}
  DI void done(const pg8::Unit&) const {}
};
template <class Epi> DI void run_gemm(LAS unsigned char* lds, const bf16_t* A, int lda, const bf16_t* Bt, int ldb, int M, int N, int K, const Epi& E) {
  pg8::Gemm g{A, Bt, M, N, K, lda, ldb}; pg8::StaticOrder S; S.init(M, N, (int)gridDim.x, (int)blockIdx.x);
  pg8::gemm_phase<Epi, pg8::StaticOrder, true, true>(lds, g, S, E);
}

typedef const unsigned long long __attribute__((address_space(4)))* kargp_t;
DI Params load_params(kargp_t q) { asm volatile("" : "+s"(q)); Params r; unsigned long long* d = (unsigned long long*)&r;
#pragma unroll
  for (int i = 0; i < 30; ++i) d[i] = q[i];
  return r; }
#define PH_BEGIN { const Params p = load_params(kp); unsigned char* ws = p.ws; (void)ws;
#ifdef PROBE_A
#define TSL ((LAS unsigned long long*)(lds + 143360))
#define PH_END } GSYNC(); if (blockIdx.x == 0 && threadIdx.x == 0) { const unsigned long long now_ = __builtin_amdgcn_s_memrealtime(); if (ph_id == PROBE_A) TSL[0] = now_; if (ph_id == PROBE_B) TSL[1] = now_; if (ph_id == PROBE_C) TSL[2] = now_; if (ph_id == PROBE_D) TSL[3] = now_; } ++ph_id;
#else
#define PH_END } GSYNC();
#endif
#define WSP(T, off) ((T*)(ws + (off)))
typedef pg8::EpiBf16<0> EB;

__global__ void __launch_bounds__(NT, 2) fwd_kernel(Params p_unused) {
  extern __shared__ __attribute__((aligned(16))) unsigned char lds_raw[];
  LAS unsigned char* lds = (LAS unsigned char*)lds_raw;
  cg::grid_group grid = cg::this_grid();
  const kargp_t kp = (kargp_t)__builtin_amdgcn_kernarg_segment_ptr();
  constexpr size_t MOD1 = WS_MOD + (size_t)17 * 6144 * 4;
#ifdef PROBE_A
  int ph_id = 0; if (blockIdx.x == 0 && threadIdx.x == 0) { const unsigned long long now_ = __builtin_amdgcn_s_memrealtime(); TSL[0] = now_; TSL[1] = now_; TSL[2] = now_; TSL[3] = now_; }
#endif

  unsigned* ws_bar;
  { const Params p = load_params(kp); ws_bar = (unsigned*)(p.ws + WS_BAR);
    if (threadIdx.x < 2) ((LAS unsigned*)(lds + LDS_BARST))[threadIdx.x] = 0u;
    __syncthreads();
    (void)xcd_barrier_post(ws_bar, (volatile LAS unsigned*)(lds + LDS_BARST));
    phase_prologue(p, lds); }
  grid.sync();
  PH_BEGIN phase_norm_mod(p.x, p.ctx, p.norm1_g, WSP(const float, WS_MOD), 0, 1, WSP(bf16_t, WS_Z), 0, MT); PH_END
  PH_BEGIN run_gemm(lds, WSP(const bf16_t, WS_Z), DM, WSP(const bf16_t, WS_W_EVIN), DM, MT, EV_PITCH, DM, EB{WSP(bf16_t, WS_H), EV_PITCH, nullptr, 0, 0, 1.f}); PH_END
  PH_BEGIN phase_post_even(p); PH_END
  PH_BEGIN run_gemm(lds, WSP(const bf16_t, WS_H) + 768, EV_PITCH, WSP(const bf16_t, WS_W_QUP), 384, MT, 1792, 384, EB{WSP(bf16_t, WS_QB), 1792, nullptr, 768, 768, 0.10206207261596577f * LOG2E}); PH_END
  PH_BEGIN phase_attn_even(p, lds); PH_END
  PH_BEGIN run_gemm(lds, WSP(const bf16_t, WS_Y), DM, WSP(const bf16_t, WS_W_EVOUT), DM, ML, DM, DM, EpiRes{p.x, p.ctx, p.out, WSP(float, WS_HC), WSP(const float, WS_MOD) + 2 * 1024, 0}); PH_END
  PH_BEGIN
    if (blockIdx.x < 64) { pg8::Gemm g{WSP(const bf16_t, WS_Y) + (size_t)ML * DM, WSP(const bf16_t, WS_W_EVOUT), MC, DM, DM, DM, DM}; pg8::StaticOrder S; S.init(MC, DM, 64, (int)blockIdx.x);
      pg8::gemm_phase<EpiRes, pg8::StaticOrder, true, true>(lds, g, S, EpiRes{p.x, p.ctx, p.out, WSP(float, WS_HC), WSP(const float, WS_MOD) + 2 * 1024, ML}); }
    else phase_norm_mod(p.out, WSP(const float, WS_HC), p.norm2_g, WSP(const float, WS_MOD), 3, 4, WSP(bf16_t, WS_Z), 0, ML, 64, (int)gridDim.x - 64);
  PH_END
  PH_BEGIN phase_norm_mod(p.out, WSP(const float, WS_HC), p.norm2_g, WSP(const float, WS_MOD), 3, 4, WSP(bf16_t, WS_Z), ML, MT); PH_END
  PH_BEGIN run_gemm(lds, WSP(const bf16_t, WS_Z), DM, WSP(const bf16_t, WS_W_UP), DM, MT, FF2, DM, EpiConv{WSP(bf16_t, WS_ACT), WSP(float, WS_HALO), p.ffn_conv_w, p.ffn_conv_b, (LAS float*)(lds + 131072)}); PH_END
  PH_BEGIN { pg8::StaticOrder S; S.init(ML, DM, (int)gridDim.x, (int)blockIdx.x); conv_fix_my_tiles(S, 0, WSP(const float, WS_HALO), WSP(bf16_t, WS_ACT), p.ffn_conv_w, p.ffn_conv_b); }
    run_gemm(lds, WSP(const bf16_t, WS_ACT), FF, WSP(const bf16_t, WS_W_DOWN), FF, ML, DM, FF, EpiRes{p.out, WSP(const float, WS_HC), p.out, WSP(float, WS_HC), WSP(const float, WS_MOD) + 5 * 1024, 0}); PH_END
  PH_BEGIN
    if (blockIdx.x < 64) { pg8::Gemm g{WSP(const bf16_t, WS_ACT) + (size_t)ML * FF, WSP(const bf16_t, WS_W_DOWN), MC, DM, FF, FF, FF}; pg8::StaticOrder S; S.init(MC, DM, 64, (int)blockIdx.x);
      conv_fix_my_tiles(S, 128, WSP(const float, WS_HALO), WSP(bf16_t, WS_ACT), p.ffn_conv_w, p.ffn_conv_b);
      pg8::gemm_phase<EpiRes, pg8::StaticOrder, true, true>(lds, g, S, EpiRes{p.out, WSP(const float, WS_HC), p.out, WSP(float, WS_HC), WSP(const float, WS_MOD) + 5 * 1024, ML}); }
    else phase_norm_mod(p.out, WSP(const float, WS_HC), p.norm1_g + DM, WSP(const float, MOD1), 0, 1, WSP(bf16_t, WS_Z), 0, ML, 64, (int)gridDim.x - 64);
  PH_END
  PH_BEGIN phase_norm_mod(p.out, WSP(const float, WS_HC), p.norm1_g + DM, WSP(const float, MOD1), 0, 1, WSP(bf16_t, WS_Z), ML, MT); PH_END
  PH_BEGIN { pg8::Gemm g{WSP(const bf16_t, WS_Z), WSP(const bf16_t, WS_W_ODIN), MT, OD_PITCH, DM, DM, DM}; OdinOrder S; S.init((int)gridDim.x, (int)blockIdx.x);
    pg8::gemm_phase<EB, OdinOrder, true, true>(lds, g, S, EB{WSP(bf16_t, WS_H), OD_PITCH, nullptr, 0, 0, 1.f}); } PH_END
  PH_BEGIN phase_post_odd(p); PH_END
  PH_BEGIN phase_sgu(p, lds); }
  PH_BEGIN phase_attn_odd(p, lds); PH_END
  PH_BEGIN run_gemm(lds, WSP(const bf16_t, WS_Y), DM, WSP(const bf16_t, WS_W_ODOUT), DM, ML, DM, DM, EpiRes{p.out, WSP(const float, WS_HC), p.out, WSP(float, WS_HC), WSP(const float, MOD1) + 2 * 1024, 0}); PH_END
  PH_BEGIN phase_norm_mod(p.out, WSP(const float, WS_HC), p.norm2_g + DM, WSP(const float, MOD1), 3, 4, WSP(bf16_t, WS_Z), 0, ML); PH_END
  PH_BEGIN run_gemm(lds, WSP(const bf16_t, WS_Z), DM, WSP(const bf16_t, WS_W_UP) + (size_t)FF2 * DM, DM, ML, FF2, DM, EpiConv{WSP(bf16_t, WS_ACT), WSP(float, WS_HALO), p.ffn_conv_w + 3 * FF2, p.ffn_conv_b + FF2, (LAS float*)(lds + 131072)}); PH_END
  PH_BEGIN { pg8::StaticOrder S; S.init(ML, DM, (int)gridDim.x, (int)blockIdx.x); conv_fix_my_tiles(S, 0, WSP(const float, WS_HALO), WSP(bf16_t, WS_ACT), p.ffn_conv_w + 3 * FF2, p.ffn_conv_b + FF2); }
    run_gemm(lds, WSP(const bf16_t, WS_ACT), FF, WSP(const bf16_t, WS_W_DOWN) + (size_t)DM * FF, FF, ML, DM, FF, EpiRes{p.out, WSP(const float, WS_HC), p.out, WSP(float, WS_HC), WSP(const float, MOD1) + 5 * 1024, 0}); PH_END
  { const Params p = load_params(kp); phase_final_norm(p.out, p.final_g); }
#ifdef PROBE_A
  { const Params p = load_params(kp); float* slot = (float*)(p.ws + WS_TAB + 900 * 1024);
    if (blockIdx.x == 0 && threadIdx.x == 0) { slot[0] = (float)(TSL[3] - TSL[2]) * 1e-4f; slot[1] = (float)(TSL[1] - TSL[0]) * 1e-4f; }
    GSYNC();
    const float d = *slot;
    for (int i = blockIdx.x * NT + threadIdx.x; i < (1 << 20); i += gridDim.x * NT) p.out[i] += (i == 0) ? slot[1] : d; }
#endif
}

extern "C" void kernel_launch(void* const* d_in, const int* in_sizes, int n_in, void* d_out, int out_size, void* d_ws, size_t ws_size, hipStream_t stream) {
  static int grid = 0;
  if (grid == 0) {
    int dev = 0, cus = 0, per_cu = 0;
    hipGetDevice(&dev); hipDeviceGetAttribute(&cus, hipDeviceAttributeMultiprocessorCount, dev);
    hipFuncSetAttribute((const void*)fwd_kernel, hipFuncAttributeMaxDynamicSharedMemorySize, LDS_BYTES);
    if (hipOccupancyMaxActiveBlocksPerMultiprocessor(&per_cu, (const void*)fwd_kernel, NT, LDS_BYTES) != hipSuccess || per_cu < 1) per_cu = 1;
    (void)hipGetLastError();
    if (cus <= 0) cus = 256;
    grid = cus;
  }
  Params p{};
  const float** f = (const float**)&p;
  for (int i = 0; i < 28; ++i) f[i] = (const float*)d_in[i];
  p.out = (float*)d_out; p.ws = (unsigned char*)d_ws;
  (void)hipMemsetAsync((unsigned char*)d_ws + WS_BAR, 0, XCD_BAR_WORDS * 4, stream);
  void* args[] = {&p};
  hipError_t e = hipLaunchCooperativeKernel((const void*)fwd_kernel, dim3(grid), dim3(NT), args, LDS_BYTES, stream);
  if (e != hipSuccess) fprintf(stderr, "cooperative launch failed: %s (grid %d)\n", hipGetErrorString(e), grid);
}
```

```cpp
#include <hip/hip_runtime.h>
#include <hip/hip_cooperative_groups.h>
#include <cstdio>
#include <cstdint>
namespace cg = cooperative_groups;
namespace pg8 {
#define PG8_LAS __attribute__((address_space(3)))
typedef unsigned short bf16_t;
typedef short bf16x8 __attribute__((ext_vector_type(8)));
typedef float f32x4 __attribute__((ext_vector_type(4)));
typedef unsigned u32x4 __attribute__((ext_vector_type(4)));
constexpr int BM = 256, BK = 64, HALF = 128, HTB = HALF * BK * 2  , STAGE_BYTES = 8 * HTB, NXCD = 8, WGM = 8;

__host__ __device__ __forceinline__ int lds_byte(int r, int c) { const int st = (r >> 4) * 2 + (c >> 5), rr = r & 15, cc = c & 31, ob = rr * 64 + cc * 2; return st * 1024 + (ob ^ (((ob >> 9) & 1) << 5)); }
__host__ __device__ __forceinline__ void stage_rc(int b, int& R, int& C) { const int st = b / 1024, sb = b % 1024, swz = sb ^ (((sb >> 9) & 1) << 5); R = (st >> 1) * 16 + swz / 64; C = (st & 1) * 32 + (swz % 64) / 2; }
__host__ __device__ __forceinline__ int perm32(int rho) { const int n = rho >> 4, i = rho & 15; return 8 * (i >> 2) + 4 * n + (i & 3); }

struct Unit { int pm, pn; };
struct Gemm { const bf16_t* A; const bf16_t* Bt; int M, N, K, lda, ldb; };

struct StaticOrder {
    int nM, nN, nwg, G, c;
    __host__ __device__ void init(int M, int N, int G_, int c_) { nM = M / BM; nN = N / BM; nwg = nM * nN; G = G_; c = c_; }
    __host__ __device__ bool next(int i, Unit& u) const {
        const long L = (long)i * G + c; if (L >= nwg) return false;
        int wgid = (int)L; { const int q = nwg / NXCD, r = nwg % NXCD, xcd = wgid % NXCD, off = wgid / NXCD; wgid = (xcd < r ? xcd * (q + 1) : r * (q + 1) + (xcd - r) * q) + off; }
        const int nig = WGM * nN, gid = wgid / nig, fm = gid * WGM, gsz = (nM - fm) < WGM ? (nM - fm) : WGM;
        u.pm = fm + ((wgid % nig) % gsz); u.pn = (wgid % nig) / gsz; return true;
    }
    __device__ __forceinline__ void a_ready(const Unit&) const {}
    __device__ __forceinline__ void done(const Unit&) const {}
};

__device__ __forceinline__ unsigned cvt_pk_bf16(float lo, float hi) { unsigned r; asm volatile("v_cvt_pk_bf16_f32 %0, %1, %2" : "=v"(r) : "v"(lo), "v"(hi)); return r; }
typedef float f32x2 __attribute__((ext_vector_type(2)));
__device__ __forceinline__ f32x2 gelu_pk(f32x2 v) {
    const f32x2 av = __builtin_elementwise_abs(v), d = av * 0.2316418882f + 1.0f;
    f32x2 t; t.x = __builtin_amdgcn_rcpf(d.x); t.y = __builtin_amdgcn_rcpf(d.y);
    f32x2 q = t * 0.5307027145f + (-0.7265760135f); q = q * t + 0.7107068705f; q = q * t + (-0.142248368f); q = q * t + 0.127414796f; q = q * t;
    const f32x2 s = (v * v) * (-0.72134752044f);
    f32x2 e; e.x = __builtin_amdgcn_exp2f(s.x); e.y = __builtin_amdgcn_exp2f(s.y);
    const f32x2 m = v * (q * e), r = v - m;
    f32x2 o; o.x = v.x < 0.f ? m.x : r.x; o.y = v.y < 0.f ? m.y : r.y; return o;
}

template <int ACT  > struct EpiBf16 {
    static constexpr bool PERM = true, AFTER_DRAIN = false; static_assert(ACT == 0 || ACT == 1, "EpiBf16: ACT is 0 (none) or 1 (gelu_pk)");
    bf16_t* O; int ldc; const float* bias; int split_cols; size_t split_stride; float scale0;
    __device__ __forceinline__ void operator()(const f32x4 (&acc)[2][2][4][2], const Unit& u, int wr, int wc, int fr, int fq) const {
        const int row0 = u.pm * BM + wr * 64 + fr; int colt = u.pn * BM; bf16_t* base = O;
        float sc = 1.f; if (split_cols) { const int t = colt / split_cols; base += (size_t)t * split_stride; colt -= t * split_cols; if (t == 0) sc = scale0; }
        const int col0 = colt + wc * 32 + 8 * fq, bcol0 = u.pn * BM + wc * 32 + 8 * fq;
        f32x4 bv[2][2];
#pragma unroll
        for (int bj = 0; bj < 2; ++bj)
#pragma unroll
            for (int n = 0; n < 2; ++n) bv[bj][n] = bias ? *(const f32x4*)(bias + bcol0 + bj * HALF + 4 * n) : (f32x4){0.f, 0.f, 0.f, 0.f};
#pragma unroll
        for (int ai = 0; ai < 2; ++ai)
#pragma unroll
            for (int m = 0; m < 4; ++m) { bf16_t* rowp = base + (size_t)(row0 + ai * HALF + m * 16) * ldc + col0;
#pragma unroll
                for (int bj = 0; bj < 2; ++bj) { f32x4 v0 = acc[ai][bj][m][0] + bv[bj][0], v1 = acc[ai][bj][m][1] + bv[bj][1];
                    if (ACT == 1) { f32x2 a = gelu_pk((f32x2){v0[0], v0[1]}), b = gelu_pk((f32x2){v0[2], v0[3]}), c = gelu_pk((f32x2){v1[0], v1[1]}), d = gelu_pk((f32x2){v1[2], v1[3]});
                        v0 = (f32x4){a.x, a.y, b.x, b.y}; v1 = (f32x4){c.x, c.y, d.x, d.y}; }
                    v0 = v0 * sc; v1 = v1 * sc; u32x4 w; w.x = cvt_pk_bf16(v0[0], v0[1]); w.y = cvt_pk_bf16(v0[2], v0[3]); w.z = cvt_pk_bf16(v1[0], v1[1]); w.w = cvt_pk_bf16(v1[2], v1[3]);
                    *(u32x4*)(rowp + bj * HALF) = w; } }
    }
};
template <class Epi, class Sched, bool ALIGN_EPI = false, bool SP2 = false>
__device__ __forceinline__ void gemm_phase(PG8_LAS unsigned char* lds, const Gemm g, const Sched& S, const Epi& E) {
    int tid_ = threadIdx.x; asm volatile("" : "+v"(tid_));
    const int tid = tid_, wid = __builtin_amdgcn_readfirstlane(tid >> 6), lane = tid & 63, wr = wid >> 2, wc = wid & 3, fr = lane & 15, fq = lane >> 4;
    const int K = g.K, nt = K / BK;
    unsigned voffA[2], voffB[2];
#pragma unroll
    for (int i = 0; i < 2; ++i) { int R, C; stage_rc(tid * 16 + i * 8192, R, C); const int Rb = Epi::PERM ? ((R & ~31) + perm32(R & 31)) : R;
        voffA[i] = (unsigned)(R * g.lda + C) * 2u; voffB[i] = (unsigned)(Rb * g.ldb + C) * 2u; }
    const size_t kstep = (size_t)(BK * 2);
    const size_t hstepA = (size_t)HALF * g.lda * 2, hstepB = (size_t)HALF * g.ldb * 2;
    const size_t tstepA = 2 * hstepA, tstepB = 2 * hstepB;
    const unsigned ldsw = (unsigned)wid * 1024u;
    const int aoff = lds_byte(wr * 64 + fr, fq * 8), boff = lds_byte(wc * 32 + fr, fq * 8);
#define PG8_SA(b, h) (((b) * 2 + (h)) * HTB)
#define PG8_SB(b, h) ((4 + (b) * 2 + (h)) * HTB)
#define PG8_STAGE(bufoff, gbase, voff) do { _Pragma("unroll") for (int _i = 0; _i < 2; ++_i) \
        __builtin_amdgcn_global_load_lds((const unsigned*)((const char*)(gbase) + (voff)[_i]), (PG8_LAS unsigned*)(lds + (bufoff) + ldsw + _i * 8192), 16, 0, 0); } while (0)
#define PG8_LDA(dst, b, h) do { _Pragma("unroll") for (int m = 0; m < 4; ++m) _Pragma("unroll") for (int k = 0; k < 2; ++k) dst[m][k] = *(const PG8_LAS bf16x8*)(lds + PG8_SA(b, h) + aoff + m * 2048 + k * 1024); } while (0)
#define PG8_LDB(dst, b, h) do { _Pragma("unroll") for (int n = 0; n < 2; ++n) _Pragma("unroll") for (int k = 0; k < 2; ++k) dst[n][k] = *(const PG8_LAS bf16x8*)(lds + PG8_SB(b, h) + boff + n * 2048 + k * 1024); } while (0)
#define PG8_MMA(ai, bj, At, Bt) do { __builtin_amdgcn_s_setprio(1); _Pragma("unroll") for (int m = 0; m < 4; ++m) _Pragma("unroll") for (int n = 0; n < 2; ++n) _Pragma("unroll") for (int k = 0; k < 2; ++k) \
        acc[ai][bj][m][n] = __builtin_amdgcn_mfma_f32_16x16x32_bf16(Bt[n][k], At[m][k], acc[ai][bj][m][n], 0, 0, 0); __builtin_amdgcn_s_setprio(0); } while (0)
#define PG8_WAIT_V(n) asm volatile("s_waitcnt vmcnt(" #n ")" ::: "memory")
#define PG8_WAIT_L(n) asm volatile("s_waitcnt lgkmcnt(" #n ")" ::: "memory")
#define PG8_BAR __builtin_amdgcn_s_barrier()
#define PG8_SCHED __builtin_amdgcn_sched_barrier(0)
    Unit cur, nxt; int ui = 0;
    if (!S.next(0, cur)) return;
    f32x4 acc[2][2][4][2];
#pragma unroll
    for (int a = 0; a < 2; ++a)
#pragma unroll
        for (int b = 0; b < 2; ++b)
#pragma unroll
            for (int m = 0; m < 4; ++m)
#pragma unroll
                for (int n = 0; n < 2; ++n) acc[a][b][m][n] = (f32x4){0.f, 0.f, 0.f, 0.f};
    bf16x8 At[4][2], B0[2][2], B1[2][2];
    const char* cA = (const char*)g.A + (size_t)cur.pm * tstepA; const char* cB = (const char*)g.Bt + (size_t)cur.pn * tstepB;
    S.a_ready(cur);
    if constexpr (SP2) {
        PG8_STAGE(PG8_SB(0, 0), cB, voffB); PG8_STAGE(PG8_SB(0, 1), cB + hstepB, voffB); PG8_STAGE(PG8_SA(0, 0), cA, voffA); PG8_STAGE(PG8_SA(0, 1), cA + hstepA, voffA);
        if (wr == 1) PG8_BAR;
        PG8_WAIT_V(2); PG8_BAR;
        PG8_STAGE(PG8_SB(1, 0), cB + kstep, voffB); PG8_STAGE(PG8_SA(1, 0), cA + kstep, voffA); PG8_STAGE(PG8_SB(1, 1), cB + hstepB + kstep, voffB);
        PG8_WAIT_V(6); PG8_BAR;
    } else {
        PG8_STAGE(PG8_SB(0, 0), cB, voffB); PG8_STAGE(PG8_SA(0, 0), cA, voffA); PG8_STAGE(PG8_SB(0, 1), cB + hstepB, voffB); PG8_STAGE(PG8_SA(0, 1), cA + hstepA, voffA);
        if (wr == 1) PG8_BAR;
        PG8_WAIT_V(4); PG8_BAR;
        PG8_STAGE(PG8_SB(1, 0), cB + kstep, voffB); PG8_STAGE(PG8_SA(1, 0), cA + kstep, voffA); PG8_STAGE(PG8_SB(1, 1), cB + hstepB + kstep, voffB);
        PG8_WAIT_V(6); PG8_BAR;
    }
    for (;;) {
        const bool has_next = S.next(ui + 1, nxt);
        const char* nA = has_next ? (const char*)g.A + (size_t)nxt.pm * tstepA : cA; const char* nB = has_next ? (const char*)g.Bt + (size_t)nxt.pn * tstepB : cB;
        for (int t = 0; t < nt; t += 2) {
            const bool last = (t == nt - 2);
            const char* a1 = cA + (size_t)(t + 1) * kstep;
            const char* a2 = last ? nA : cA + (size_t)(t + 2) * kstep; const char* b2 = last ? nB : cB + (size_t)(t + 2) * kstep;
            const char* a3 = a2 + kstep; const char* b3 = b2 + kstep;
            if (last && has_next) S.a_ready(nxt);
            if constexpr (SP2) {
            PG8_LDB(B0, 0, 0); PG8_LDB(B1, 0, 1); PG8_SCHED; PG8_LDA(At, 0, 0); PG8_STAGE(PG8_SA(1, 1), a1 + hstepA, voffA);
            PG8_WAIT_V(8); PG8_WAIT_L(0); PG8_BAR; PG8_MMA(0, 0, At, B0); PG8_MMA(0, 1, At, B1); PG8_BAR; PG8_SCHED;
            PG8_LDA(At, 0, 1); PG8_STAGE(PG8_SB(0, 0), b2, voffB); PG8_STAGE(PG8_SB(0, 1), b2 + hstepB, voffB); PG8_STAGE(PG8_SA(0, 0), a2, voffA);
            PG8_WAIT_V(8); PG8_WAIT_L(0); PG8_BAR; PG8_MMA(1, 0, At, B0); PG8_MMA(1, 1, At, B1); PG8_BAR; PG8_SCHED;
            PG8_LDB(B0, 1, 0); PG8_LDB(B1, 1, 1); PG8_SCHED; PG8_LDA(At, 1, 0); PG8_STAGE(PG8_SA(0, 1), a2 + hstepA, voffA);
            PG8_WAIT_V(8); PG8_WAIT_L(0); PG8_BAR; PG8_MMA(0, 0, At, B0); PG8_MMA(0, 1, At, B1); PG8_BAR; PG8_SCHED;
            PG8_LDA(At, 1, 1); PG8_STAGE(PG8_SB(1, 0), b3, voffB); PG8_STAGE(PG8_SB(1, 1), b3 + hstepB, voffB); PG8_STAGE(PG8_SA(1, 0), a3, voffA);
            PG8_WAIT_V(8); PG8_WAIT_L(0); PG8_BAR; PG8_MMA(1, 0, At, B0); PG8_MMA(1, 1, At, B1); PG8_BAR; PG8_SCHED;
            } else {
            PG8_LDB(B0, 0, 0); PG8_SCHED; PG8_LDA(At, 0, 0); PG8_STAGE(PG8_SA(1, 1), a1 + hstepA, voffA);
            PG8_WAIT_L(8); PG8_BAR; PG8_WAIT_L(0); PG8_MMA(0, 0, At, B0); PG8_BAR; PG8_SCHED;
            PG8_LDB(B1, 0, 1); PG8_STAGE(PG8_SB(0, 0), b2, voffB);
            PG8_BAR; PG8_WAIT_L(0); PG8_MMA(0, 1, At, B1); PG8_BAR;
            PG8_LDA(At, 0, 1); PG8_STAGE(PG8_SA(0, 0), a2, voffA);
            PG8_BAR; PG8_WAIT_L(0); PG8_MMA(1, 0, At, B0); PG8_BAR; PG8_SCHED;
            PG8_STAGE(PG8_SB(0, 1), b2 + hstepB, voffB);
            PG8_WAIT_V(6); PG8_BAR; PG8_MMA(1, 1, At, B1); PG8_BAR;
            PG8_LDB(B0, 1, 0); PG8_SCHED; PG8_LDA(At, 1, 0); PG8_STAGE(PG8_SA(0, 1), a2 + hstepA, voffA);
            PG8_WAIT_L(8); PG8_BAR; PG8_WAIT_L(0); PG8_MMA(0, 0, At, B0); PG8_BAR; PG8_SCHED;
            PG8_LDB(B1, 1, 1); PG8_STAGE(PG8_SB(1, 0), b3, voffB);
            PG8_BAR; PG8_WAIT_L(0); PG8_MMA(0, 1, At, B1); PG8_BAR;
            PG8_LDA(At, 1, 1); PG8_STAGE(PG8_SA(1, 0), a3, voffA);
            PG8_BAR; PG8_WAIT_L(0); PG8_MMA(1, 0, At, B0); PG8_BAR; PG8_SCHED;
            PG8_STAGE(PG8_SB(1, 1), b3 + hstepB, voffB);
            PG8_WAIT_V(6); PG8_BAR; PG8_MMA(1, 1, At, B1); PG8_BAR;
            }
        }
        if constexpr (ALIGN_EPI) { if (wr == 0) PG8_BAR; }
        if constexpr (!Epi::AFTER_DRAIN) { E(acc, cur, wr, wc, fr, fq); S.done(cur); }
        if (!has_next) break;
#pragma unroll
        for (int a = 0; a < 2; ++a)
#pragma unroll
            for (int b = 0; b < 2; ++b)
#pragma unroll
                for (int m = 0; m < 4; ++m)
#pragma unroll
                    for (int n = 0; n < 2; ++n) acc[a][b][m][n] = (f32x4){0.f, 0.f, 0.f, 0.f};
        cur = nxt; cA = nA; cB = nB; ++ui;
        if constexpr (ALIGN_EPI) { if (wr == 1) PG8_BAR; }
    }
    PG8_WAIT_V(0);
    if constexpr (!ALIGN_EPI) { if (wr == 0) PG8_BAR; }
    PG8_BAR;
    if constexpr (Epi::AFTER_DRAIN) { E.fused(acc, cur, wr, wc, fr, fq, lds, wid, lane); S.done(cur); }
#undef PG8_SA
#undef PG8_SB
#undef PG8_STAGE
#undef PG8_LDA
#undef PG8_LDB
#undef PG8_MMA
#undef PG8_WAIT_V
#undef PG8_WAIT_L
#undef PG8_BAR
#undef PG8_SCHED
}
}

#define LAS __attribute__((address_space(3)))
#define DI __device__ __forceinline__
typedef unsigned short bf16_t;
typedef short bf16x8 __attribute__((ext_vector_type(8)));
typedef short s16x4 __attribute__((ext_vector_type(4)));
typedef float f32x4 __attribute__((ext_vector_type(4)));
typedef float f32x16 __attribute__((ext_vector_type(16)));
typedef unsigned u32x4 __attribute__((ext_vector_type(4)));
typedef unsigned u32x2 __attribute__((ext_vector_type(2)));
typedef float f32x2_t __attribute__((ext_vector_type(2)));
typedef __bf16 bf16x2_t __attribute__((ext_vector_type(2)));

constexpr int NB = 16, SEQ = 2048, DM = 1024, CTX = 256;
constexpr int ML = NB * SEQ;
constexpr int MC = NB * CTX;
constexpr int MT = ML + MC;
constexpr int FF = 2816, FF2 = 5632;
constexpr int EV_IN = 1184, EV_PITCH = 1280, OD_PITCH = 1792;
constexpr float EPS = 1e-6f;
constexpr float LOG2E = 1.4426950408889634f;
constexpr int NT = 512;

constexpr size_t MiB = 1u << 20;
constexpr size_t WS_MOD = 0;
constexpr size_t WS_TAB = 1 * MiB;
constexpr size_t WS_W_EVIN = 2 * MiB;
constexpr size_t WS_W_QUP = 5 * MiB;
constexpr size_t WS_W_KVUP = 6 * MiB;
constexpr size_t WS_W_EVOUT = 7 * MiB;
constexpr size_t WS_W_ODIN = 9 * MiB;
constexpr size_t WS_W_ODOUT = 13 * MiB;
constexpr size_t WS_W_UP = 15 * MiB;
constexpr size_t WS_W_DOWN = 37 * MiB;
constexpr size_t WS_HC = 48 * MiB;
constexpr size_t WS_Z = 64 * MiB;
constexpr size_t WS_BIG = 136 * MiB;
constexpr size_t WS_H = WS_BIG;
constexpr size_t WS_QB = WS_BIG + 126 * MiB;
constexpr size_t WS_KVB = WS_BIG + 180 * MiB;
constexpr size_t WS_Y = WS_BIG + 252 * MiB;
constexpr size_t WS_ACT = WS_BIG;
constexpr size_t WS_HALO = WS_BIG + 200 * MiB;

struct Params {
  const float *x, *c, *ctx, *c_ctx, *mod_w, *mod_b, *norm1_g, *norm2_g;
  const float *ev_w_in, *ev_qa_g, *ev_ka_g, *ev_qlat_g, *ev_w_q_up, *ev_kvlat_g, *ev_w_kv_up, *ev_w_out;
  const float *od_w_in, *od_ln_g, *od_ln_b, *od_sgu_w, *od_sgu_b, *od_sink, *od_w_out;
  const float *ffn_up, *ffn_conv_w, *ffn_conv_b, *ffn_down, *final_g;
  float* out; unsigned char* ws;
};

DI float bf2f(unsigned short b) { return __uint_as_float(((unsigned)b) << 16); }
DI float bflo(unsigned w) { return __uint_as_float(w << 16); }
DI float bfhi(unsigned w) { return __uint_as_float(w & 0xffff0000u); }
DI unsigned pk2(float lo, float hi) { f32x2_t v = {lo, hi}; bf16x2_t b = __builtin_convertvector(v, bf16x2_t); return __builtin_bit_cast(unsigned, b); }
DI unsigned short f2bf(float f) { return (unsigned short)(pk2(f, 0.f) & 0xffffu); }
DI float wave_sum(float v) {
#pragma unroll
  for (int o = 1; o < 64; o <<= 1) v += __shfl_xor(v, o);
  return v;
}
DI float sigmoidf_(float x) { return 1.f / (1.f + __expf(-x)); }
DI float siluf_(float x) { return x * sigmoidf_(x); }
DI float geluf_(float x) { const float u = 1.5957691216057308f * (x + 0.044715f * x * x * x); return x * sigmoidf_(u); }
DI int crow(int r, int hi) { return (r & 3) + 8 * (r >> 2) + 4 * hi; }
DI int modrow(int row) { return row < ML ? (row >> 11) : 16; }
DI int xcd_vid() { const int G = gridDim.x, b = blockIdx.x; return (G % 8 == 0) ? (b % 8) * (G / 8) + b / 8 : b; }
DI int opaque_tid() { int t = threadIdx.x; asm volatile("" : "+v"(t)); return t; }

struct EpiRes {
  static constexpr bool PERM = false, AFTER_DRAIN = false;
  const float* baseL; const float* baseC; float* outL; float* outC; const float* gate;    int row0;
  DI void operator()(const pg8::f32x4 (&acc)[2][2][4][2], const pg8::Unit& u, int wr, int wc, int fr, int fq) const {
    const int rt = row0 + u.pm * 256; const bool lat = rt < ML; const int mr = lat ? (rt >> 11) : 16;
    const float* base = lat ? baseL + (size_t)rt * DM + u.pn * 256 : baseC + (size_t)(rt - ML) * DM + u.pn * 256;
    float* out = lat ? outL + (size_t)rt * DM + u.pn * 256 : outC + (size_t)(rt - ML) * DM + u.pn * 256;
    const float* gp = gate + (size_t)mr * 6144 + u.pn * 256;
    const int lo = (wr * 64 + fr) * DM + wc * 32 + 4 * fq;
    const int lc = wc * 32 + 4 * fq;
    pg8::f32x4 gv[2][2];
#pragma unroll
    for (int bj = 0; bj < 2; ++bj)
#pragma unroll
      for (int n = 0; n < 2; ++n) gv[bj][n] = *(const pg8::f32x4*)(gp + bj * 128 + n * 16 + lc);
    pg8::f32x4 cur[2][2], nxt[2][2];
#pragma unroll
    for (int bj = 0; bj < 2; ++bj)
#pragma unroll
      for (int n = 0; n < 2; ++n) cur[bj][n] = *(const pg8::f32x4*)(base + bj * 128 + n * 16 + lo);
#pragma unroll
    for (int g = 0; g < 8; ++g) {
      const int ai = g >> 2, mm = g & 3;
      if (g < 7) { const float* bp = base + (((g + 1) >> 2) * 128 + ((g + 1) & 3) * 16) * DM;
#pragma unroll
        for (int bj = 0; bj < 2; ++bj)
#pragma unroll
          for (int n = 0; n < 2; ++n) nxt[bj][n] = *(const pg8::f32x4*)(bp + bj * 128 + n * 16 + lo); }
      float* op = out + (ai * 128 + mm * 16) * DM;
#pragma unroll
      for (int bj = 0; bj < 2; ++bj)
#pragma unroll
        for (int n = 0; n < 2; ++n) *(pg8::f32x4*)(op + bj * 128 + n * 16 + lo) = cur[bj][n] + gv[bj][n] * acc[ai][bj][mm][n];
      asm volatile("" ::: "memory");
#pragma unroll
      for (int bj = 0; bj < 2; ++bj)
#pragma unroll
        for (int n = 0; n < 2; ++n) cur[bj][n] = nxt[bj][n];
    }
  }
};

DI float dpp_ror1(float v) { return __builtin_bit_cast(float, __builtin_amdgcn_update_dpp(0, __builtin_bit_cast(int, v), 0x121, 0xf, 0xf, true)); }
DI float dpp_rol1(float v) { return __builtin_bit_cast(float, __builtin_amdgcn_update_dpp(0, __builtin_bit_cast(int, v), 0x12F, 0xf, 0xf, true)); }
struct EpiConv {
  static constexpr bool PERM = true, AFTER_DRAIN = false;
  bf16_t* ACT; float* HALO; const float* cw; const float* cb; LAS float* edge;
  DI void operator()(const pg8::f32x4 (&acc)[2][2][4][2], const pg8::Unit& u, int wr, int wc, int fr, int fq) const {
    const int cl = wc * 32 + 8 * fq;
#pragma unroll
    for (int ai = 0; ai < 2; ++ai) {
      const int sl = 2 * ai + wr;
      if (fr == 0) {
#pragma unroll
        for (int bj = 0; bj < 2; ++bj)
#pragma unroll
          for (int n = 0; n < 2; ++n) *(LAS pg8::f32x4*)(edge + ((sl * 2 + 0) * 2 + bj) * 128 + cl + 4 * n) = acc[ai][bj][0][n];
      }
      if (fr == 15) {
#pragma unroll
        for (int bj = 0; bj < 2; ++bj)
#pragma unroll
          for (int n = 0; n < 2; ++n) *(LAS pg8::f32x4*)(edge + ((sl * 2 + 1) * 2 + bj) * 128 + cl + 4 * n) = acc[ai][bj][3][n];
      }
    }
    if (wr == 0 && fr < 2) {
#pragma unroll
      for (int bj = 0; bj < 2; ++bj)
#pragma unroll
        for (int n = 0; n < 2; ++n) *(pg8::f32x4*)(HALO + (size_t)(u.pm * 4 + fr) * FF2 + bj * FF + u.pn * 128 + cl + 4 * n) = acc[0][bj][0][n];
    }
    if (wr == 1 && fr >= 14) {
#pragma unroll
      for (int bj = 0; bj < 2; ++bj)
#pragma unroll
        for (int n = 0; n < 2; ++n) *(pg8::f32x4*)(HALO + (size_t)(u.pm * 4 + fr - 12) * FF2 + bj * FF + u.pn * 128 + cl + 4 * n) = acc[1][bj][3][n];
    }
    asm volatile("s_waitcnt lgkmcnt(0)" ::: "memory"); __builtin_amdgcn_s_barrier(); asm volatile("" ::: "memory");
    const pg8::f32x4 zero4 = {0.f, 0.f, 0.f, 0.f};
#pragma unroll
    for (int n = 0; n < 2; ++n) {
      const int ca = u.pn * 128 + cl + 4 * n;
      const pg8::f32x4 wa0 = *(const pg8::f32x4*)(cw + ca), wa1 = *(const pg8::f32x4*)(cw + FF2 + ca), wa2 = *(const pg8::f32x4*)(cw + 2 * FF2 + ca), ba = *(const pg8::f32x4*)(cb + ca);
      const pg8::f32x4 wg0 = *(const pg8::f32x4*)(cw + FF + ca), wg1 = *(const pg8::f32x4*)(cw + FF2 + FF + ca), wg2 = *(const pg8::f32x4*)(cw + 2 * FF2 + FF + ca), bg = *(const pg8::f32x4*)(cb + FF + ca);
#pragma unroll
      for (int ai = 0; ai < 2; ++ai) {
        const int sl = 2 * ai + wr;
        const pg8::f32x4 ua = sl > 0 ? *(const LAS pg8::f32x4*)(edge + (((sl - 1) * 2 + 1) * 2 + 0) * 128 + cl + 4 * n) : zero4;
        const pg8::f32x4 ug = sl > 0 ? *(const LAS pg8::f32x4*)(edge + (((sl - 1) * 2 + 1) * 2 + 1) * 128 + cl + 4 * n) : zero4;
        const pg8::f32x4 da = sl < 3 ? *(const LAS pg8::f32x4*)(edge + (((sl + 1) * 2 + 0) * 2 + 0) * 128 + cl + 4 * n) : zero4;
        const pg8::f32x4 dg = sl < 3 ? *(const LAS pg8::f32x4*)(edge + (((sl + 1) * 2 + 0) * 2 + 1) * 128 + cl + 4 * n) : zero4;
#pragma unroll
        for (int mm = 0; mm < 4; ++mm) {
          float o[4];
#pragma unroll
          for (int e = 0; e < 4; ++e) {
            const float ca_ = acc[ai][0][mm][n][e], cg_ = acc[ai][1][mm][n][e];
            const float pa = mm > 0 ? dpp_ror1(acc[ai][0][mm > 0 ? mm - 1 : 0][n][e]) : ua[e], pg = mm > 0 ? dpp_ror1(acc[ai][1][mm > 0 ? mm - 1 : 0][n][e]) : ug[e];
            const float na = mm < 3 ? dpp_rol1(acc[ai][0][mm < 3 ? mm + 1 : 3][n][e]) : da[e], ng = mm < 3 ? dpp_rol1(acc[ai][1][mm < 3 ? mm + 1 : 3][n][e]) : dg[e];
            const float rca = dpp_ror1(ca_), rcg = dpp_ror1(cg_), lca = dpp_rol1(ca_), lcg = dpp_rol1(cg_);
            const float upa = fr > 0 ? rca : pa, upg = fr > 0 ? rcg : pg;
            const float dna = fr < 15 ? lca : na, dng = fr < 15 ? lcg : ng;
            const float A = wa0[e] * upa + wa1[e] * ca_ + wa2[e] * dna + ba[e];
            const float G = wg0[e] * upg + wg1[e] * cg_ + wg2[e] * dng + bg[e];
            o[e] = siluf_(G) * A;
          }
          const int row = u.pm * 256 + ai * 128 + wr * 64 + mm * 16 + fr;
          u32x2 w; w.x = pk2(o[0], o[1]); w.y = pk2(o[2], o[3]);
          *(u32x2*)(ACT + (size_t)row * FF + ca) = w;
        }
      }
    }
  }
};
DI void phase_conv_fix(const float* HALO, bf16_t* ACT, const float* cw, const float* cb, int ntiles) {
  const int tid = opaque_tid(); const int total = ntiles * 2 * (FF / 4);
  for (int it = blockIdx.x * NT + tid; it < total; it += gridDim.x * NT) {
    const int j = (it % (FF / 4)) * 4, tr = it / (FF / 4), pm = tr >> 1, bot = tr & 1;
    const bool first = pm < 128 ? (pm & 7) == 0 : true, last = pm < 128 ? (pm & 7) == 7 : true;
    const float* hc = HALO + (size_t)(pm * 4 + (bot ? 3 : 0)) * FF2 + j;
    const float* hu = bot ? HALO + (size_t)(pm * 4 + 2) * FF2 + j : (first ? nullptr : HALO + (size_t)((pm - 1) * 4 + 3) * FF2 + j);
    const float* hd = bot ? (last ? nullptr : HALO + (size_t)((pm + 1) * 4 + 0) * FF2 + j) : HALO + (size_t)(pm * 4 + 1) * FF2 + j;
    const f32x4 z = {0.f, 0.f, 0.f, 0.f};
    const f32x4 ca_ = *(const f32x4*)hc, cg_ = *(const f32x4*)(hc + FF);
    const f32x4 ua = hu ? *(const f32x4*)hu : z, ug = hu ? *(const f32x4*)(hu + FF) : z, da = hd ? *(const f32x4*)hd : z, dg = hd ? *(const f32x4*)(hd + FF) : z;
    const f32x4 A = *(const f32x4*)(cw + j) * ua + *(const f32x4*)(cw + FF2 + j) * ca_ + *(const f32x4*)(cw + 2 * FF2 + j) * da + *(const f32x4*)(cb + j);
    const f32x4 G = *(const f32x4*)(cw + FF + j) * ug + *(const f32x4*)(cw + FF2 + FF + j) * cg_ + *(const f32x4*)(cw + 2 * FF2 + FF + j) * dg + *(const f32x4*)(cb + FF + j);
    u32x2 w; w.x = pk2(siluf_(G.x) * A.x, siluf_(G.y) * A.y); w.y = pk2(siluf_(G.z) * A.z, siluf_(G.w) * A.w);
    *(u32x2*)(ACT + (size_t)(pm * 256 + (bot ? 255 : 0)) * FF + j) = w;
  }
}

DI void conv_fix_tile(const float* HALO, bf16_t* ACT, const float* cw, const float* cb, int pm, int tid) {
  for (int it = tid; it < 2 * (FF / 4); it += NT) {
    const int j = (it % (FF / 4)) * 4, bot = it / (FF / 4);
    const bool first = pm < 128 ? (pm & 7) == 0 : true, last = pm < 128 ? (pm & 7) == 7 : true;
    const float* hc = HALO + (size_t)(pm * 4 + (bot ? 3 : 0)) * FF2 + j;
    const float* hu = bot ? HALO + (size_t)(pm * 4 + 2) * FF2 + j : (first ? nullptr : HALO + (size_t)((pm - 1) * 4 + 3) * FF2 + j);
    const float* hd = bot ? (last ? nullptr : HALO + (size_t)((pm + 1) * 4 + 0) * FF2 + j) : HALO + (size_t)(pm * 4 + 1) * FF2 + j;
    const f32x4 z = {0.f, 0.f, 0.f, 0.f};
    const f32x4 ca_ = *(const f32x4*)hc, cg_ = *(const f32x4*)(hc + FF);
    const f32x4 ua = hu ? *(const f32x4*)hu : z, ug = hu ? *(const f32x4*)(hu + FF) : z, da = hd ? *(const f32x4*)hd : z, dg = hd ? *(const f32x4*)(hd + FF) : z;
    const f32x4 A = *(const f32x4*)(cw + j) * ua + *(const f32x4*)(cw + FF2 + j) * ca_ + *(const f32x4*)(cw + 2 * FF2 + j) * da + *(const f32x4*)(cb + j);
    const f32x4 G = *(const f32x4*)(cw + FF + j) * ug + *(const f32x4*)(cw + FF2 + FF + j) * cg_ + *(const f32x4*)(cw + 2 * FF2 + FF + j) * dg + *(const f32x4*)(cb + FF + j);
    u32x2 w; w.x = pk2(siluf_(G.x) * A.x, siluf_(G.y) * A.y); w.y = pk2(siluf_(G.z) * A.z, siluf_(G.w) * A.w);
    *(u32x2*)(ACT + (size_t)(pm * 256 + (bot ? 255 : 0)) * FF + j) = w;
  }
}
DI void conv_fix_my_tiles(const pg8::StaticOrder& S, int pm_off, const float* HALO, bf16_t* ACT, const float* cw, const float* cb) {
  const int tid = opaque_tid(); pg8::Unit u; int lastpm = -1;
  for (int i = 0; S.next(i, u); ++i) if (u.pm != lastpm) { conv_fix_tile(HALO, ACT, cw, cb, pm_off + u.pm, tid); lastpm = u.pm; }
  asm volatile("s_waitcnt vmcnt(0)" ::: "memory"); __syncthreads();
}

DI void transpose_item(const float* W, int K, int N, bf16_t* WT, int row_off, LAS float* scr, int item, int lane, int ldo, int koff, bool UPPERM) {
  const int nblk = N / 32, kb = item / nblk, nb = item % nblk, k0 = 64 * kb, n0 = 32 * nb;
#pragma unroll 16
  for (int i = 0; i < 32; ++i) { const int kk = 2 * i + (lane >> 5); scr[kk * 33 + (lane & 31)] = W[(size_t)(k0 + kk) * N + n0 + (lane & 31)]; }
  asm volatile("s_waitcnt lgkmcnt(0)" ::: "memory");
  const int c = lane & 7;
#pragma unroll
  for (int j = 0; j < 4; ++j) { const int n = (lane >> 3) + 8 * j; const LAS float* s = scr + (8 * c) * 33 + n;
    u32x4 o; o.x = pk2(s[0 * 33], s[1 * 33]); o.y = pk2(s[2 * 33], s[3 * 33]); o.z = pk2(s[4 * 33], s[5 * 33]); o.w = pk2(s[6 * 33], s[7 * 33]);
    int drow = row_off + n0 + n;
    if (UPPERM) { const int ns = n0 + n, hg = ns >= FF ? 1 : 0, nn = ns - hg * FF; drow = row_off + (nn >> 7) * 256 + hg * 128 + (nn & 127); }
    *(u32x4*)(WT + (size_t)drow * ldo + koff + k0 + 8 * c) = o; }
  asm volatile("s_waitcnt lgkmcnt(0)" ::: "memory");
}

DI void phase_prologue(const Params& p, LAS unsigned char* lds) {
  const int tid = opaque_tid(), lane = tid & 63, wave = __builtin_amdgcn_readfirstlane(tid >> 6), G = gridDim.x;
  unsigned char* ws = p.ws;
  { float* COSH = (float*)(ws + WS_TAB); float* SINH = COSH + 2048 * 32; float* COSR = SINH + 2048 * 32; float* SINR = COSR + 2048 * 16;
    for (int i = blockIdx.x * NT + tid; i < 2048 * 32; i += G * NT) { const int t = i >> 5, f = i & 31; const float pos = (float)((f < 16) ? (t >> 6) : (t & 63));
      const float inv = powf(10000.f, -(float)(f & 15) / 16.f); const float a = pos * inv; COSH[i] = cosf(a); SINH[i] = sinf(a); }
    for (int i = blockIdx.x * NT + tid; i < 2048 * 16; i += G * NT) { const int t = i >> 4, f = i & 15; const float pos = (float)((f < 8) ? (t >> 6) : (t & 63));
      const float inv = powf(10000.f, -(float)(f & 7) / 8.f); const float a = pos * inv; COSR[i] = cosf(a); SINR[i] = sinf(a); }
  }
  constexpr int I1 = 16 * 37, I2 = 4 * 24, I3 = 2 * 32, I4 = 16 * 32, I5 = 16 * 56, I6 = 16 * 32, I7 = 16 * 176, I9 = 44 * 32;
  constexpr int NIT = I1 + I2 + I3 + I4 + I5 + I6 + 2 * I7 + 2 * I9;
  auto do_item = [&](int it, LAS float* scr) {
    int r = it; const float* W; bf16_t* WT; int K, N, ro = 0, ldo, ko = 0; bool up = false;
    if (r < I1) { W = p.ev_w_in; K = 1024; N = EV_IN; WT = (bf16_t*)(ws + WS_W_EVIN); ldo = 1024; }
    else if ((r -= I1) < I2) { W = p.ev_w_q_up; K = 256; N = 768; WT = (bf16_t*)(ws + WS_W_QUP); ldo = 384; }
    else if ((r -= I2) < I3) { W = p.ev_w_kv_up; K = 128; N = 1024; WT = (bf16_t*)(ws + WS_W_QUP); ro = 768; ldo = 384; ko = 256; }
    else if ((r -= I3) < I4) { W = p.ev_w_out; K = 1024; N = 1024; WT = (bf16_t*)(ws + WS_W_EVOUT); ldo = 1024; }
    else if ((r -= I4) < I5) { W = p.od_w_in; K = 1024; N = 1792; WT = (bf16_t*)(ws + WS_W_ODIN); ldo = 1024; }
    else if ((r -= I5) < I6) { W = p.od_w_out; K = 1024; N = 1024; WT = (bf16_t*)(ws + WS_W_ODOUT); ldo = 1024; }
    else if ((r -= I6) < I7) { W = p.ffn_up; K = 1024; N = FF2; WT = (bf16_t*)(ws + WS_W_UP); ldo = 1024; up = true; }
    else if ((r -= I7) < I7) { W = p.ffn_up + (size_t)1024 * FF2; K = 1024; N = FF2; WT = (bf16_t*)(ws + WS_W_UP) + (size_t)FF2 * 1024; ldo = 1024; up = true; }
    else if ((r -= I7) < I9) { W = p.ffn_down; K = FF; N = 1024; WT = (bf16_t*)(ws + WS_W_DOWN); ldo = FF; }
    else { r -= I9; W = p.ffn_down + (size_t)FF * 1024; K = FF; N = 1024; WT = (bf16_t*)(ws + WS_W_DOWN) + (size_t)1024 * FF; ldo = FF; }
    transpose_item(W, K, N, WT, ro, scr, r, lane, ldo, ko, up);
  };
  const int nGB = G < 192 ? G : 192;
  const int nTW = nGB * 4, NA = nTW * 7 < NIT ? nTW * 7 : NIT;
  { LAS float* s = (LAS float*)lds; LAS float* red = s + 17 * 1024; float* MOD = (float*)(ws + WS_MOD);
    for (int it = blockIdx.x; it < 192; it += G) {
      for (int i = tid; i < 17 * 1024; i += NT) { const int r = i >> 10, k = i & 1023; const float v = r < 16 ? p.c[r * 1024 + k] : p.c_ctx[k]; s[i] = siluf_(v); }
      __syncthreads();
      const int layer = it / 96, j0 = (it % 96) * 64;
      if (wave < 4) {
        const int cq = tid & 15, kg = tid >> 4;
        f32x4 acc[17];
#pragma unroll
        for (int r = 0; r < 17; ++r) acc[r] = (f32x4){0.f, 0.f, 0.f, 0.f};
        const float* w = p.mod_w + (size_t)layer * 1024 * 6144 + j0 + 4 * cq;
#pragma unroll 8
        for (int k = kg * 64; k < kg * 64 + 64; ++k) { const f32x4 wv = *(const f32x4*)(w + (size_t)k * 6144);
#pragma unroll
          for (int r = 0; r < 17; ++r) acc[r] += wv * s[r * 1024 + k]; }
#pragma unroll
        for (int r = 0; r < 17; ++r) {
#pragma unroll
          for (int e = 0; e < 4; ++e) { float v = acc[r][e]; v += __shfl_xor(v, 16); v += __shfl_xor(v, 32); acc[r][e] = v; }
          if ((lane >> 4) == 0) *(LAS f32x4*)(red + (wave * 17 + r) * 64 + 4 * cq) = acc[r]; }
      } else if (it == (int)blockIdx.x) {
        LAS float* scr = (LAS float*)(lds + 87040 + (wave - 4) * 8448);
        const int tw = blockIdx.x * 4 + (wave - 4);
        for (int j = 0; j < 7; ++j) { const int item = tw + j * nTW; if (item < NA) do_item(item, scr); }
      }
      __syncthreads();
      for (int o = tid; o < 17 * 64; o += NT) { const int r = o >> 6, j = o & 63; float sum = p.mod_b[layer * 6144 + j0 + j];
#pragma unroll
        for (int q = 0; q < 4; ++q) sum += red[(q * 17 + r) * 64 + j];
        MOD[((size_t)layer * 17 + r) * 6144 + j0 + j] = sum; }
      __syncthreads();
    }
  }
  __syncthreads();
  { LAS float* scr = (LAS float*)(lds + wave * 8448);
    const int gw = blockIdx.x * 8 + wave, NGW = G * 8;
    for (int it = NA + gw; it < NIT; it += NGW) do_item(it, scr);
    { bf16_t* wq = (bf16_t*)(ws + WS_W_QUP);
      for (int i = blockIdx.x * NT + tid; i < 768 * 16; i += G * NT) { const int r_ = i >> 4, c_ = i & 15; *(u32x4*)(wq + (size_t)r_ * 384 + 256 + c_ * 8) = (u32x4){0u, 0u, 0u, 0u}; }
      for (int i = blockIdx.x * NT + tid; i < 1024 * 32; i += G * NT) { const int r_ = 768 + (i >> 5), c_ = i & 31; *(u32x4*)(wq + (size_t)r_ * 384 + c_ * 8) = (u32x4){0u, 0u, 0u, 0u}; } }
    u32x4* z = (u32x4*)((bf16_t*)(ws + WS_W_EVIN) + (size_t)EV_IN * 1024);
    for (int i = blockIdx.x * NT + tid; i < (EV_PITCH - EV_IN) * 1024 / 8; i += G * NT) z[i] = (u32x4){0u, 0u, 0u, 0u};
  }
}

DI void phase_norm_mod(const float* srcL, const float* srcC, const float* g, const float* modl, int shiftIdx, int scaleIdx, bf16_t* Z, int rowBeg, int rowEnd, int blk0 = 0, int nblk = 0) {
  if (nblk == 0) nblk = gridDim.x;
  const int tid = opaque_tid(), lane = tid & 63, gw = ((int)blockIdx.x - blk0) * 8 + (tid >> 6), NGW = nblk * 8;
  for (int row0 = rowBeg + gw; row0 < rowEnd; row0 += 2 * NGW) {
    const int row1 = row0 + NGW; const bool has1 = row1 < rowEnd; const int r1 = has1 ? row1 : row0;
    const float* s0 = row0 < ML ? srcL + (size_t)row0 * DM : srcC + (size_t)(row0 - ML) * DM;
    const float* s1 = r1 < ML ? srcL + (size_t)r1 * DM : srcC + (size_t)(r1 - ML) * DM;
    f32x4 v0[4], v1[4];
#pragma unroll
    for (int j = 0; j < 4; ++j) { v0[j] = *(const f32x4*)(s0 + 4 * (64 * j + lane)); v1[j] = *(const f32x4*)(s1 + 4 * (64 * j + lane)); }
    float ss0 = 0.f, ss1 = 0.f;
#pragma unroll
    for (int j = 0; j < 4; ++j) { ss0 += (v0[j].x * v0[j].x + v0[j].y * v0[j].y) + (v0[j].z * v0[j].z + v0[j].w * v0[j].w); ss1 += (v1[j].x * v1[j].x + v1[j].y * v1[j].y) + (v1[j].z * v1[j].z + v1[j].w * v1[j].w); }
    const float q0 = rsqrtf(wave_sum(ss0) * (1.f / DM) + EPS), q1 = rsqrtf(wave_sum(ss1) * (1.f / DM) + EPS);
    const float* mp0 = modl + (size_t)modrow(row0) * 6144; const float* mp1 = modl + (size_t)modrow(r1) * 6144;
#pragma unroll
    for (int j = 0; j < 4; ++j) { const int k = 4 * (64 * j + lane);
      const f32x4 gg = *(const f32x4*)(g + k);
      { const f32x4 sc = *(const f32x4*)(mp0 + scaleIdx * 1024 + k), sh = *(const f32x4*)(mp0 + shiftIdx * 1024 + k);
        const f32x4 z = (v0[j] * q0) * gg * (sc + 1.f) + sh; u32x2 w; w.x = pk2(z.x, z.y); w.y = pk2(z.z, z.w); *(u32x2*)(Z + (size_t)row0 * DM + k) = w; }
      if (has1) { const f32x4 sc = *(const f32x4*)(mp1 + scaleIdx * 1024 + k), sh = *(const f32x4*)(mp1 + shiftIdx * 1024 + k);
        const f32x4 z = (v1[j] * q1) * gg * (sc + 1.f) + sh; u32x2 w; w.x = pk2(z.x, z.y); w.y = pk2(z.z, z.w); *(u32x2*)(Z + (size_t)row1 * DM + k) = w; }
    }
  }
}
DI void phase_final_norm(float* out, const float* g) {
  const int tid = opaque_tid(), lane = tid & 63, gw = blockIdx.x * 8 + (tid >> 6), NGW = gridDim.x * 8;
  for (int row = gw; row < ML; row += NGW) {
    float* src = out + (size_t)row * DM;
    f32x4 v[4]; float ss = 0.f;
#pragma unroll
    for (int j = 0; j < 4; ++j) { v[j] = *(const f32x4*)(src + 4 * (64 * j + lane)); ss += (v[j].x * v[j].x + v[j].y * v[j].y) + (v[j].z * v[j].z + v[j].w * v[j].w); }
    const float r = rsqrtf(wave_sum(ss) * (1.f / DM) + EPS);
#pragma unroll
    for (int j = 0; j < 4; ++j) { const int k = 4 * (64 * j + lane); const f32x4 gg = *(const f32x4*)(g + k); *(f32x4*)(src + k) = (v[j] * r) * gg; }
  }
}
DI void head_fix(bf16_t* base, int sub, const float* gain, bool norm, bool rope, const float* cs, const float* sn, float scale, bool doit) {
  const u32x2 a = *(const u32x2*)(base + 4 * sub), b = *(const u32x2*)(base + 32 + 4 * sub);
  float x1[4] = {bflo(a.x), bfhi(a.x), bflo(a.y), bfhi(a.y)}, x2[4] = {bflo(b.x), bfhi(b.x), bflo(b.y), bfhi(b.y)};
  if (norm) {
    float ss = 0.f;
#pragma unroll
    for (int j = 0; j < 4; ++j) ss += x1[j] * x1[j] + x2[j] * x2[j];
    ss += __shfl_xor(ss, 1); ss += __shfl_xor(ss, 2); ss += __shfl_xor(ss, 4);
    const float r = rsqrtf(ss * (1.f / 64.f) + EPS);
#pragma unroll
    for (int j = 0; j < 4; ++j) { x1[j] = x1[j] * r * gain[4 * sub + j]; x2[j] = x2[j] * r * gain[32 + 4 * sub + j]; }
  }
  if (rope) {
#pragma unroll
    for (int j = 0; j < 4; ++j) { const float c = cs[4 * sub + j], s = sn[4 * sub + j]; const float o1 = x1[j] * c - x2[j] * s, o2 = x1[j] * s + x2[j] * c; x1[j] = o1; x2[j] = o2; }
  }
  if (doit) {
    u32x2 wa, wb; wa.x = pk2(x1[0] * scale, x1[1] * scale); wa.y = pk2(x1[2] * scale, x1[3] * scale); wb.x = pk2(x2[0] * scale, x2[1] * scale); wb.y = pk2(x2[2] * scale, x2[3] * scale);
    *(u32x2*)(base + 4 * sub) = wa; *(u32x2*)(base + 32 + 4 * sub) = wb;
  }
}
DI void phase_post_even(const Params& p) {
  const int tid = opaque_tid(), lane = tid & 63, gw = blockIdx.x * 8 + (tid >> 6), NGW = gridDim.x * 8;
  bf16_t* H = (bf16_t*)(p.ws + WS_H);
  const float* COSH = (const float*)(p.ws + WS_TAB); const float* SINH = COSH + 2048 * 32; const float* COSR = SINH + 2048 * 32; const float* SINR = COSR + 2048 * 16;
  for (int row = gw; row < MT; row += NGW) {
    bf16_t* hr = H + (size_t)row * EV_PITCH; const bool lat = row < ML; const int t = row & (SEQ - 1);
    const int sub = lane & 7;
    head_fix(hr + 512 + ((lane >> 3) & 1) * 64, sub, p.ev_ka_g, true, lat, COSH + t * 32, SINH + t * 32, 1.f, lane < 16);
    {
      const u32x2 a = *(const u32x2*)(hr + 768 + 4 * lane); float x[4] = {bflo(a.x), bfhi(a.x), bflo(a.y), bfhi(a.y)};
      const float r = rsqrtf(wave_sum(x[0] * x[0] + x[1] * x[1] + x[2] * x[2] + x[3] * x[3]) * (1.f / 256.f) + EPS);
      const f32x4 g = *(const f32x4*)(p.ev_qlat_g + 4 * lane);
      u32x2 w; w.x = pk2(x[0] * r * g.x, x[1] * r * g.y); w.y = pk2(x[2] * r * g.z, x[3] * r * g.w); *(u32x2*)(hr + 768 + 4 * lane) = w; }
    {
      const unsigned a = *(const unsigned*)(hr + 1024 + 2 * lane); const float x0 = bflo(a), x1 = bfhi(a);
      const float r = rsqrtf(wave_sum(x0 * x0 + x1 * x1) * (1.f / 128.f) + EPS);
      *(unsigned*)(hr + 1024 + 2 * lane) = pk2(x0 * r * p.ev_kvlat_g[2 * lane], x1 * r * p.ev_kvlat_g[2 * lane + 1]); }
    if (lat && lane < 16) {
      const float x1 = bf2f(hr[1152 + lane]), x2 = bf2f(hr[1152 + 16 + lane]); const float c = COSR[t * 16 + lane], s = SINR[t * 16 + lane];
      hr[1152 + lane] = f2bf(x1 * c - x2 * s); hr[1152 + 16 + lane] = f2bf(x1 * s + x2 * c); }
  }
}
DI void phase_post_odd(const Params& p) {
  const int tid = opaque_tid(), lane = tid & 63, gw = blockIdx.x * 8 + (tid >> 6), NGW = gridDim.x * 8;
  bf16_t* H = (bf16_t*)(p.ws + WS_H);
  const float* COSH = (const float*)(p.ws + WS_TAB); const float* SINH = COSH + 2048 * 32;
  for (int row = gw; row < ML; row += NGW) {
    bf16_t* hr = H + (size_t)row * OD_PITCH; const int t = row & (SEQ - 1); const int sub = lane & 7;
    { const u32x4 a = *(const u32x4*)(hr + 512 + 8 * lane);
      float x[8] = {bflo(a.x), bfhi(a.x), bflo(a.y), bfhi(a.y), bflo(a.z), bfhi(a.z), bflo(a.w), bfhi(a.w)}; float s = 0.f;
#pragma unroll
      for (int j = 0; j < 8; ++j) { x[j] = geluf_(x[j]); s += x[j]; }
      const float mu = wave_sum(s) * (1.f / 512.f); float q = 0.f;
#pragma unroll
      for (int j = 0; j < 8; ++j) { x[j] -= mu; q += x[j] * x[j]; }
      const float r = rsqrtf(wave_sum(q) * (1.f / 512.f) + EPS);
      const f32x4 g0 = *(const f32x4*)(p.od_ln_g + 8 * lane), g1 = *(const f32x4*)(p.od_ln_g + 8 * lane + 4), b0 = *(const f32x4*)(p.od_ln_b + 8 * lane), b1 = *(const f32x4*)(p.od_ln_b + 8 * lane + 4);
      u32x4 w; w.x = pk2(x[0] * r * g0.x + b0.x, x[1] * r * g0.y + b0.y); w.y = pk2(x[2] * r * g0.z + b0.z, x[3] * r * g0.w + b0.w);
      w.z = pk2(x[4] * r * g1.x + b1.x, x[5] * r * g1.y + b1.y); w.w = pk2(x[6] * r * g1.z + b1.z, x[7] * r * g1.w + b1.w);
      *(u32x4*)(hr + 512 + 8 * lane) = w; }
    head_fix(hr + 1536 + ((lane >> 3) & 1) * 64, sub, nullptr, false, true, COSH + t * 32, SINH + t * 32, 1.f, lane < 16);
  }
}
DI void phase_conv_act(const bf16_t* HUP, bf16_t* ACT, const float* cw, const float* cb, int rbeg, int rend) {
  const long total = (long)(rend - rbeg) * 352; const int tid = opaque_tid();
  for (long it = (long)blockIdx.x * NT + tid; it < total; it += (long)gridDim.x * NT) {
    const int lr = (int)(it / 352), ch = (int)(it % 352), row = rbeg + lr, j = ch * 8;
    const int pos = row < ML ? (row & (SEQ - 1)) : ((row - ML) & (CTX - 1)); const int len = row < ML ? SEQ : CTX;
    const bf16_t* h = HUP + (size_t)lr * FF2 + j;
    const u32x4 z4 = {0u, 0u, 0u, 0u};
    const u32x4 a0 = pos > 0 ? *(const u32x4*)(h - FF2) : z4, a1 = *(const u32x4*)h, a2 = pos < len - 1 ? *(const u32x4*)(h + FF2) : z4;
    const u32x4 g0 = pos > 0 ? *(const u32x4*)(h - FF2 + FF) : z4, g1 = *(const u32x4*)(h + FF), g2 = pos < len - 1 ? *(const u32x4*)(h + FF2 + FF) : z4;
    float o[8];
#pragma unroll
    for (int e = 0; e < 8; ++e) {
      const unsigned wa0 = a0[e >> 1], wa1 = a1[e >> 1], wa2 = a2[e >> 1], wg0 = g0[e >> 1], wg1 = g1[e >> 1], wg2 = g2[e >> 1];
      const float xa0 = (e & 1) ? bfhi(wa0) : bflo(wa0), xa1 = (e & 1) ? bfhi(wa1) : bflo(wa1), xa2 = (e & 1) ? bfhi(wa2) : bflo(wa2);
      const float xg0 = (e & 1) ? bfhi(wg0) : bflo(wg0), xg1 = (e & 1) ? bfhi(wg1) : bflo(wg1), xg2 = (e & 1) ? bfhi(wg2) : bflo(wg2);
      const int ja = j + e, jg = FF + j + e;
      const float A = cw[ja] * xa0 + cw[FF2 + ja] * xa1 + cw[2 * FF2 + ja] * xa2 + cb[ja];
      const float Gv = cw[jg] * xg0 + cw[FF2 + jg] * xg1 + cw[2 * FF2 + jg] * xg2 + cb[jg];
      o[e] = siluf_(Gv) * A;
    }
    u32x4 w; w.x = pk2(o[0], o[1]); w.y = pk2(o[2], o[3]); w.z = pk2(o[4], o[5]); w.w = pk2(o[6], o[7]);
    *(u32x4*)(ACT + (size_t)lr * FF + j) = w;
  }
}

struct AttnJob { const bf16_t *Q, *K1, *K2, *V; bf16_t* O; int qp, k1p, k2p, vp, op; int s0row, s0n, s1row, s1n; int win, qpos0, s1pos0; float sink2; int has_sink; const float* rope_cos; const float* rope_sin; const float* qg; const float* cosh; const float* sinh; float qscale; int q_rope; };
DI s16x4 vtr(const LAS unsigned char* pp) { typedef short v4i16_t __attribute__((ext_vector_type(4))); return __builtin_bit_cast(s16x4, __builtin_amdgcn_ds_read_tr16_b64_v4i16((LAS v4i16_t*)pp)); }
#define MFMA32(a, b, c) __builtin_amdgcn_mfma_f32_32x32x16_bf16((a), (b), (c), 0, 0, 0)

DI void q_fix64(bf16x8 (&qf)[4], const AttnJob& J, int pos, int h) {
  float x[4][8];
#pragma unroll
  for (int s = 0; s < 4; ++s)
#pragma unroll
    for (int j = 0; j < 8; ++j) x[s][j] = bf2f((unsigned short)qf[s][j]);
  if (J.qg) {
    float ss = 0.f;
#pragma unroll
    for (int s = 0; s < 4; ++s)
#pragma unroll
      for (int j = 0; j < 8; ++j) ss += x[s][j] * x[s][j];
    ss += __shfl_xor(ss, 32);
    const float r = rsqrtf(ss * (1.f / 64.f) + EPS);
#pragma unroll
    for (int s = 0; s < 4; ++s) { const f32x4 g0 = *(const f32x4*)(J.qg + 16 * s + 8 * h), g1 = *(const f32x4*)(J.qg + 16 * s + 8 * h + 4);
#pragma unroll
      for (int j = 0; j < 4; ++j) { x[s][j] *= r * g0[j]; x[s][4 + j] *= r * g1[j]; } }
  }
  if (J.q_rope) {
#pragma unroll
    for (int s = 0; s < 2; ++s) { const float* cp = J.cosh + pos * 32 + 16 * s + 8 * h; const float* sp = J.sinh + pos * 32 + 16 * s + 8 * h;
      const f32x4 c0 = *(const f32x4*)cp, c1 = *(const f32x4*)(cp + 4), s0 = *(const f32x4*)sp, s1 = *(const f32x4*)(sp + 4);
#pragma unroll
      for (int j = 0; j < 8; ++j) { const float c = j < 4 ? c0[j & 3] : c1[j & 3], sn = j < 4 ? s0[j & 3] : s1[j & 3]; const float x1 = x[s][j], x2 = x[s + 2][j];
        x[s][j] = x1 * c - x2 * sn; x[s + 2][j] = x1 * sn + x2 * c; } }
  }
#pragma unroll
  for (int s = 0; s < 4; ++s) { u32x4 w; w.x = pk2(x[s][0] * J.qscale, x[s][1] * J.qscale); w.y = pk2(x[s][2] * J.qscale, x[s][3] * J.qscale);
    w.z = pk2(x[s][4] * J.qscale, x[s][5] * J.qscale); w.w = pk2(x[s][6] * J.qscale, x[s][7] * J.qscale); qf[s] = __builtin_bit_cast(bf16x8, w); }
}
template <int DK> DI void attn_unit(const AttnJob& J, LAS unsigned char* lds) {
  constexpr int KP = DK * 2 + 16, VP = 144, KBUF = 64 * KP, VBUF = 64 * VP, NS = DK / 16;
  const int tid = opaque_tid(), lane = tid & 63, wave = tid >> 6, r32 = lane & 31, h = lane >> 5;
  LAS unsigned char* Kl = lds; LAS unsigned char* Vl = lds + 2 * KBUF;
  const bf16_t* qrow = J.Q + (size_t)(wave * 32 + r32) * J.qp;
  bf16x8 qf[NS];
#pragma unroll
  for (int s = 0; s < NS; ++s) qf[s] = *(const bf16x8*)(qrow + 16 * s + 8 * h);
  if constexpr (DK == 64) q_fix64(qf, J, J.qpos0 + wave * 32 + r32, h);
  if (DK == 96) { if (J.rope_cos) {
    const float* cs = J.rope_cos + (J.qpos0 + wave * 32 + r32) * 16 + 8 * h; const float* sn = J.rope_sin + (J.qpos0 + wave * 32 + r32) * 16 + 8 * h;
#pragma unroll
    for (int j = 0; j < 8; ++j) { const float x1 = bf2f((unsigned short)qf[NS - 2][j]), x2 = bf2f((unsigned short)qf[NS - 1][j]); const float c = cs[j], s_ = sn[j];
      qf[NS - 2][j] = (short)f2bf(x1 * c - x2 * s_); qf[NS - 1][j] = (short)f2bf(x1 * s_ + x2 * c); } } }
  const int nt0 = J.s0n >> 6, nt = nt0 + (J.s1n >> 6);
  const int srow = tid >> 3, sch = tid & 7;
  const int s2row = (tid >> 2) & 63, s2ch = tid & 3;
  u32x4 rk, rv, rk2;
  auto tile_row = [&](int t) -> int { return t < nt0 ? J.s0row + 64 * t : J.s1row + 64 * (t - nt0); };
  auto gload = [&](int t) { const int kr0 = tile_row(t);
    rk = *(const u32x4*)(J.K1 + (size_t)(kr0 + srow) * J.k1p + sch * 8);
    rv = *(const u32x4*)(J.V + (size_t)(kr0 + srow) * J.vp + sch * 8);
    if (DK == 96) { if (tid < 256) rk2 = *(const u32x4*)(J.K2 + (size_t)(kr0 + s2row) * J.k2p + s2ch * 8); } };
  auto lstore = [&](int b) {
    *(LAS u32x4*)(Kl + b * KBUF + srow * KP + sch * 16) = rk;
    *(LAS u32x4*)(Vl + b * VBUF + srow * VP + sch * 16) = rv;
    if (DK == 96) { if (tid < 256) *(LAS u32x4*)(Kl + b * KBUF + s2row * KP + 128 + s2ch * 16) = rk2; } };
  gload(0); lstore(0); __syncthreads();
  float m = 0.f, lsum = 0.f; f32x16 O0 = {}, O1 = {};
  const int qpos = J.qpos0 + wave * 32 + r32, qmin = J.qpos0 + wave * 32;
  const int q4 = (lane & 15) >> 2, p4 = lane & 3, blk = (lane >> 4) & 1;
  for (int t = 0; t < nt; ++t) {
    if (t + 1 < nt) gload(t + 1);
    const LAS unsigned char* Kb = Kl + (t & 1) * KBUF; const LAS unsigned char* Vb = Vl + (t & 1) * VBUF;
    bool active = true; int kp0 = 0;
    if (J.win && t >= nt0) { kp0 = J.s1pos0 + 64 * (t - nt0); active = (kp0 + 63 >= qmin - 128) && (kp0 <= qmin + 31 + 128); }
    if (active) {
      f32x16 S0, S1;
#pragma unroll
      for (int i = 0; i < 16; ++i) { S0[i] = -m; S1[i] = -m; }
#pragma unroll
      for (int s = 0; s < NS; ++s) {
        const bf16x8 k0 = *(const LAS bf16x8*)(Kb + r32 * KP + (16 * s + 8 * h) * 2);
        const bf16x8 k1 = *(const LAS bf16x8*)(Kb + (32 + r32) * KP + (16 * s + 8 * h) * 2);
        S0 = MFMA32(k0, qf[s], S0); S1 = MFMA32(k1, qf[s], S1);
      }
      if (J.win && t >= nt0) {
#pragma unroll
        for (int i = 0; i < 16; ++i) { const int kpos = kp0 + crow(i, h); const int d0 = qpos - kpos, d1 = d0 - 32;
          if (d0 > 128 || d0 < -128) S0[i] = -1e30f; if (d1 > 128 || d1 < -128) S1[i] = -1e30f; }
      }
      float mx = fmaxf(S0[0], S1[0]);
#pragma unroll
      for (int i = 1; i < 16; ++i) mx = fmaxf(mx, fmaxf(S0[i], S1[i]));
      mx = fmaxf(mx, __shfl_xor(mx, 32));
      if (__any(mx > 6.0f)) {
        const float dl = fmaxf(mx, 0.f); m += dl; const float alpha = __builtin_amdgcn_exp2f(-dl); lsum *= alpha;
#pragma unroll
        for (int i = 0; i < 16; ++i) { S0[i] -= dl; S1[i] -= dl; O0[i] *= alpha; O1[i] *= alpha; }
      }
      float ps = 0.f;
#pragma unroll
      for (int i = 0; i < 16; ++i) { S0[i] = __builtin_amdgcn_exp2f(S0[i]); S1[i] = __builtin_amdgcn_exp2f(S1[i]); ps += S0[i] + S1[i]; }
      lsum += ps;
#pragma unroll
      for (int kb = 0; kb < 2; ++kb)
#pragma unroll
        for (int s2 = 0; s2 < 2; ++s2) {
          u32x4 pw;
          if (kb == 0) { pw.x = pk2(S0[8 * s2 + 0], S0[8 * s2 + 1]); pw.y = pk2(S0[8 * s2 + 2], S0[8 * s2 + 3]); pw.z = pk2(S0[8 * s2 + 4], S0[8 * s2 + 5]); pw.w = pk2(S0[8 * s2 + 6], S0[8 * s2 + 7]); }
          else         { pw.x = pk2(S1[8 * s2 + 0], S1[8 * s2 + 1]); pw.y = pk2(S1[8 * s2 + 2], S1[8 * s2 + 3]); pw.z = pk2(S1[8 * s2 + 4], S1[8 * s2 + 5]); pw.w = pk2(S1[8 * s2 + 6], S1[8 * s2 + 7]); }
          const bf16x8 pf = __builtin_bit_cast(bf16x8, pw);
          const LAS unsigned char* vb = Vb + (kb * 32 + 16 * s2 + 4 * h + q4) * VP + (blk * 16 + 4 * p4) * 2;
          { const s16x4 lo = vtr(vb), hi = vtr(vb + 8 * VP); const bf16x8 vf = __builtin_shufflevector(lo, hi, 0, 1, 2, 3, 4, 5, 6, 7); O0 = MFMA32(vf, pf, O0); }
          { const s16x4 lo = vtr(vb + 64), hi = vtr(vb + 64 + 8 * VP); const bf16x8 vf = __builtin_shufflevector(lo, hi, 0, 1, 2, 3, 4, 5, 6, 7); O1 = MFMA32(vf, pf, O1); }
        }
    }
    if (t + 1 < nt) lstore((t + 1) & 1);
    __syncthreads();
  }
  lsum += __shfl_xor(lsum, 32);
  if (J.has_sink) lsum += __builtin_amdgcn_exp2f(J.sink2 - m);
  const float inv = 1.f / lsum;
  bf16_t* orow = J.O + (size_t)(wave * 32 + r32) * J.op;
#pragma unroll
  for (int g = 0; g < 4; ++g) {
    u32x2 w0, w1; w0.x = pk2(O0[4 * g] * inv, O0[4 * g + 1] * inv); w0.y = pk2(O0[4 * g + 2] * inv, O0[4 * g + 3] * inv);
    w1.x = pk2(O1[4 * g] * inv, O1[4 * g + 1] * inv); w1.y = pk2(O1[4 * g + 2] * inv, O1[4 * g + 3] * inv);
    *(u32x2*)(orow + 8 * g + 4 * h) = w0; *(u32x2*)(orow + 32 + 8 * g + 4 * h) = w1;
  }
}

template <int DK> DI void attn_unit2(const AttnJob& J, LAS unsigned char* lds) {
  constexpr int KP = DK * 2 + 16, VP = 144, KBUF = 64 * KP, VBUF = 64 * VP, NS = DK / 16;
  const int tid = opaque_tid(), lane = tid & 63, wave = tid >> 6, r32 = lane & 31, h = lane >> 5;
  LAS unsigned char* Kl = lds; LAS unsigned char* Vl = lds + 2 * KBUF;
  bf16x8 qf[2][NS];
#pragma unroll
  for (int qb = 0; qb < 2; ++qb) {
    const bf16_t* qrow = J.Q + (size_t)(wave * 64 + qb * 32 + r32) * J.qp;
#pragma unroll
    for (int s = 0; s < NS; ++s) qf[qb][s] = *(const bf16x8*)(qrow + 16 * s + 8 * h);
    if constexpr (DK == 64) q_fix64(qf[qb], J, J.qpos0 + wave * 64 + qb * 32 + r32, h);
    if (DK == 96) { if (J.rope_cos) {
      const float* cs = J.rope_cos + (J.qpos0 + wave * 64 + qb * 32 + r32) * 16 + 8 * h; const float* sn = J.rope_sin + (J.qpos0 + wave * 64 + qb * 32 + r32) * 16 + 8 * h;
#pragma unroll
      for (int j = 0; j < 8; ++j) { const float x1 = bf2f((unsigned short)qf[qb][NS - 2][j]), x2 = bf2f((unsigned short)qf[qb][NS - 1][j]); const float c = cs[j], s_ = sn[j];
        qf[qb][NS - 2][j] = (short)f2bf(x1 * c - x2 * s_); qf[qb][NS - 1][j] = (short)f2bf(x1 * s_ + x2 * c); } } }
  }
  const int nt0 = J.s0n >> 6, nt = nt0 + (J.s1n >> 6);
  const int srow = tid >> 3, sch = tid & 7; const int s2row = (tid >> 2) & 63, s2ch = tid & 3;
  u32x4 rk, rv, rk2;
  auto tile_row = [&](int t) -> int { return t < nt0 ? J.s0row + 64 * t : J.s1row + 64 * (t - nt0); };
  auto gload = [&](int t) { const int kr0 = tile_row(t);
    rk = *(const u32x4*)(J.K1 + (size_t)(kr0 + srow) * J.k1p + sch * 8);
    rv = *(const u32x4*)(J.V + (size_t)(kr0 + srow) * J.vp + sch * 8);
    if (DK == 96) { if (tid < 256) rk2 = *(const u32x4*)(J.K2 + (size_t)(kr0 + s2row) * J.k2p + s2ch * 8); } };
  auto lstore = [&](int b) {
    *(LAS u32x4*)(Kl + b * KBUF + srow * KP + sch * 16) = rk;
    *(LAS u32x4*)(Vl + b * VBUF + srow * VP + sch * 16) = rv;
    if (DK == 96) { if (tid < 256) *(LAS u32x4*)(Kl + b * KBUF + s2row * KP + 128 + s2ch * 16) = rk2; } };
  gload(0); lstore(0); __syncthreads();
  float m[2] = {0.f, 0.f}, lsum[2] = {0.f, 0.f}; f32x16 O[2][2];
#pragma unroll
  for (int qb = 0; qb < 2; ++qb) { O[qb][0] = (f32x16){}; O[qb][1] = (f32x16){}; }
  const int q4 = (lane & 15) >> 2, p4 = lane & 3, blk = (lane >> 4) & 1;
  const int qmin = J.qpos0 + wave * 64;
  for (int t = 0; t < nt; ++t) {
    if (t + 1 < nt) gload(t + 1);
    const LAS unsigned char* Kb = Kl + (t & 1) * KBUF; const LAS unsigned char* Vb = Vl + (t & 1) * VBUF;
    bool active = true; int kp0 = 0;
    if (J.win && t >= nt0) { kp0 = J.s1pos0 + 64 * (t - nt0); active = (kp0 + 63 >= qmin - 128) && (kp0 <= qmin + 63 + 128); }
    if (active) {
    f32x16 S[2][2];
#pragma unroll
    for (int qb = 0; qb < 2; ++qb)
#pragma unroll
      for (int i = 0; i < 16; ++i) { S[qb][0][i] = -m[qb]; S[qb][1][i] = -m[qb]; }
#pragma unroll
    for (int s = 0; s < NS; ++s) {
      const bf16x8 k0 = *(const LAS bf16x8*)(Kb + r32 * KP + (16 * s + 8 * h) * 2);
      const bf16x8 k1 = *(const LAS bf16x8*)(Kb + (32 + r32) * KP + (16 * s + 8 * h) * 2);
#pragma unroll
      for (int qb = 0; qb < 2; ++qb) { S[qb][0] = MFMA32(k0, qf[qb][s], S[qb][0]); S[qb][1] = MFMA32(k1, qf[qb][s], S[qb][1]); }
    }
    if (J.win && t >= nt0) {
#pragma unroll
      for (int qb = 0; qb < 2; ++qb) { const int qpos = qmin + qb * 32 + r32;
#pragma unroll
        for (int i = 0; i < 16; ++i) { const int kpos = kp0 + crow(i, h); const int d0 = qpos - kpos, d1 = d0 - 32;
          if (d0 > 128 || d0 < -128) S[qb][0][i] = -1e30f; if (d1 > 128 || d1 < -128) S[qb][1][i] = -1e30f; } }
    }
#pragma unroll
    for (int qb = 0; qb < 2; ++qb) {
      float mx = fmaxf(S[qb][0][0], S[qb][1][0]);
#pragma unroll
      for (int i = 1; i < 16; ++i) mx = fmaxf(mx, fmaxf(S[qb][0][i], S[qb][1][i]));
      mx = fmaxf(mx, __shfl_xor(mx, 32));
      if (__any(mx > 6.0f)) {
        const float dl = fmaxf(mx, 0.f); m[qb] += dl; const float alpha = __builtin_amdgcn_exp2f(-dl); lsum[qb] *= alpha;
#pragma unroll
        for (int i = 0; i < 16; ++i) { S[qb][0][i] -= dl; S[qb][1][i] -= dl; O[qb][0][i] *= alpha; O[qb][1][i] *= alpha; }
      }
      float ps = 0.f;
#pragma unroll
      for (int i = 0; i < 16; ++i) { S[qb][0][i] = __builtin_amdgcn_exp2f(S[qb][0][i]); S[qb][1][i] = __builtin_amdgcn_exp2f(S[qb][1][i]); ps += S[qb][0][i] + S[qb][1][i]; }
      lsum[qb] += ps;
    }
#pragma unroll
    for (int kb = 0; kb < 2; ++kb)
#pragma unroll
      for (int s2 = 0; s2 < 2; ++s2) {
        const LAS unsigned char* vb = Vb + (kb * 32 + 16 * s2 + 4 * h + q4) * VP + (blk * 16 + 4 * p4) * 2;
        const s16x4 lo0 = vtr(vb), hi0 = vtr(vb + 8 * VP), lo1 = vtr(vb + 64), hi1 = vtr(vb + 64 + 8 * VP);
        const bf16x8 vf0 = __builtin_shufflevector(lo0, hi0, 0, 1, 2, 3, 4, 5, 6, 7), vf1 = __builtin_shufflevector(lo1, hi1, 0, 1, 2, 3, 4, 5, 6, 7);
#pragma unroll
        for (int qb = 0; qb < 2; ++qb) {
          u32x4 pw; pw.x = pk2(S[qb][kb][8 * s2 + 0], S[qb][kb][8 * s2 + 1]); pw.y = pk2(S[qb][kb][8 * s2 + 2], S[qb][kb][8 * s2 + 3]);
          pw.z = pk2(S[qb][kb][8 * s2 + 4], S[qb][kb][8 * s2 + 5]); pw.w = pk2(S[qb][kb][8 * s2 + 6], S[qb][kb][8 * s2 + 7]);
          const bf16x8 pf = __builtin_bit_cast(bf16x8, pw);
          O[qb][0] = MFMA32(vf0, pf, O[qb][0]); O[qb][1] = MFMA32(vf1, pf, O[qb][1]);
        }
      }
    }
    if (t + 1 < nt) lstore((t + 1) & 1);
    __syncthreads();
  }
#pragma unroll
  for (int qb = 0; qb < 2; ++qb) {
    float l = lsum[qb]; l += __shfl_xor(l, 32); if (J.has_sink) l += __builtin_amdgcn_exp2f(J.sink2 - m[qb]); const float inv = 1.f / l;
    bf16_t* orow = J.O + (size_t)(wave * 64 + qb * 32 + r32) * J.op;
#pragma unroll
    for (int g = 0; g < 4; ++g) {
      u32x2 w0, w1; w0.x = pk2(O[qb][0][4 * g] * inv, O[qb][0][4 * g + 1] * inv); w0.y = pk2(O[qb][0][4 * g + 2] * inv, O[qb][0][4 * g + 3] * inv);
      w1.x = pk2(O[qb][1][4 * g] * inv, O[qb][1][4 * g + 1] * inv); w1.y = pk2(O[qb][1][4 * g + 2] * inv, O[qb][1][4 * g + 3] * inv);
      *(u32x2*)(orow + 8 * g + 4 * h) = w0; *(u32x2*)(orow + 32 + 8 * g + 4 * h) = w1;
    }
  }
}

DI void phase_attn_even(const Params& p, LAS unsigned char* lds) {
  const bf16_t* H = (const bf16_t*)(p.ws + WS_H); const bf16_t* QB = (const bf16_t*)(p.ws + WS_QB); const bf16_t* KVB = (const bf16_t*)(p.ws + WS_KVB); bf16_t* Y = (bf16_t*)(p.ws + WS_Y);
  for (int u = xcd_vid(); u < 1280; u += gridDim.x) {
    AttnJob J; J.win = 0; J.qpos0 = 0; J.s1pos0 = 0; J.sink2 = 0.f; J.has_sink = 0; J.rope_cos = nullptr; J.rope_sin = nullptr;
    J.qg = p.ev_qa_g; J.cosh = (const float*)(p.ws + WS_TAB); J.sinh = J.cosh + 2048 * 32; J.qscale = 0.125f * LOG2E; J.q_rope = 0;
    int typeB, b, head, qrow0, s1n; const bool big = u < 1024; J.q_rope = big ? 1 : 0;
    if (big) { typeB = u >> 9; const int v = u & 511; b = v >> 5; head = (v >> 2) & 7; qrow0 = b * SEQ + (v & 3) * 512; s1n = SEQ; J.qpos0 = (v & 3) * 512;
      J.rope_cos = (const float*)(p.ws + WS_TAB) + 2 * 2048 * 32; J.rope_sin = J.rope_cos + 2048 * 16; }
    else { const int v = u - 1024; typeB = v >> 7; b = (v & 127) >> 3; head = v & 7; qrow0 = ML + b * CTX; s1n = 0; }
    J.s0row = ML + b * CTX; J.s0n = CTX; J.s1row = b * SEQ; J.s1n = s1n;
    if (!typeB) {
      J.Q = H + (size_t)qrow0 * EV_PITCH + head * 64; J.qp = EV_PITCH;
      J.K1 = H + 512 + (head >> 2) * 64; J.k1p = EV_PITCH; J.K2 = nullptr; J.k2p = 0;
      J.V = H + 640 + (head >> 2) * 64; J.vp = EV_PITCH;
      J.O = Y + (size_t)qrow0 * DM + head * 64; J.op = DM;
      if (big) attn_unit2<64>(J, lds); else attn_unit<64>(J, lds);
    } else {
      J.Q = QB + (size_t)qrow0 * 1792 + head * 96; J.qp = 1792;
      J.K1 = QB + 768 + head * 128; J.k1p = 1792; J.K2 = H + 1152; J.k2p = EV_PITCH;
      J.V = QB + 768 + head * 128 + 64; J.vp = 1792;
      J.O = Y + (size_t)qrow0 * DM + 512 + head * 64; J.op = DM;
      if (big) attn_unit2<96>(J, lds); else attn_unit<96>(J, lds);
    }
  }
}
DI void phase_attn_odd(const Params& p, LAS unsigned char* lds) {
  const bf16_t* H = (const bf16_t*)(p.ws + WS_H); bf16_t* Y = (bf16_t*)(p.ws + WS_Y);
  for (int u = xcd_vid(); u < 512; u += gridDim.x) {
    const int b = u >> 5, head = (u >> 2) & 7, q0 = (u & 3) * 512, qrow0 = b * SEQ + q0;
    const int lo = q0 - 128 < 0 ? 0 : q0 - 128, hi = q0 + 640 > SEQ ? SEQ : q0 + 640;
    AttnJob J; J.rope_cos = nullptr; J.rope_sin = nullptr; J.qg = nullptr; J.cosh = (const float*)(p.ws + WS_TAB); J.sinh = J.cosh + 2048 * 32; J.qscale = 0.125f * LOG2E; J.q_rope = 1; J.win = 1; J.qpos0 = q0; J.s1pos0 = lo; J.sink2 = p.od_sink[head] * LOG2E; J.has_sink = 1;
    J.s0row = ML + b * CTX; J.s0n = CTX; J.s1row = b * SEQ + lo; J.s1n = hi - lo;
    J.Q = H + (size_t)qrow0 * OD_PITCH + 1024 + head * 64; J.qp = OD_PITCH;
    J.K1 = H + 1536 + (head >> 2) * 64; J.k1p = OD_PITCH; J.K2 = nullptr; J.k2p = 0;
    J.V = H + 1664 + (head >> 2) * 64; J.vp = OD_PITCH;
    J.O = Y + (size_t)qrow0 * DM + 512 + head * 64; J.op = DM;
    attn_unit2<64>(J, lds);
  }
}
DI void phase_sgu(const Params& p, LAS unsigned char* lds) {
  constexpr int RP = 1056;
  const bf16_t* H = (const bf16_t*)(p.ws + WS_H); bf16_t* Y = (bf16_t*)(p.ws + WS_Y);
  const int tid = opaque_tid(), lane = tid & 63, g = tid >> 6, r32 = lane & 31, h = lane >> 5;
  const int q4 = (lane & 15) >> 2, p4 = lane & 3, blk = (lane >> 4) & 1;
  for (int u = blockIdx.x; u < 256; u += gridDim.x) {
    const int row0 = (u >> 4) * SEQ + (u & 15) * 128;
    __syncthreads();
    for (int i = tid; i < 128 * 64; i += NT) { const int r = i >> 6, ch = i & 63;
      *(LAS u32x4*)(lds + r * RP + ch * 16) = *(const u32x4*)(H + (size_t)(row0 + r) * OD_PITCH + 512 + ch * 8); }
    __syncthreads();
    f32x16 acc[4][2];
#pragma unroll
    for (int a = 0; a < 4; ++a) { acc[a][0] = (f32x16){}; acc[a][1] = (f32x16){}; }
    const float* wg = p.od_sgu_w + (size_t)g * 128 * 128;
#pragma unroll 1
    for (int s = 0; s < 8; ++s) {
      const LAS unsigned char* vb = lds + (16 * s + 4 * h + q4) * RP + (g * 64 + blk * 16 + 4 * p4) * 2;
      const s16x4 l0 = vtr(vb), h0 = vtr(vb + 8 * RP), l1 = vtr(vb + 64), h1 = vtr(vb + 64 + 8 * RP);
      const bf16x8 vf0 = __builtin_shufflevector(l0, h0, 0, 1, 2, 3, 4, 5, 6, 7), vf1 = __builtin_shufflevector(l1, h1, 0, 1, 2, 3, 4, 5, 6, 7);
#pragma unroll
      for (int pb = 0; pb < 4; ++pb) {
        const float* wp = wg + (size_t)(pb * 32 + r32) * 128 + 16 * s + 4 * h;
        const f32x4 w0 = *(const f32x4*)wp, w1 = *(const f32x4*)(wp + 8);
        u32x4 pw; pw.x = pk2(w0.x, w0.y); pw.y = pk2(w0.z, w0.w); pw.z = pk2(w1.x, w1.y); pw.w = pk2(w1.z, w1.w);
        const bf16x8 wf = __builtin_bit_cast(bf16x8, pw);
        acc[pb][0] = MFMA32(vf0, wf, acc[pb][0]); acc[pb][1] = MFMA32(vf1, wf, acc[pb][1]);
      }
    }
#pragma unroll
    for (int pb = 0; pb < 4; ++pb) {
      const int pp = pb * 32 + r32; const float bs = p.od_sgu_b[g * 128 + pp];
      const bf16_t* ur = H + (size_t)(row0 + pp) * OD_PITCH + g * 64; bf16_t* yr = Y + (size_t)(row0 + pp) * DM + g * 64;
#pragma unroll
      for (int db = 0; db < 2; ++db)
#pragma unroll
        for (int g4 = 0; g4 < 4; ++g4) { const int d0 = db * 32 + 8 * g4 + 4 * h;
          const u32x2 uu = *(const u32x2*)(ur + d0);
          const float y0 = geluf_(bflo(uu.x)) * (acc[pb][db][4 * g4] + bs), y1 = geluf_(bfhi(uu.x)) * (acc[pb][db][4 * g4 + 1] + bs);
          const float y2 = geluf_(bflo(uu.y)) * (acc[pb][db][4 * g4 + 2] + bs), y3 = geluf_(bfhi(uu.y)) * (acc[pb][db][4 * g4 + 3] + bs);
          u32x2 w; w.x = pk2(y0, y1); w.y = pk2(y2, y3); *(u32x2*)(yr + d0) = w; }
    }
  }
  __syncthreads();
}

#define GAS __attribute__((address_space(1)))
#define XB_TMO      128
#define XB_XCNT(j)  (256  + 64 * (j))
#define XB_XSUB(j)  (1280 + 64 * (j))
#define XB_XGEN(j)  (2304 + 64 * (j))
#define XB_TOP      3328
#define XB_TOPGEN   3392
#define XCD_BAR_WORDS 3456
#define XB_SPIN_CAP (1u << 18)

__device__ __forceinline__ unsigned xb_ld(unsigned* p)              { return __hip_atomic_load(p, __ATOMIC_RELAXED, __HIP_MEMORY_SCOPE_AGENT); }
__device__ __forceinline__ unsigned xb_add(unsigned* p, unsigned v) { return __hip_atomic_fetch_add(p, v, __ATOMIC_RELAXED, __HIP_MEMORY_SCOPE_AGENT); }
__device__ __forceinline__ unsigned xb_xcc_id() { return (unsigned)__builtin_amdgcn_s_getreg((3 << 11) | 20) & 0xFu; }
#define XB_SPIN(cond, bar) do { unsigned _sp = 0; while (cond) { __builtin_amdgcn_s_sleep(1); \
    if ((++_sp & 255u) == 0u) { if (xb_ld(&(bar)[XB_TMO])) break; if (_sp > XB_SPIN_CAP) { atomicAdd(&(bar)[XB_TMO], 1u); break; } } } } while (0)

struct XcdBarrier {
    unsigned* bar; unsigned x;
    volatile LAS unsigned* st;
};

__device__ __forceinline__ XcdBarrier xcd_barrier_post(unsigned* bar, volatile LAS unsigned* st) {
    XcdBarrier b; b.bar = bar; b.x = xb_xcc_id(); b.st = st;
    if (threadIdx.x == 0) (void)xb_add(&bar[XB_XCNT(b.x)], 1u);
    return b;
}
__device__ __forceinline__ void xcd_barrier_complete(unsigned* bar, unsigned x, unsigned& nloc, unsigned& nx) {
    const unsigned G = gridDim.x * gridDim.y * gridDim.z;
    unsigned sum, cnt, mine, sp = 0u;
    for (;;) {
        sum = 0u; cnt = 0u; mine = 0u;
#pragma unroll
        for (unsigned j = 0; j < 16; ++j) { const unsigned c = xb_ld(&bar[XB_XCNT(j)]); sum += c; cnt += (c > 0u) ? 1u : 0u; mine = (j == x) ? c : mine; }
        if (sum == G) break;
        __builtin_amdgcn_s_sleep(1);
        if ((++sp & 255u) == 0u) { if (xb_ld(&bar[XB_TMO])) break; if (sp > XB_SPIN_CAP) { atomicAdd(&bar[XB_TMO], 1u); break; } }
    }
    nloc = mine > 0u ? mine : 1u; nx = cnt > 0u ? cnt : 1u;
}

__device__ __forceinline__ void xcd_barrier(const XcdBarrier& b) {
    asm volatile("s_waitcnt vmcnt(0)" ::: "memory");
    __syncthreads();
    if (threadIdx.x == 0) {
        unsigned* bar = b.bar;
        __builtin_amdgcn_s_waitcnt(0);
        unsigned nloc = b.st[0], nx = b.st[1];
        if (nloc == 0u) { xcd_barrier_complete(bar, b.x, nloc, nx); b.st[0] = nloc; b.st[1] = nx; }
        const unsigned old = xb_add(&bar[XB_XSUB(b.x)], 1u);
        const unsigned gen = old / nloc;
        if (old + 1u == (gen + 1u) * nloc) {
            __builtin_amdgcn_fence(__ATOMIC_RELEASE, "agent");
            asm volatile("s_waitcnt vmcnt(0)" ::: "memory");
            const unsigned og = xb_add(&bar[XB_TOP], 1u);
            const unsigned tg = og / nx;
            if (og + 1u == (tg + 1u) * nx) xb_add(&bar[XB_TOPGEN], 1u);
            else XB_SPIN(xb_ld(&bar[XB_TOPGEN]) == tg, bar);
            __builtin_amdgcn_fence(__ATOMIC_ACQUIRE, "agent");
            xb_add(&bar[XB_XGEN(b.x)], 1u);
            asm volatile("s_waitcnt vmcnt(0)" ::: "memory");
        } else {
            XB_SPIN(xb_ld(&bar[XB_XGEN(b.x)]) == gen, bar);
            __builtin_amdgcn_fence(__ATOMIC_ACQUIRE, "agent");
            asm volatile("s_waitcnt vmcnt(0)" ::: "memory");
        }
    }
    __syncthreads();
}

constexpr size_t WS_BAR = 1 * MiB + 832 * 1024;
constexpr int LDS_BARST = 143360;

constexpr int LDS_BYTES = 147456;
#define GSYNC() do { XcdBarrier xb_; xb_.bar = (unsigned*)(ws_bar); xb_.x = xb_xcc_id(); xb_.st = (volatile LAS unsigned*)(lds + LDS_BARST); xcd_barrier(xb_); } while (0)
struct OdinOrder {
  pg8::StaticOrder S; int G, c;
  DI void init(int G_, int c_) { S.init(ML, OD_PITCH, G_, c_); G = G_; c = c_; }
  DI bool next(int i, pg8::Unit& u) const { const int L = i * G + c; if (L < 896) return S.next(i, u); if (L >= 912) return false; u.pm = 128 + (L - 896); u.pn = 6; return true; }
  DI void a_ready(const pg8::Unit&) const {}
  DI void done(const pg8::Unit&) const {}
};
template <class Epi> DI void run_gemm(LAS unsigned char* lds, const bf16_t* A, int lda, const bf16_t* Bt, int ldb, int M, int N, int K, const Epi& E) {
  pg8::Gemm g{A, Bt, M, N, K, lda, ldb}; pg8::StaticOrder S; S.init(M, N, (int)gridDim.x, (int)blockIdx.x);
  pg8::gemm_phase<Epi, pg8::StaticOrder, true, true>(lds, g, S, E);
}

typedef const unsigned long long __attribute__((address_space(4)))* kargp_t;
DI Params load_params(kargp_t q) { asm volatile("" : "+s"(q)); Params r; unsigned long long* d = (unsigned long long*)&r;
#pragma unroll
  for (int i = 0; i < 30; ++i) d[i] = q[i];
  return r; }
#define PH_BEGIN { const Params p = load_params(kp); unsigned char* ws = p.ws; (void)ws;
#ifdef PROBE_A
#define TSL ((LAS unsigned long long*)(lds + 143360))
#define PH_END } GSYNC(); if (blockIdx.x == 0 && threadIdx.x == 0) { const unsigned long long now_ = __builtin_amdgcn_s_memrealtime(); if (ph_id == PROBE_A) TSL[0] = now_; if (ph_id == PROBE_B) TSL[1] = now_; if (ph_id == PROBE_C) TSL[2] = now_; if (ph_id == PROBE_D) TSL[3] = now_; } ++ph_id;
#else
#define PH_END } GSYNC();
#endif
#define WSP(T, off) ((T*)(ws + (off)))
typedef pg8::EpiBf16<0> EB;

__global__ void __launch_bounds__(NT, 2) fwd_kernel(Params p_unused) {
  extern __shared__ __attribute__((aligned(16))) unsigned char lds_raw[];
  LAS unsigned char* lds = (LAS unsigned char*)lds_raw;
  cg::grid_group grid = cg::this_grid();
  const kargp_t kp = (kargp_t)__builtin_amdgcn_kernarg_segment_ptr();
  constexpr size_t MOD1 = WS_MOD + (size_t)17 * 6144 * 4;
#ifdef PROBE_A
  int ph_id = 0; if (blockIdx.x == 0 && threadIdx.x == 0) { const unsigned long long now_ = __builtin_amdgcn_s_memrealtime(); TSL[0] = now_; TSL[1] = now_; TSL[2] = now_; TSL[3] = now_; }
#endif

  unsigned* ws_bar;
  { const Params p = load_params(kp); ws_bar = (unsigned*)(p.ws + WS_BAR);
    if (threadIdx.x < 2) ((LAS unsigned*)(lds + LDS_BARST))[threadIdx.x] = 0u;
    __syncthreads();
    (void)xcd_barrier_post(ws_bar, (volatile LAS unsigned*)(lds + LDS_BARST));
    phase_prologue(p, lds); }
  GSYNC();
  if (p_unused.ws == nullptr) grid.sync();
  PH_BEGIN phase_norm_mod(p.x, p.ctx, p.norm1_g, WSP(const float, WS_MOD), 0, 1, WSP(bf16_t, WS_Z), 0, MT); PH_END
  PH_BEGIN run_gemm(lds, WSP(const bf16_t, WS_Z), DM, WSP(const bf16_t, WS_W_EVIN), DM, MT, EV_PITCH, DM, EB{WSP(bf16_t, WS_H), EV_PITCH, nullptr, 0, 0, 1.f}); PH_END
  PH_BEGIN phase_post_even(p); PH_END
  PH_BEGIN run_gemm(lds, WSP(const bf16_t, WS_H) + 768, EV_PITCH, WSP(const bf16_t, WS_W_QUP), 384, MT, 1792, 384, EB{WSP(bf16_t, WS_QB), 1792, nullptr, 768, 768, 0.10206207261596577f * LOG2E}); PH_END
  PH_BEGIN phase_attn_even(p, lds); PH_END
  PH_BEGIN run_gemm(lds, WSP(const bf16_t, WS_Y), DM, WSP(const bf16_t, WS_W_EVOUT), DM, ML, DM, DM, EpiRes{p.x, p.ctx, p.out, WSP(float, WS_HC), WSP(const float, WS_MOD) + 2 * 1024, 0}); PH_END
  PH_BEGIN
    if (blockIdx.x < 64) { pg8::Gemm g{WSP(const bf16_t, WS_Y) + (size_t)ML * DM, WSP(const bf16_t, WS_W_EVOUT), MC, DM, DM, DM, DM}; pg8::StaticOrder S; S.init(MC, DM, 64, (int)blockIdx.x);
      pg8::gemm_phase<EpiRes, pg8::StaticOrder, true, true>(lds, g, S, EpiRes{p.x, p.ctx, p.out, WSP(float, WS_HC), WSP(const float, WS_MOD) + 2 * 1024, ML}); }
    else phase_norm_mod(p.out, WSP(const float, WS_HC), p.norm2_g, WSP(const float, WS_MOD), 3, 4, WSP(bf16_t, WS_Z), 0, ML, 64, (int)gridDim.x - 64);
  PH_END
  PH_BEGIN phase_norm_mod(p.out, WSP(const float, WS_HC), p.norm2_g, WSP(const float, WS_MOD), 3, 4, WSP(bf16_t, WS_Z), ML, MT); PH_END
  PH_BEGIN run_gemm(lds, WSP(const bf16_t, WS_Z), DM, WSP(const bf16_t, WS_W_UP), DM, MT, FF2, DM, EpiConv{WSP(bf16_t, WS_ACT), WSP(float, WS_HALO), p.ffn_conv_w, p.ffn_conv_b, (LAS float*)(lds + 131072)}); PH_END
  PH_BEGIN { pg8::StaticOrder S; S.init(ML, DM, (int)gridDim.x, (int)blockIdx.x); conv_fix_my_tiles(S, 0, WSP(const float, WS_HALO), WSP(bf16_t, WS_ACT), p.ffn_conv_w, p.ffn_conv_b); }
    run_gemm(lds, WSP(const bf16_t, WS_ACT), FF, WSP(const bf16_t, WS_W_DOWN), FF, ML, DM, FF, EpiRes{p.out, WSP(const float, WS_HC), p.out, WSP(float, WS_HC), WSP(const float, WS_MOD) + 5 * 1024, 0}); PH_END
  PH_BEGIN
    if (blockIdx.x < 64) { pg8::Gemm g{WSP(const bf16_t, WS_ACT) + (size_t)ML * FF, WSP(const bf16_t, WS_W_DOWN), MC, DM, FF, FF, FF}; pg8::StaticOrder S; S.init(MC, DM, 64, (int)blockIdx.x);
      conv_fix_my_tiles(S, 128, WSP(const float, WS_HALO), WSP(bf16_t, WS_ACT), p.ffn_conv_w, p.ffn_conv_b);
      pg8::gemm_phase<EpiRes, pg8::StaticOrder, true, true>(lds, g, S, EpiRes{p.out, WSP(const float, WS_HC), p.out, WSP(float, WS_HC), WSP(const float, WS_MOD) + 5 * 1024, ML}); }
    else phase_norm_mod(p.out, WSP(const float, WS_HC), p.norm1_g + DM, WSP(const float, MOD1), 0, 1, WSP(bf16_t, WS_Z), 0, ML, 64, (int)gridDim.x - 64);
  PH_END
  PH_BEGIN phase_norm_mod(p.out, WSP(const float, WS_HC), p.norm1_g + DM, WSP(const float, MOD1), 0, 1, WSP(bf16_t, WS_Z), ML, MT); PH_END
  PH_BEGIN { pg8::Gemm g{WSP(const bf16_t, WS_Z), WSP(const bf16_t, WS_W_ODIN), MT, OD_PITCH, DM, DM, DM}; OdinOrder S; S.init((int)gridDim.x, (int)blockIdx.x);
    pg8::gemm_phase<EB, OdinOrder, true, true>(lds, g, S, EB{WSP(bf16_t, WS_H), OD_PITCH, nullptr, 0, 0, 1.f}); } PH_END
  PH_BEGIN phase_post_odd(p); PH_END
  PH_BEGIN phase_sgu(p, lds); }
  PH_BEGIN phase_attn_odd(p, lds); PH_END
  PH_BEGIN run_gemm(lds, WSP(const bf16_t, WS_Y), DM, WSP(const bf16_t, WS_W_ODOUT), DM, ML, DM, DM, EpiRes{p.out, WSP(const float, WS_HC), p.out, WSP(float, WS_HC), WSP(const float, MOD1) + 2 * 1024, 0}); PH_END
  PH_BEGIN phase_norm_mod(p.out, WSP(const float, WS_HC), p.norm2_g + DM, WSP(const float, MOD1), 3, 4, WSP(bf16_t, WS_Z), 0, ML); PH_END
  PH_BEGIN run_gemm(lds, WSP(const bf16_t, WS_Z), DM, WSP(const bf16_t, WS_W_UP) + (size_t)FF2 * DM, DM, ML, FF2, DM, EpiConv{WSP(bf16_t, WS_ACT), WSP(float, WS_HALO), p.ffn_conv_w + 3 * FF2, p.ffn_conv_b + FF2, (LAS float*)(lds + 131072)}); PH_END
  PH_BEGIN { pg8::StaticOrder S; S.init(ML, DM, (int)gridDim.x, (int)blockIdx.x); conv_fix_my_tiles(S, 0, WSP(const float, WS_HALO), WSP(bf16_t, WS_ACT), p.ffn_conv_w + 3 * FF2, p.ffn_conv_b + FF2); }
    run_gemm(lds, WSP(const bf16_t, WS_ACT), FF, WSP(const bf16_t, WS_W_DOWN) + (size_t)DM * FF, FF, ML, DM, FF, EpiRes{p.out, WSP(const float, WS_HC), p.out, WSP(float, WS_HC), WSP(const float, MOD1) + 5 * 1024, 0}); PH_END
  { const Params p = load_params(kp); phase_final_norm(p.out, p.final_g); }
#ifdef PROBE_A
  { const Params p = load_params(kp); float* slot = (float*)(p.ws + WS_TAB + 900 * 1024);
    if (blockIdx.x == 0 && threadIdx.x == 0) { slot[0] = (float)(TSL[3] - TSL[2]) * 1e-4f; slot[1] = (float)(TSL[1] - TSL[0]) * 1e-4f; }
    GSYNC();
    const float d = *slot;
    for (int i = blockIdx.x * NT + threadIdx.x; i < (1 << 20); i += gridDim.x * NT) p.out[i] += (i == 0) ? slot[1] : d; }
#endif
}

extern "C" void kernel_launch(void* const* d_in, const int* in_sizes, int n_in, void* d_out, int out_size, void* d_ws, size_t ws_size, hipStream_t stream) {
  static int grid = 0;
  if (grid == 0) {
    int dev = 0, cus = 0, per_cu = 0;
    hipGetDevice(&dev); hipDeviceGetAttribute(&cus, hipDeviceAttributeMultiprocessorCount, dev);
    hipFuncSetAttribute((const void*)fwd_kernel, hipFuncAttributeMaxDynamicSharedMemorySize, LDS_BYTES);
    if (hipOccupancyMaxActiveBlocksPerMultiprocessor(&per_cu, (const void*)fwd_kernel, NT, LDS_BYTES) != hipSuccess || per_cu < 1) per_cu = 1;
    (void)hipGetLastError();
    if (cus <= 0) cus = 256;
    grid = cus;
  }
  Params p{};
  const float** f = (const float**)&p;
  for (int i = 0; i < 28; ++i) f[i] = (const float*)d_in[i];
  p.out = (float*)d_out; p.ws = (unsigned char*)d_ws;
  (void)hipMemsetAsync((unsigned char*)d_ws + WS_BAR, 0, XCD_BAR_WORDS * 4, stream);
  void* args[] = {&p};
  hipError_t e = hipLaunchCooperativeKernel((const void*)fwd_kernel, dim3(grid), dim3(NT), args, LDS_BYTES, stream);
  if (e != hipSuccess) fprintf(stderr, "cooperative launch failed: %s (grid %d)\n", hipGetErrorString(e), grid);
}
```

```cpp
#include <hip/hip_runtime.h>
#include <hip/hip_cooperative_groups.h>
#include <cstdio>
#include <cstdint>
namespace cg = cooperative_groups;
namespace pg8 {
#define PG8_LAS __attribute__((address_space(3)))
typedef unsigned short bf16_t;
typedef short bf16x8 __attribute__((ext_vector_type(8)));
typedef float f32x4 __attribute__((ext_vector_type(4)));
typedef unsigned u32x4 __attribute__((ext_vector_type(4)));
constexpr int BM = 256, BK = 64, HALF = 128, HTB = HALF * BK * 2  , STAGE_BYTES = 8 * HTB, NXCD = 8, WGM = 8;

__host__ __device__ __forceinline__ int lds_byte(int r, int c) { const int st = (r >> 4) * 2 + (c >> 5), rr = r & 15, cc = c & 31, ob = rr * 64 + cc * 2; return st * 1024 + (ob ^ (((ob >> 9) & 1) << 5)); }
__host__ __device__ __forceinline__ void stage_rc(int b, int& R, int& C) { const int st = b / 1024, sb = b % 1024, swz = sb ^ (((sb >> 9) & 1) << 5); R = (st >> 1) * 16 + swz / 64; C = (st & 1) * 32 + (swz % 64) / 2; }
__host__ __device__ __forceinline__ int perm32(int rho) { const int n = rho >> 4, i = rho & 15; return 8 * (i >> 2) + 4 * n + (i & 3); }

struct Unit { int pm, pn; };
struct Gemm { const bf16_t* A; const bf16_t* Bt; int M, N, K, lda, ldb; };

struct StaticOrder {
    int nM, nN, nwg, G, c;
    __host__ __device__ void init(int M, int N, int G_, int c_) { nM = M / BM; nN = N / BM; nwg = nM * nN; G = G_; c = c_; }
    __host__ __device__ bool next(int i, Unit& u) const {
        const long L = (long)i * G + c; if (L >= nwg) return false;
        int wgid = (int)L; { const int q = nwg / NXCD, r = nwg % NXCD, xcd = wgid % NXCD, off = wgid / NXCD; wgid = (xcd < r ? xcd * (q + 1) : r * (q + 1) + (xcd - r) * q) + off; }
        const int nig = WGM * nN, gid = wgid / nig, fm = gid * WGM, gsz = (nM - fm) < WGM ? (nM - fm) : WGM;
        u.pm = fm + ((wgid % nig) % gsz); u.pn = (wgid % nig) / gsz; return true;
    }
    __device__ __forceinline__ void a_ready(const Unit&) const {}
    __device__ __forceinline__ void done(const Unit&) const {}
};

__device__ __forceinline__ unsigned cvt_pk_bf16(float lo, float hi) { unsigned r; asm volatile("v_cvt_pk_bf16_f32 %0, %1, %2" : "=v"(r) : "v"(lo), "v"(hi)); return r; }
typedef float f32x2 __attribute__((ext_vector_type(2)));
__device__ __forceinline__ f32x2 gelu_pk(f32x2 v) {
    const f32x2 av = __builtin_elementwise_abs(v), d = av * 0.2316418882f + 1.0f;
    f32x2 t; t.x = __builtin_amdgcn_rcpf(d.x); t.y = __builtin_amdgcn_rcpf(d.y);
    f32x2 q = t * 0.5307027145f + (-0.7265760135f); q = q * t + 0.7107068705f; q = q * t + (-0.142248368f); q = q * t + 0.127414796f; q = q * t;
    const f32x2 s = (v * v) * (-0.72134752044f);
    f32x2 e; e.x = __builtin_amdgcn_exp2f(s.x); e.y = __builtin_amdgcn_exp2f(s.y);
    const f32x2 m = v * (q * e), r = v - m;
    f32x2 o; o.x = v.x < 0.f ? m.x : r.x; o.y = v.y < 0.f ? m.y : r.y; return o;
}

template <int ACT  > struct EpiBf16 {
    static constexpr bool PERM = true, AFTER_DRAIN = false; static_assert(ACT == 0 || ACT == 1, "EpiBf16: ACT is 0 (none) or 1 (gelu_pk)");
    bf16_t* O; int ldc; const float* bias; int split_cols; size_t split_stride; float scale0;
    __device__ __forceinline__ void operator()(const f32x4 (&acc)[2][2][4][2], const Unit& u, int wr, int wc, int fr, int fq) const {
        const int row0 = u.pm * BM + wr * 64 + fr; int colt = u.pn * BM; bf16_t* base = O;
        float sc = 1.f; if (split_cols) { const int t = colt / split_cols; base += (size_t)t * split_stride; colt -= t * split_cols; if (t == 0) sc = scale0; }
        const int col0 = colt + wc * 32 + 8 * fq, bcol0 = u.pn * BM + wc * 32 + 8 * fq;
        f32x4 bv[2][2];
#pragma unroll
        for (int bj = 0; bj < 2; ++bj)
#pragma unroll
            for (int n = 0; n < 2; ++n) bv[bj][n] = bias ? *(const f32x4*)(bias + bcol0 + bj * HALF + 4 * n) : (f32x4){0.f, 0.f, 0.f, 0.f};
#pragma unroll
        for (int ai = 0; ai < 2; ++ai)
#pragma unroll
            for (int m = 0; m < 4; ++m) { bf16_t* rowp = base + (size_t)(row0 + ai * HALF + m * 16) * ldc + col0;
#pragma unroll
                for (int bj = 0; bj < 2; ++bj) { f32x4 v0 = acc[ai][bj][m][0] + bv[bj][0], v1 = acc[ai][bj][m][1] + bv[bj][1];
                    if (ACT == 1) { f32x2 a = gelu_pk((f32x2){v0[0], v0[1]}), b = gelu_pk((f32x2){v0[2], v0[3]}), c = gelu_pk((f32x2){v1[0], v1[1]}), d = gelu_pk((f32x2){v1[2], v1[3]});
                        v0 = (f32x4){a.x, a.y, b.x, b.y}; v1 = (f32x4){c.x, c.y, d.x, d.y}; }
                    v0 = v0 * sc; v1 = v1 * sc; u32x4 w; w.x = cvt_pk_bf16(v0[0], v0[1]); w.y = cvt_pk_bf16(v0[2], v0[3]); w.z = cvt_pk_bf16(v1[0], v1[1]); w.w = cvt_pk_bf16(v1[2], v1[3]);
                    *(u32x4*)(rowp + bj * HALF) = w; } }
    }
};
template <class Epi, class Sched, bool ALIGN_EPI = false, bool SP2 = false>
__device__ __forceinline__ void gemm_phase(PG8_LAS unsigned char* lds, const Gemm g, const Sched& S, const Epi& E) {
    int tid_ = threadIdx.x; asm volatile("" : "+v"(tid_));
    const int tid = tid_, wid = __builtin_amdgcn_readfirstlane(tid >> 6), lane = tid & 63, wr = wid >> 2, wc = wid & 3, fr = lane & 15, fq = lane >> 4;
    const int K = g.K, nt = K / BK;
    unsigned voffA[2], voffB[2];
#pragma unroll
    for (int i = 0; i < 2; ++i) { int R, C; stage_rc(tid * 16 + i * 8192, R, C); const int Rb = Epi::PERM ? ((R & ~31) + perm32(R & 31)) : R;
        voffA[i] = (unsigned)(R * g.lda + C) * 2u; voffB[i] = (unsigned)(Rb * g.ldb + C) * 2u; }
    const size_t kstep = (size_t)(BK * 2);
    const size_t hstepA = (size_t)HALF * g.lda * 2, hstepB = (size_t)HALF * g.ldb * 2;
    const size_t tstepA = 2 * hstepA, tstepB = 2 * hstepB;
    const unsigned ldsw = (unsigned)wid * 1024u;
    const int aoff = lds_byte(wr * 64 + fr, fq * 8), boff = lds_byte(wc * 32 + fr, fq * 8);
#define PG8_SA(b, h) (((b) * 2 + (h)) * HTB)
#define PG8_SB(b, h) ((4 + (b) * 2 + (h)) * HTB)
#define PG8_STAGE(bufoff, gbase, voff) do { _Pragma("unroll") for (int _i = 0; _i < 2; ++_i) \
        __builtin_amdgcn_global_load_lds((const unsigned*)((const char*)(gbase) + (voff)[_i]), (PG8_LAS unsigned*)(lds + (bufoff) + ldsw + _i * 8192), 16, 0, 0); } while (0)
#define PG8_LDA(dst, b, h) do { _Pragma("unroll") for (int m = 0; m < 4; ++m) _Pragma("unroll") for (int k = 0; k < 2; ++k) dst[m][k] = *(const PG8_LAS bf16x8*)(lds + PG8_SA(b, h) + aoff + m * 2048 + k * 1024); } while (0)
#define PG8_LDB(dst, b, h) do { _Pragma("unroll") for (int n = 0; n < 2; ++n) _Pragma("unroll") for (int k = 0; k < 2; ++k) dst[n][k] = *(const PG8_LAS bf16x8*)(lds + PG8_SB(b, h) + boff + n * 2048 + k * 1024); } while (0)
#define PG8_MMA(ai, bj, At, Bt) do { __builtin_amdgcn_s_setprio(1); _Pragma("unroll") for (int m = 0; m < 4; ++m) _Pragma("unroll") for (int n = 0; n < 2; ++n) _Pragma("unroll") for (int k = 0; k < 2; ++k) \
        acc[ai][bj][m][n] = __builtin_amdgcn_mfma_f32_16x16x32_bf16(Bt[n][k], At[m][k], acc[ai][bj][m][n], 0, 0, 0); __builtin_amdgcn_s_setprio(0); } while (0)
#define PG8_WAIT_V(n) asm volatile("s_waitcnt vmcnt(" #n ")" ::: "memory")
#define PG8_WAIT_L(n) asm volatile("s_waitcnt lgkmcnt(" #n ")" ::: "memory")
#define PG8_BAR __builtin_amdgcn_s_barrier()
#define PG8_SCHED __builtin_amdgcn_sched_barrier(0)
    Unit cur, nxt; int ui = 0;
    if (!S.next(0, cur)) return;
    f32x4 acc[2][2][4][2];
#pragma unroll
    for (int a = 0; a < 2; ++a)
#pragma unroll
        for (int b = 0; b < 2; ++b)
#pragma unroll
            for (int m = 0; m < 4; ++m)
#pragma unroll
                for (int n = 0; n < 2; ++n) acc[a][b][m][n] = (f32x4){0.f, 0.f, 0.f, 0.f};
    bf16x8 At[4][2], B0[2][2], B1[2][2];
    const char* cA = (const char*)g.A + (size_t)cur.pm * tstepA; const char* cB = (const char*)g.Bt + (size_t)cur.pn * tstepB;
    S.a_ready(cur);
    if constexpr (SP2) {
        PG8_STAGE(PG8_SB(0, 0), cB, voffB); PG8_STAGE(PG8_SB(0, 1), cB + hstepB, voffB); PG8_STAGE(PG8_SA(0, 0), cA, voffA); PG8_STAGE(PG8_SA(0, 1), cA + hstepA, voffA);
        if (wr == 1) PG8_BAR;
        PG8_WAIT_V(2); PG8_BAR;
        PG8_STAGE(PG8_SB(1, 0), cB + kstep, voffB); PG8_STAGE(PG8_SA(1, 0), cA + kstep, voffA); PG8_STAGE(PG8_SB(1, 1), cB + hstepB + kstep, voffB);
        PG8_WAIT_V(6); PG8_BAR;
    } else {
        PG8_STAGE(PG8_SB(0, 0), cB, voffB); PG8_STAGE(PG8_SA(0, 0), cA, voffA); PG8_STAGE(PG8_SB(0, 1), cB + hstepB, voffB); PG8_STAGE(PG8_SA(0, 1), cA + hstepA, voffA);
        if (wr == 1) PG8_BAR;
        PG8_WAIT_V(4); PG8_BAR;
        PG8_STAGE(PG8_SB(1, 0), cB + kstep, voffB); PG8_STAGE(PG8_SA(1, 0), cA + kstep, voffA); PG8_STAGE(PG8_SB(1, 1), cB + hstepB + kstep, voffB);
        PG8_WAIT_V(6); PG8_BAR;
    }
    for (;;) {
        const bool has_next = S.next(ui + 1, nxt);
        const char* nA = has_next ? (const char*)g.A + (size_t)nxt.pm * tstepA : cA; const char* nB = has_next ? (const char*)g.Bt + (size_t)nxt.pn * tstepB : cB;
        for (int t = 0; t < nt; t += 2) {
            const bool last = (t == nt - 2);
            const char* a1 = cA + (size_t)(t + 1) * kstep;
            const char* a2 = last ? nA : cA + (size_t)(t + 2) * kstep; const char* b2 = last ? nB : cB + (size_t)(t + 2) * kstep;
            const char* a3 = a2 + kstep; const char* b3 = b2 + kstep;
            if (last && has_next) S.a_ready(nxt);
            if constexpr (SP2) {
            PG8_LDB(B0, 0, 0); PG8_LDB(B1, 0, 1); PG8_SCHED; PG8_LDA(At, 0, 0); PG8_STAGE(PG8_SA(1, 1), a1 + hstepA, voffA);
            PG8_WAIT_V(8); PG8_WAIT_L(0); PG8_BAR; PG8_MMA(0, 0, At, B0); PG8_MMA(0, 1, At, B1); PG8_BAR; PG8_SCHED;
            PG8_LDA(At, 0, 1); PG8_STAGE(PG8_SB(0, 0), b2, voffB); PG8_STAGE(PG8_SB(0, 1), b2 + hstepB, voffB); PG8_STAGE(PG8_SA(0, 0), a2, voffA);
            PG8_WAIT_V(8); PG8_WAIT_L(0); PG8_BAR; PG8_MMA(1, 0, At, B0); PG8_MMA(1, 1, At, B1); PG8_BAR; PG8_SCHED;
            PG8_LDB(B0, 1, 0); PG8_LDB(B1, 1, 1); PG8_SCHED; PG8_LDA(At, 1, 0); PG8_STAGE(PG8_SA(0, 1), a2 + hstepA, voffA);
            PG8_WAIT_V(8); PG8_WAIT_L(0); PG8_BAR; PG8_MMA(0, 0, At, B0); PG8_MMA(0, 1, At, B1); PG8_BAR; PG8_SCHED;
            PG8_LDA(At, 1, 1); PG8_STAGE(PG8_SB(1, 0), b3, voffB); PG8_STAGE(PG8_SB(1, 1), b3 + hstepB, voffB); PG8_STAGE(PG8_SA(1, 0), a3, voffA);
            PG8_WAIT_V(8); PG8_WAIT_L(0); PG8_BAR; PG8_MMA(1, 0, At, B0); PG8_MMA(1, 1, At, B1); PG8_BAR; PG8_SCHED;
            } else {
            PG8_LDB(B0, 0, 0); PG8_SCHED; PG8_LDA(At, 0, 0); PG8_STAGE(PG8_SA(1, 1), a1 + hstepA, voffA);
            PG8_WAIT_L(8); PG8_BAR; PG8_WAIT_L(0); PG8_MMA(0, 0, At, B0); PG8_BAR; PG8_SCHED;
            PG8_LDB(B1, 0, 1); PG8_STAGE(PG8_SB(0, 0), b2, voffB);
            PG8_BAR; PG8_WAIT_L(0); PG8_MMA(0, 1, At, B1); PG8_BAR;
            PG8_LDA(At, 0, 1); PG8_STAGE(PG8_SA(0, 0), a2, voffA);
            PG8_BAR; PG8_WAIT_L(0); PG8_MMA(1, 0, At, B0); PG8_BAR; PG8_SCHED;
            PG8_STAGE(PG8_SB(0, 1), b2 + hstepB, voffB);
            PG8_WAIT_V(6); PG8_BAR; PG8_MMA(1, 1, At, B1); PG8_BAR;
            PG8_LDB(B0, 1, 0); PG8_SCHED; PG8_LDA(At, 1, 0); PG8_STAGE(PG8_SA(0, 1), a2 + hstepA, voffA);
            PG8_WAIT_L(8); PG8_BAR; PG8_WAIT_L(0); PG8_MMA(0, 0, At, B0); PG8_BAR; PG8_SCHED;
            PG8_LDB(B1, 1, 1); PG8_STAGE(PG8_SB(1, 0), b3, voffB);
            PG8_BAR; PG8_WAIT_L(0); PG8_MMA(0, 1, At, B1); PG8_BAR;
            PG8_LDA(At, 1, 1); PG8_STAGE(PG8_SA(1, 0), a3, voffA);
            PG8_BAR; PG8_WAIT_L(0); PG8_MMA(1, 0, At, B0); PG8_BAR; PG8_SCHED;
            PG8_STAGE(PG8_SB(1, 1), b3 + hstepB, voffB);
            PG8_WAIT_V(6); PG8_BAR; PG8_MMA(1, 1, At, B1); PG8_BAR;
            }
        }
        if constexpr (ALIGN_EPI) { if (wr == 0) PG8_BAR; }
        if constexpr (!Epi::AFTER_DRAIN) { E(acc, cur, wr, wc, fr, fq); S.done(cur); }
        if (!has_next) break;
#pragma unroll
        for (int a = 0; a < 2; ++a)
#pragma unroll
            for (int b = 0; b < 2; ++b)
#pragma unroll
                for (int m = 0; m < 4; ++m)
#pragma unroll
                    for (int n = 0; n < 2; ++n) acc[a][b][m][n] = (f32x4){0.f, 0.f, 0.f, 0.f};
        cur = nxt; cA = nA; cB = nB; ++ui;
        if constexpr (ALIGN_EPI) { if (wr == 1) PG8_BAR; }
    }
    PG8_WAIT_V(0);
    if constexpr (!ALIGN_EPI) { if (wr == 0) PG8_BAR; }
    PG8_BAR;
    if constexpr (Epi::AFTER_DRAIN) { E.fused(acc, cur, wr, wc, fr, fq, lds, wid, lane); S.done(cur); }
#undef PG8_SA
#undef PG8_SB
#undef PG8_STAGE
#undef PG8_LDA
#undef PG8_LDB
#undef PG8_MMA
#undef PG8_WAIT_V
#undef PG8_WAIT_L
#undef PG8_BAR
#undef PG8_SCHED
}
}

#define LAS __attribute__((address_space(3)))
#define DI __device__ __forceinline__
typedef unsigned short bf16_t;
typedef short bf16x8 __attribute__((ext_vector_type(8)));
typedef short s16x4 __attribute__((ext_vector_type(4)));
typedef float f32x4 __attribute__((ext_vector_type(4)));
typedef float f32x16 __attribute__((ext_vector_type(16)));
typedef unsigned u32x4 __attribute__((ext_vector_type(4)));
typedef unsigned u32x2 __attribute__((ext_vector_type(2)));
typedef float f32x2_t __attribute__((ext_vector_type(2)));
typedef __bf16 bf16x2_t __attribute__((ext_vector_type(2)));

constexpr int NB = 16, SEQ = 2048, DM = 1024, CTX = 256;
constexpr int ML = NB * SEQ;
constexpr int MC = NB * CTX;
constexpr int MT = ML + MC;
constexpr int FF = 2816, FF2 = 5632;
constexpr int EV_IN = 1184, EV_PITCH = 1280, OD_PITCH = 1792;
constexpr float EPS = 1e-6f;
constexpr float LOG2E = 1.4426950408889634f;
constexpr int NT = 512;

constexpr size_t MiB = 1u << 20;
constexpr size_t WS_MOD = 0;
constexpr size_t WS_TAB = 1 * MiB;
constexpr size_t WS_W_EVIN = 2 * MiB;
constexpr size_t WS_W_QUP = 5 * MiB;
constexpr size_t WS_W_KVUP = 6 * MiB;
constexpr size_t WS_W_EVOUT = 7 * MiB;
constexpr size_t WS_W_ODIN = 9 * MiB;
constexpr size_t WS_W_ODOUT = 13 * MiB;
constexpr size_t WS_W_UP = 15 * MiB;
constexpr size_t WS_W_DOWN = 37 * MiB;
constexpr size_t WS_HC = 48 * MiB;
constexpr size_t WS_Z = 64 * MiB;
constexpr size_t WS_BIG = 136 * MiB;
constexpr size_t WS_H = WS_BIG;
constexpr size_t WS_QB = WS_BIG + 126 * MiB;
constexpr size_t WS_KVB = WS_BIG + 180 * MiB;
constexpr size_t WS_Y = WS_BIG + 252 * MiB;
constexpr size_t WS_ACT = WS_BIG;
constexpr size_t WS_HALO = WS_BIG + 200 * MiB;

struct Params {
  const float *x, *c, *ctx, *c_ctx, *mod_w, *mod_b, *norm1_g, *norm2_g;
  const float *ev_w_in, *ev_qa_g, *ev_ka_g, *ev_qlat_g, *ev_w_q_up, *ev_kvlat_g, *ev_w_kv_up, *ev_w_out;
  const float *od_w_in, *od_ln_g, *od_ln_b, *od_sgu_w, *od_sgu_b, *od_sink, *od_w_out;
  const float *ffn_up, *ffn_conv_w, *ffn_conv_b, *ffn_down, *final_g;
  float* out; unsigned char* ws;
};

DI float bf2f(unsigned short b) { return __uint_as_float(((unsigned)b) << 16); }
DI float bflo(unsigned w) { return __uint_as_float(w << 16); }
DI float bfhi(unsigned w) { return __uint_as_float(w & 0xffff0000u); }
DI unsigned pk2(float lo, float hi) { f32x2_t v = {lo, hi}; bf16x2_t b = __builtin_convertvector(v, bf16x2_t); return __builtin_bit_cast(unsigned, b); }
DI unsigned short f2bf(float f) { return (unsigned short)(pk2(f, 0.f) & 0xffffu); }
DI float wave_sum(float v) {
#pragma unroll
  for (int o = 1; o < 64; o <<= 1) v += __shfl_xor(v, o);
  return v;
}
DI float sigmoidf_(float x) { return 1.f / (1.f + __expf(-x)); }
DI float siluf_(float x) { return x * sigmoidf_(x); }
DI float geluf_(float x) { const float u = 1.5957691216057308f * (x + 0.044715f * x * x * x); return x * sigmoidf_(u); }
DI int crow(int r, int hi) { return (r & 3) + 8 * (r >> 2) + 4 * hi; }
DI int modrow(int row) { return row < ML ? (row >> 11) : 16; }
DI int xcd_vid() { const int G = gridDim.x, b = blockIdx.x; return (G % 8 == 0) ? (b % 8) * (G / 8) + b / 8 : b; }
DI int opaque_tid() { int t = threadIdx.x; asm volatile("" : "+v"(t)); return t; }

struct EpiRes {
  static constexpr bool PERM = false, AFTER_DRAIN = false;
  const float* baseL; const float* baseC; float* outL; float* outC; const float* gate;    int row0;
  DI void operator()(const pg8::f32x4 (&acc)[2][2][4][2], const pg8::Unit& u, int wr, int wc, int fr, int fq) const {
    const int rt = row0 + u.pm * 256; const bool lat = rt < ML; const int mr = lat ? (rt >> 11) : 16;
    const float* base = lat ? baseL + (size_t)rt * DM + u.pn * 256 : baseC + (size_t)(rt - ML) * DM + u.pn * 256;
    float* out = lat ? outL + (size_t)rt * DM + u.pn * 256 : outC + (size_t)(rt - ML) * DM + u.pn * 256;
    const float* gp = gate + (size_t)mr * 6144 + u.pn * 256;
    const int lo = (wr * 64 + fr) * DM + wc * 32 + 4 * fq;
    const int lc = wc * 32 + 4 * fq;
    pg8::f32x4 gv[2][2];
#pragma unroll
    for (int bj = 0; bj < 2; ++bj)
#pragma unroll
      for (int n = 0; n < 2; ++n) gv[bj][n] = *(const pg8::f32x4*)(gp + bj * 128 + n * 16 + lc);
    pg8::f32x4 cur[2][2], nxt[2][2];
#pragma unroll
    for (int bj = 0; bj < 2; ++bj)
#pragma unroll
      for (int n = 0; n < 2; ++n) cur[bj][n] = *(const pg8::f32x4*)(base + bj * 128 + n * 16 + lo);
#pragma unroll
    for (int g = 0; g < 8; ++g) {
      const int ai = g >> 2, mm = g & 3;
      if (g < 7) { const float* bp = base + (((g + 1) >> 2) * 128 + ((g + 1) & 3) * 16) * DM;
#pragma unroll
        for (int bj = 0; bj < 2; ++bj)
#pragma unroll
          for (int n = 0; n < 2; ++n) nxt[bj][n] = *(const pg8::f32x4*)(bp + bj * 128 + n * 16 + lo); }
      float* op = out + (ai * 128 + mm * 16) * DM;
#pragma unroll
      for (int bj = 0; bj < 2; ++bj)
#pragma unroll
        for (int n = 0; n < 2; ++n) *(pg8::f32x4*)(op + bj * 128 + n * 16 + lo) = cur[bj][n] + gv[bj][n] * acc[ai][bj][mm][n];
      asm volatile("" ::: "memory");
#pragma unroll
      for (int bj = 0; bj < 2; ++bj)
#pragma unroll
        for (int n = 0; n < 2; ++n) cur[bj][n] = nxt[bj][n];
    }
  }
};

DI float dpp_ror1(float v) { return __builtin_bit_cast(float, __builtin_amdgcn_update_dpp(0, __builtin_bit_cast(int, v), 0x121, 0xf, 0xf, true)); }
DI float dpp_rol1(float v) { return __builtin_bit_cast(float, __builtin_amdgcn_update_dpp(0, __builtin_bit_cast(int, v), 0x12F, 0xf, 0xf, true)); }
struct EpiConv {
  static constexpr bool PERM = true, AFTER_DRAIN = false;
  bf16_t* ACT; float* HALO; const float* cw; const float* cb; LAS float* edge;
  DI void operator()(const pg8::f32x4 (&acc)[2][2][4][2], const pg8::Unit& u, int wr, int wc, int fr, int fq) const {
    const int cl = wc * 32 + 8 * fq;
#pragma unroll
    for (int ai = 0; ai < 2; ++ai) {
      const int sl = 2 * ai + wr;
      if (fr == 0) {
#pragma unroll
        for (int bj = 0; bj < 2; ++bj)
#pragma unroll
          for (int n = 0; n < 2; ++n) *(LAS pg8::f32x4*)(edge + ((sl * 2 + 0) * 2 + bj) * 128 + cl + 4 * n) = acc[ai][bj][0][n];
      }
      if (fr == 15) {
#pragma unroll
        for (int bj = 0; bj < 2; ++bj)
#pragma unroll
          for (int n = 0; n < 2; ++n) *(LAS pg8::f32x4*)(edge + ((sl * 2 + 1) * 2 + bj) * 128 + cl + 4 * n) = acc[ai][bj][3][n];
      }
    }
    if (wr == 0 && fr < 2) {
#pragma unroll
      for (int bj = 0; bj < 2; ++bj)
#pragma unroll
        for (int n = 0; n < 2; ++n) *(pg8::f32x4*)(HALO + (size_t)(u.pm * 4 + fr) * FF2 + bj * FF + u.pn * 128 + cl + 4 * n) = acc[0][bj][0][n];
    }
    if (wr == 1 && fr >= 14) {
#pragma unroll
      for (int bj = 0; bj < 2; ++bj)
#pragma unroll
        for (int n = 0; n < 2; ++n) *(pg8::f32x4*)(HALO + (size_t)(u.pm * 4 + fr - 12) * FF2 + bj * FF + u.pn * 128 + cl + 4 * n) = acc[1][bj][3][n];
    }
    asm volatile("s_waitcnt lgkmcnt(0)" ::: "memory"); __builtin_amdgcn_s_barrier(); asm volatile("" ::: "memory");
    const pg8::f32x4 zero4 = {0.f, 0.f, 0.f, 0.f};
#pragma unroll
    for (int n = 0; n < 2; ++n) {
      const int ca = u.pn * 128 + cl + 4 * n;
      const pg8::f32x4 wa0 = *(const pg8::f32x4*)(cw + ca), wa1 = *(const pg8::f32x4*)(cw + FF2 + ca), wa2 = *(const pg8::f32x4*)(cw + 2 * FF2 + ca), ba = *(const pg8::f32x4*)(cb + ca);
      const pg8::f32x4 wg0 = *(const pg8::f32x4*)(cw + FF + ca), wg1 = *(const pg8::f32x4*)(cw + FF2 + FF + ca), wg2 = *(const pg8::f32x4*)(cw + 2 * FF2 + FF + ca), bg = *(const pg8::f32x4*)(cb + FF + ca);
#pragma unroll
      for (int ai = 0; ai < 2; ++ai) {
        const int sl = 2 * ai + wr;
        const pg8::f32x4 ua = sl > 0 ? *(const LAS pg8::f32x4*)(edge + (((sl - 1) * 2 + 1) * 2 + 0) * 128 + cl + 4 * n) : zero4;
        const pg8::f32x4 ug = sl > 0 ? *(const LAS pg8::f32x4*)(edge + (((sl - 1) * 2 + 1) * 2 + 1) * 128 + cl + 4 * n) : zero4;
        const pg8::f32x4 da = sl < 3 ? *(const LAS pg8::f32x4*)(edge + (((sl + 1) * 2 + 0) * 2 + 0) * 128 + cl + 4 * n) : zero4;
        const pg8::f32x4 dg = sl < 3 ? *(const LAS pg8::f32x4*)(edge + (((sl + 1) * 2 + 0) * 2 + 1) * 128 + cl + 4 * n) : zero4;
#pragma unroll
        for (int mm = 0; mm < 4; ++mm) {
          float o[4];
#pragma unroll
          for (int e = 0; e < 4; ++e) {
            const float ca_ = acc[ai][0][mm][n][e], cg_ = acc[ai][1][mm][n][e];
            const float pa = mm > 0 ? dpp_ror1(acc[ai][0][mm > 0 ? mm - 1 : 0][n][e]) : ua[e], pg = mm > 0 ? dpp_ror1(acc[ai][1][mm > 0 ? mm - 1 : 0][n][e]) : ug[e];
            const float na = mm < 3 ? dpp_rol1(acc[ai][0][mm < 3 ? mm + 1 : 3][n][e]) : da[e], ng = mm < 3 ? dpp_rol1(acc[ai][1][mm < 3 ? mm + 1 : 3][n][e]) : dg[e];
            const float rca = dpp_ror1(ca_), rcg = dpp_ror1(cg_), lca = dpp_rol1(ca_), lcg = dpp_rol1(cg_);
            const float upa = fr > 0 ? rca : pa, upg = fr > 0 ? rcg : pg;
            const float dna = fr < 15 ? lca : na, dng = fr < 15 ? lcg : ng;
            const float A = wa0[e] * upa + wa1[e] * ca_ + wa2[e] * dna + ba[e];
            const float G = wg0[e] * upg + wg1[e] * cg_ + wg2[e] * dng + bg[e];
            o[e] = siluf_(G) * A;
          }
          const int row = u.pm * 256 + ai * 128 + wr * 64 + mm * 16 + fr;
          u32x2 w; w.x = pk2(o[0], o[1]); w.y = pk2(o[2], o[3]);
          *(u32x2*)(ACT + (size_t)row * FF + ca) = w;
        }
      }
    }
  }
};
DI void phase_conv_fix(const float* HALO, bf16_t* ACT, const float* cw, const float* cb, int ntiles) {
  const int tid = opaque_tid(); const int total = ntiles * 2 * (FF / 4);
  for (int it = blockIdx.x * NT + tid; it < total; it += gridDim.x * NT) {
    const int j = (it % (FF / 4)) * 4, tr = it / (FF / 4), pm = tr >> 1, bot = tr & 1;
    const bool first = pm < 128 ? (pm & 7) == 0 : true, last = pm < 128 ? (pm & 7) == 7 : true;
    const float* hc = HALO + (size_t)(pm * 4 + (bot ? 3 : 0)) * FF2 + j;
    const float* hu = bot ? HALO + (size_t)(pm * 4 + 2) * FF2 + j : (first ? nullptr : HALO + (size_t)((pm - 1) * 4 + 3) * FF2 + j);
    const float* hd = bot ? (last ? nullptr : HALO + (size_t)((pm + 1) * 4 + 0) * FF2 + j) : HALO + (size_t)(pm * 4 + 1) * FF2 + j;
    const f32x4 z = {0.f, 0.f, 0.f, 0.f};
    const f32x4 ca_ = *(const f32x4*)hc, cg_ = *(const f32x4*)(hc + FF);
    const f32x4 ua = hu ? *(const f32x4*)hu : z, ug = hu ? *(const f32x4*)(hu + FF) : z, da = hd ? *(const f32x4*)hd : z, dg = hd ? *(const f32x4*)(hd + FF) : z;
    const f32x4 A = *(const f32x4*)(cw + j) * ua + *(const f32x4*)(cw + FF2 + j) * ca_ + *(const f32x4*)(cw + 2 * FF2 + j) * da + *(const f32x4*)(cb + j);
    const f32x4 G = *(const f32x4*)(cw + FF + j) * ug + *(const f32x4*)(cw + FF2 + FF + j) * cg_ + *(const f32x4*)(cw + 2 * FF2 + FF + j) * dg + *(const f32x4*)(cb + FF + j);
    u32x2 w; w.x = pk2(siluf_(G.x) * A.x, siluf_(G.y) * A.y); w.y = pk2(siluf_(G.z) * A.z, siluf_(G.w) * A.w);
    *(u32x2*)(ACT + (size_t)(pm * 256 + (bot ? 255 : 0)) * FF + j) = w;
  }
}

DI void conv_fix_tile(const float* HALO, bf16_t* ACT, const float* cw, const float* cb, int pm, int tid) {
  for (int it = tid; it < 2 * (FF / 4); it += NT) {
    const int j = (it % (FF / 4)) * 4, bot = it / (FF / 4);
    const bool first = pm < 128 ? (pm & 7) == 0 : true, last = pm < 128 ? (pm & 7) == 7 : true;
    const float* hc = HALO + (size_t)(pm * 4 + (bot ? 3 : 0)) * FF2 + j;
    const float* hu = bot ? HALO + (size_t)(pm * 4 + 2) * FF2 + j : (first ? nullptr : HALO + (size_t)((pm - 1) * 4 + 3) * FF2 + j);
    const float* hd = bot ? (last ? nullptr : HALO + (size_t)((pm + 1) * 4 + 0) * FF2 + j) : HALO + (size_t)(pm * 4 + 1) * FF2 + j;
    const f32x4 z = {0.f, 0.f, 0.f, 0.f};
    const f32x4 ca_ = *(const f32x4*)hc, cg_ = *(const f32x4*)(hc + FF);
    const f32x4 ua = hu ? *(const f32x4*)hu : z, ug = hu ? *(const f32x4*)(hu + FF) : z, da = hd ? *(const f32x4*)hd : z, dg = hd ? *(const f32x4*)(hd + FF) : z;
    const f32x4 A = *(const f32x4*)(cw + j) * ua + *(const f32x4*)(cw + FF2 + j) * ca_ + *(const f32x4*)(cw + 2 * FF2 + j) * da + *(const f32x4*)(cb + j);
    const f32x4 G = *(const f32x4*)(cw + FF + j) * ug + *(const f32x4*)(cw + FF2 + FF + j) * cg_ + *(const f32x4*)(cw + 2 * FF2 + FF + j) * dg + *(const f32x4*)(cb + FF + j);
    u32x2 w; w.x = pk2(siluf_(G.x) * A.x, siluf_(G.y) * A.y); w.y = pk2(siluf_(G.z) * A.z, siluf_(G.w) * A.w);
    *(u32x2*)(ACT + (size_t)(pm * 256 + (bot ? 255 : 0)) * FF + j) = w;
  }
}
DI void conv_fix_my_tiles(const pg8::StaticOrder& S, int pm_off, const float* HALO, bf16_t* ACT, const float* cw, const float* cb) {
  const int tid = opaque_tid(); pg8::Unit u; int lastpm = -1;
  for (int i = 0; S.next(i, u); ++i) if (u.pm != lastpm) { conv_fix_tile(HALO, ACT, cw, cb, pm_off + u.pm, tid); lastpm = u.pm; }
  asm volatile("s_waitcnt vmcnt(0)" ::: "memory"); __syncthreads();
}

DI void transpose_item(const float* W, int K, int N, bf16_t* WT, int row_off, LAS float* scr, int item, int lane, int ldo, int koff, bool UPPERM) {
  const int nblk = N / 32, kb = item / nblk, nb = item % nblk, k0 = 64 * kb, n0 = 32 * nb;
#pragma unroll 16
  for (int i = 0; i < 32; ++i) { const int kk = 2 * i + (lane >> 5); scr[kk * 33 + (lane & 31)] = W[(size_t)(k0 + kk) * N + n0 + (lane & 31)]; }
  asm volatile("s_waitcnt lgkmcnt(0)" ::: "memory");
  const int c = lane & 7;
#pragma unroll
  for (int j = 0; j < 4; ++j) { const int n = (lane >> 3) + 8 * j; const LAS float* s = scr + (8 * c) * 33 + n;
    u32x4 o; o.x = pk2(s[0 * 33], s[1 * 33]); o.y = pk2(s[2 * 33], s[3 * 33]); o.z = pk2(s[4 * 33], s[5 * 33]); o.w = pk2(s[6 * 33], s[7 * 33]);
    int drow = row_off + n0 + n;
    if (UPPERM) { const int ns = n0 + n, hg = ns >= FF ? 1 : 0, nn = ns - hg * FF; drow = row_off + (nn >> 7) * 256 + hg * 128 + (nn & 127); }
    *(u32x4*)(WT + (size_t)drow * ldo + koff + k0 + 8 * c) = o; }
  asm volatile("s_waitcnt lgkmcnt(0)" ::: "memory");
}

DI void phase_prologue(const Params& p, LAS unsigned char* lds) {
  const int tid = opaque_tid(), lane = tid & 63, wave = __builtin_amdgcn_readfirstlane(tid >> 6), G = gridDim.x;
  unsigned char* ws = p.ws;
  { float* COSH = (float*)(ws + WS_TAB); float* SINH = COSH + 2048 * 32; float* COSR = SINH + 2048 * 32; float* SINR = COSR + 2048 * 16;
    for (int i = blockIdx.x * NT + tid; i < 2048 * 32; i += G * NT) { const int t = i >> 5, f = i & 31; const float pos = (float)((f < 16) ? (t >> 6) : (t & 63));
      const float inv = powf(10000.f, -(float)(f & 15) / 16.f); const float a = pos * inv; COSH[i] = cosf(a); SINH[i] = sinf(a); }
    for (int i = blockIdx.x * NT + tid; i < 2048 * 16; i += G * NT) { const int t = i >> 4, f = i & 15; const float pos = (float)((f < 8) ? (t >> 6) : (t & 63));
      const float inv = powf(10000.f, -(float)(f & 7) / 8.f); const float a = pos * inv; COSR[i] = cosf(a); SINR[i] = sinf(a); }
  }
  constexpr int I1 = 16 * 37, I2 = 4 * 24, I3 = 2 * 32, I4 = 16 * 32, I5 = 16 * 56, I6 = 16 * 32, I7 = 16 * 176, I9 = 44 * 32;
  constexpr int NIT = I1 + I2 + I3 + I4 + I5 + I6 + 2 * I7 + 2 * I9;
  auto do_item = [&](int it, LAS float* scr) {
    int r = it; const float* W; bf16_t* WT; int K, N, ro = 0, ldo, ko = 0; bool up = false;
    if (r < I1) { W = p.ev_w_in; K = 1024; N = EV_IN; WT = (bf16_t*)(ws + WS_W_EVIN); ldo = 1024; }
    else if ((r -= I1) < I2) { W = p.ev_w_q_up; K = 256; N = 768; WT = (bf16_t*)(ws + WS_W_QUP); ldo = 384; }
    else if ((r -= I2) < I3) { W = p.ev_w_kv_up; K = 128; N = 1024; WT = (bf16_t*)(ws + WS_W_QUP); ro = 768; ldo = 384; ko = 256; }
    else if ((r -= I3) < I4) { W = p.ev_w_out; K = 1024; N = 1024; WT = (bf16_t*)(ws + WS_W_EVOUT); ldo = 1024; }
    else if ((r -= I4) < I5) { W = p.od_w_in; K = 1024; N = 1792; WT = (bf16_t*)(ws + WS_W_ODIN); ldo = 1024; }
    else if ((r -= I5) < I6) { W = p.od_w_out; K = 1024; N = 1024; WT = (bf16_t*)(ws + WS_W_ODOUT); ldo = 1024; }
    else if ((r -= I6) < I7) { W = p.ffn_up; K = 1024; N = FF2; WT = (bf16_t*)(ws + WS_W_UP); ldo = 1024; up = true; }
    else if ((r -= I7) < I7) { W = p.ffn_up + (size_t)1024 * FF2; K = 1024; N = FF2; WT = (bf16_t*)(ws + WS_W_UP) + (size_t)FF2 * 1024; ldo = 1024; up = true; }
    else if ((r -= I7) < I9) { W = p.ffn_down; K = FF; N = 1024; WT = (bf16_t*)(ws + WS_W_DOWN); ldo = FF; }
    else { r -= I9; W = p.ffn_down + (size_t)FF * 1024; K = FF; N = 1024; WT = (bf16_t*)(ws + WS_W_DOWN) + (size_t)1024 * FF; ldo = FF; }
    transpose_item(W, K, N, WT, ro, scr, r, lane, ldo, ko, up);
  };
  const int nGB = G < 192 ? G : 192;
  const int nTW = nGB * 4, NA = nTW * 7 < NIT ? nTW * 7 : NIT;
  { LAS float* s = (LAS float*)lds; LAS float* red = s + 17 * 1024; float* MOD = (float*)(ws + WS_MOD);
    for (int it = blockIdx.x; it < 192; it += G) {
      for (int i = tid; i < 17 * 1024; i += NT) { const int r = i >> 10, k = i & 1023; const float v = r < 16 ? p.c[r * 1024 + k] : p.c_ctx[k]; s[i] = siluf_(v); }
      __syncthreads();
      const int layer = it / 96, j0 = (it % 96) * 64;
      if (wave < 4) {
        const int cq = tid & 15, kg = tid >> 4;
        f32x4 acc[17];
#pragma unroll
        for (int r = 0; r < 17; ++r) acc[r] = (f32x4){0.f, 0.f, 0.f, 0.f};
        const float* w = p.mod_w + (size_t)layer * 1024 * 6144 + j0 + 4 * cq;
#pragma unroll 8
        for (int k = kg * 64; k < kg * 64 + 64; ++k) { const f32x4 wv = *(const f32x4*)(w + (size_t)k * 6144);
#pragma unroll
          for (int r = 0; r < 17; ++r) acc[r] += wv * s[r * 1024 + k]; }
#pragma unroll
        for (int r = 0; r < 17; ++r) {
#pragma unroll
          for (int e = 0; e < 4; ++e) { float v = acc[r][e]; v += __shfl_xor(v, 16); v += __shfl_xor(v, 32); acc[r][e] = v; }
          if ((lane >> 4) == 0) *(LAS f32x4*)(red + (wave * 17 + r) * 64 + 4 * cq) = acc[r]; }
      } else if (it == (int)blockIdx.x) {
        LAS float* scr = (LAS float*)(lds + 87040 + (wave - 4) * 8448);
        const int tw = blockIdx.x * 4 + (wave - 4);
        for (int j = 0; j < 7; ++j) { const int item = tw + j * nTW; if (item < NA) do_item(item, scr); }
      }
      __syncthreads();
      for (int o = tid; o < 17 * 64; o += NT) { const int r = o >> 6, j = o & 63; float sum = p.mod_b[layer * 6144 + j0 + j];
#pragma unroll
        for (int q = 0; q < 4; ++q) sum += red[(q * 17 + r) * 64 + j];
        MOD[((size_t)layer * 17 + r) * 6144 + j0 + j] = sum; }
      __syncthreads();
    }
  }
  __syncthreads();
  { LAS float* scr = (LAS float*)(lds + wave * 8448);
    const int gw = blockIdx.x * 8 + wave, NGW = G * 8;
    for (int it = NA + gw; it < NIT; it += NGW) do_item(it, scr);
    { bf16_t* wq = (bf16_t*)(ws + WS_W_QUP);
      for (int i = blockIdx.x * NT + tid; i < 768 * 16; i += G * NT) { const int r_ = i >> 4, c_ = i & 15; *(u32x4*)(wq + (size_t)r_ * 384 + 256 + c_ * 8) = (u32x4){0u, 0u, 0u, 0u}; }
      for (int i = blockIdx.x * NT + tid; i < 1024 * 32; i += G * NT) { const int r_ = 768 + (i >> 5), c_ = i & 31; *(u32x4*)(wq + (size_t)r_ * 384 + c_ * 8) = (u32x4){0u, 0u, 0u, 0u}; } }
    u32x4* z = (u32x4*)((bf16_t*)(ws + WS_W_EVIN) + (size_t)EV_IN * 1024);
    for (int i = blockIdx.x * NT + tid; i < (EV_PITCH - EV_IN) * 1024 / 8; i += G * NT) z[i] = (u32x4){0u, 0u, 0u, 0u};
  }
}

DI void phase_norm_mod(const float* srcL, const float* srcC, const float* g, const float* modl, int shiftIdx, int scaleIdx, bf16_t* Z, int rowBeg, int rowEnd, int blk0 = 0, int nblk = 0) {
  if (nblk == 0) nblk = gridDim.x;
  const int tid = opaque_tid(), lane = tid & 63, gw = ((int)blockIdx.x - blk0) * 8 + (tid >> 6), NGW = nblk * 8;
  for (int row0 = rowBeg + gw; row0 < rowEnd; row0 += 2 * NGW) {
    const int row1 = row0 + NGW; const bool has1 = row1 < rowEnd; const int r1 = has1 ? row1 : row0;
    const float* s0 = row0 < ML ? srcL + (size_t)row0 * DM : srcC + (size_t)(row0 - ML) * DM;
    const float* s1 = r1 < ML ? srcL + (size_t)r1 * DM : srcC + (size_t)(r1 - ML) * DM;
    f32x4 v0[4], v1[4];
#pragma unroll
    for (int j = 0; j < 4; ++j) { v0[j] = *(const f32x4*)(s0 + 4 * (64 * j + lane)); v1[j] = *(const f32x4*)(s1 + 4 * (64 * j + lane)); }
    float ss0 = 0.f, ss1 = 0.f;
#pragma unroll
    for (int j = 0; j < 4; ++j) { ss0 += (v0[j].x * v0[j].x + v0[j].y * v0[j].y) + (v0[j].z * v0[j].z + v0[j].w * v0[j].w); ss1 += (v1[j].x * v1[j].x + v1[j].y * v1[j].y) + (v1[j].z * v1[j].z + v1[j].w * v1[j].w); }
    const float q0 = rsqrtf(wave_sum(ss0) * (1.f / DM) + EPS), q1 = rsqrtf(wave_sum(ss1) * (1.f / DM) + EPS);
    const float* mp0 = modl + (size_t)modrow(row0) * 6144; const float* mp1 = modl + (size_t)modrow(r1) * 6144;
#pragma unroll
    for (int j = 0; j < 4; ++j) { const int k = 4 * (64 * j + lane);
      const f32x4 gg = *(const f32x4*)(g + k);
      { const f32x4 sc = *(const f32x4*)(mp0 + scaleIdx * 1024 + k), sh = *(const f32x4*)(mp0 + shiftIdx * 1024 + k);
        const f32x4 z = (v0[j] * q0) * gg * (sc + 1.f) + sh; u32x2 w; w.x = pk2(z.x, z.y); w.y = pk2(z.z, z.w); *(u32x2*)(Z + (size_t)row0 * DM + k) = w; }
      if (has1) { const f32x4 sc = *(const f32x4*)(mp1 + scaleIdx * 1024 + k), sh = *(const f32x4*)(mp1 + shiftIdx * 1024 + k);
        const f32x4 z = (v1[j] * q1) * gg * (sc + 1.f) + sh; u32x2 w; w.x = pk2(z.x, z.y); w.y = pk2(z.z, z.w); *(u32x2*)(Z + (size_t)row1 * DM + k) = w; }
    }
  }
}
DI void phase_final_norm(float* out, const float* g) {
  const int tid = opaque_tid(), lane = tid & 63, gw = blockIdx.x * 8 + (tid >> 6), NGW = gridDim.x * 8;
  for (int row = gw; row < ML; row += NGW) {
    float* src = out + (size_t)row * DM;
    f32x4 v[4]; float ss = 0.f;
#pragma unroll
    for (int j = 0; j < 4; ++j) { v[j] = *(const f32x4*)(src + 4 * (64 * j + lane)); ss += (v[j].x * v[j].x + v[j].y * v[j].y) + (v[j].z * v[j].z + v[j].w * v[j].w); }
    const float r = rsqrtf(wave_sum(ss) * (1.f / DM) + EPS);
#pragma unroll
    for (int j = 0; j < 4; ++j) { const int k = 4 * (64 * j + lane); const f32x4 gg = *(const f32x4*)(g + k); *(f32x4*)(src + k) = (v[j] * r) * gg; }
  }
}
DI void head_fix(bf16_t* base, int sub, const float* gain, bool norm, bool rope, const float* cs, const float* sn, float scale, bool doit) {
  const u32x2 a = *(const u32x2*)(base + 4 * sub), b = *(const u32x2*)(base + 32 + 4 * sub);
  float x1[4] = {bflo(a.x), bfhi(a.x), bflo(a.y), bfhi(a.y)}, x2[4] = {bflo(b.x), bfhi(b.x), bflo(b.y), bfhi(b.y)};
  if (norm) {
    float ss = 0.f;
#pragma unroll
    for (int j = 0; j < 4; ++j) ss += x1[j] * x1[j] + x2[j] * x2[j];
    ss += __shfl_xor(ss, 1); ss += __shfl_xor(ss, 2); ss += __shfl_xor(ss, 4);
    const float r = rsqrtf(ss * (1.f / 64.f) + EPS);
#pragma unroll
    for (int j = 0; j < 4; ++j) { x1[j] = x1[j] * r * gain[4 * sub + j]; x2[j] = x2[j] * r * gain[32 + 4 * sub + j]; }
  }
  if (rope) {
#pragma unroll
    for (int j = 0; j < 4; ++j) { const float c = cs[4 * sub + j], s = sn[4 * sub + j]; const float o1 = x1[j] * c - x2[j] * s, o2 = x1[j] * s + x2[j] * c; x1[j] = o1; x2[j] = o2; }
  }
  if (doit) {
    u32x2 wa, wb; wa.x = pk2(x1[0] * scale, x1[1] * scale); wa.y = pk2(x1[2] * scale, x1[3] * scale); wb.x = pk2(x2[0] * scale, x2[1] * scale); wb.y = pk2(x2[2] * scale, x2[3] * scale);
    *(u32x2*)(base + 4 * sub) = wa; *(u32x2*)(base + 32 + 4 * sub) = wb;
  }
}
DI void phase_post_even(const Params& p) {
  const int tid = opaque_tid(), lane = tid & 63, gw = blockIdx.x * 8 + (tid >> 6), NGW = gridDim.x * 8;
  bf16_t* H = (bf16_t*)(p.ws + WS_H);
  const float* COSH = (const float*)(p.ws + WS_TAB); const float* SINH = COSH + 2048 * 32; const float* COSR = SINH + 2048 * 32; const float* SINR = COSR + 2048 * 16;
  for (int row = gw; row < MT; row += NGW) {
    bf16_t* hr = H + (size_t)row * EV_PITCH; const bool lat = row < ML; const int t = row & (SEQ - 1);
    const int sub = lane & 7;
    head_fix(hr + 512 + ((lane >> 3) & 1) * 64, sub, p.ev_ka_g, true, lat, COSH + t * 32, SINH + t * 32, 1.f, lane < 16);
    {
      const u32x2 a = *(const u32x2*)(hr + 768 + 4 * lane); float x[4] = {bflo(a.x), bfhi(a.x), bflo(a.y), bfhi(a.y)};
      const float r = rsqrtf(wave_sum(x[0] * x[0] + x[1] * x[1] + x[2] * x[2] + x[3] * x[3]) * (1.f / 256.f) + EPS);
      const f32x4 g = *(const f32x4*)(p.ev_qlat_g + 4 * lane);
      u32x2 w; w.x = pk2(x[0] * r * g.x, x[1] * r * g.y); w.y = pk2(x[2] * r * g.z, x[3] * r * g.w); *(u32x2*)(hr + 768 + 4 * lane) = w; }
    {
      const unsigned a = *(const unsigned*)(hr + 1024 + 2 * lane); const float x0 = bflo(a), x1 = bfhi(a);
      const float r = rsqrtf(wave_sum(x0 * x0 + x1 * x1) * (1.f / 128.f) + EPS);
      *(unsigned*)(hr + 1024 + 2 * lane) = pk2(x0 * r * p.ev_kvlat_g[2 * lane], x1 * r * p.ev_kvlat_g[2 * lane + 1]); }
    if (lat && lane < 16) {
      const float x1 = bf2f(hr[1152 + lane]), x2 = bf2f(hr[1152 + 16 + lane]); const float c = COSR[t * 16 + lane], s = SINR[t * 16 + lane];
      hr[1152 + lane] = f2bf(x1 * c - x2 * s); hr[1152 + 16 + lane] = f2bf(x1 * s + x2 * c); }
  }
}
DI void phase_post_odd(const Params& p) {
  const int tid = opaque_tid(), lane = tid & 63, gw = blockIdx.x * 8 + (tid >> 6), NGW = gridDim.x * 8;
  bf16_t* H = (bf16_t*)(p.ws + WS_H);
  const float* COSH = (const float*)(p.ws + WS_TAB); const float* SINH = COSH + 2048 * 32;
  for (int row = gw; row < ML; row += NGW) {
    bf16_t* hr = H + (size_t)row * OD_PITCH; const int t = row & (SEQ - 1); const int sub = lane & 7;
    { const u32x4 a = *(const u32x4*)(hr + 512 + 8 * lane);
      float x[8] = {bflo(a.x), bfhi(a.x), bflo(a.y), bfhi(a.y), bflo(a.z), bfhi(a.z), bflo(a.w), bfhi(a.w)}; float s = 0.f;
#pragma unroll
      for (int j = 0; j < 8; ++j) { x[j] = geluf_(x[j]); s += x[j]; }
      const float mu = wave_sum(s) * (1.f / 512.f); float q = 0.f;
#pragma unroll
      for (int j = 0; j < 8; ++j) { x[j] -= mu; q += x[j] * x[j]; }
      const float r = rsqrtf(wave_sum(q) * (1.f / 512.f) + EPS);
      const f32x4 g0 = *(const f32x4*)(p.od_ln_g + 8 * lane), g1 = *(const f32x4*)(p.od_ln_g + 8 * lane + 4), b0 = *(const f32x4*)(p.od_ln_b + 8 * lane), b1 = *(const f32x4*)(p.od_ln_b + 8 * lane + 4);
      u32x4 w; w.x = pk2(x[0] * r * g0.x + b0.x, x[1] * r * g0.y + b0.y); w.y = pk2(x[2] * r * g0.z + b0.z, x[3] * r * g0.w + b0.w);
      w.z = pk2(x[4] * r * g1.x + b1.x, x[5] * r * g1.y + b1.y); w.w = pk2(x[6] * r * g1.z + b1.z, x[7] * r * g1.w + b1.w);
      *(u32x4*)(hr + 512 + 8 * lane) = w; }
    head_fix(hr + 1536 + ((lane >> 3) & 1) * 64, sub, nullptr, false, true, COSH + t * 32, SINH + t * 32, 1.f, lane < 16);
  }
}
DI void phase_conv_act(const bf16_t* HUP, bf16_t* ACT, const float* cw, const float* cb, int rbeg, int rend) {
  const long total = (long)(rend - rbeg) * 352; const int tid = opaque_tid();
  for (long it = (long)blockIdx.x * NT + tid; it < total; it += (long)gridDim.x * NT) {
    const int lr = (int)(it / 352), ch = (int)(it % 352), row = rbeg + lr, j = ch * 8;
    const int pos = row < ML ? (row & (SEQ - 1)) : ((row - ML) & (CTX - 1)); const int len = row < ML ? SEQ : CTX;
    const bf16_t* h = HUP + (size_t)lr * FF2 + j;
    const u32x4 z4 = {0u, 0u, 0u, 0u};
    const u32x4 a0 = pos > 0 ? *(const u32x4*)(h - FF2) : z4, a1 = *(const u32x4*)h, a2 = pos < len - 1 ? *(const u32x4*)(h + FF2) : z4;
    const u32x4 g0 = pos > 0 ? *(const u32x4*)(h - FF2 + FF) : z4, g1 = *(const u32x4*)(h + FF), g2 = pos < len - 1 ? *(const u32x4*)(h + FF2 + FF) : z4;
    float o[8];
#pragma unroll
    for (int e = 0; e < 8; ++e) {
      const unsigned wa0 = a0[e >> 1], wa1 = a1[e >> 1], wa2 = a2[e >> 1], wg0 = g0[e >> 1], wg1 = g1[e >> 1], wg2 = g2[e >> 1];
      const float xa0 = (e & 1) ? bfhi(wa0) : bflo(wa0), xa1 = (e & 1) ? bfhi(wa1) : bflo(wa1), xa2 = (e & 1) ? bfhi(wa2) : bflo(wa2);
      const float xg0 = (e & 1) ? bfhi(wg0) : bflo(wg0), xg1 = (e & 1) ? bfhi(wg1) : bflo(wg1), xg2 = (e & 1) ? bfhi(wg2) : bflo(wg2);
      const int ja = j + e, jg = FF + j + e;
      const float A = cw[ja] * xa0 + cw[FF2 + ja] * xa1 + cw[2 * FF2 + ja] * xa2 + cb[ja];
      const float Gv = cw[jg] * xg0 + cw[FF2 + jg] * xg1 + cw[2 * FF2 + jg] * xg2 + cb[jg];
      o[e] = siluf_(Gv) * A;
    }
    u32x4 w; w.x = pk2(o[0], o[1]); w.y = pk2(o[2], o[3]); w.z = pk2(o[4], o[5]); w.w = pk2(o[6], o[7]);
    *(u32x4*)(ACT + (size_t)lr * FF + j) = w;
  }
}

struct AttnJob { const bf16_t *Q, *K1, *K2, *V; bf16_t* O; int qp, k1p, k2p, vp, op; int s0row, s0n, s1row, s1n; int win, qpos0, s1pos0; float sink2; int has_sink; const float* rope_cos; const float* rope_sin; const float* qg; const float* cosh; const float* sinh; float qscale; int q_rope; };
DI s16x4 vtr(const LAS unsigned char* pp) { typedef short v4i16_t __attribute__((ext_vector_type(4))); return __builtin_bit_cast(s16x4, __builtin_amdgcn_ds_read_tr16_b64_v4i16((LAS v4i16_t*)pp)); }
#define MFMA32(a, b, c) __builtin_amdgcn_mfma_f32_32x32x16_bf16((a), (b), (c), 0, 0, 0)

DI void q_fix64(bf16x8 (&qf)[4], const AttnJob& J, int pos, int h) {
  float x[4][8];
#pragma unroll
  for (int s = 0; s < 4; ++s)
#pragma unroll
    for (int j = 0; j < 8; ++j) x[s][j] = bf2f((unsigned short)qf[s][j]);
  if (J.qg) {
    float ss = 0.f;
#pragma unroll
    for (int s = 0; s < 4; ++s)
#pragma unroll
      for (int j = 0; j < 8; ++j) ss += x[s][j] * x[s][j];
    ss += __shfl_xor(ss, 32);
    const float r = rsqrtf(ss * (1.f / 64.f) + EPS);
#pragma unroll
    for (int s = 0; s < 4; ++s) { const f32x4 g0 = *(const f32x4*)(J.qg + 16 * s + 8 * h), g1 = *(const f32x4*)(J.qg + 16 * s + 8 * h + 4);
#pragma unroll
      for (int j = 0; j < 4; ++j) { x[s][j] *= r * g0[j]; x[s][4 + j] *= r * g1[j]; } }
  }
  if (J.q_rope) {
#pragma unroll
    for (int s = 0; s < 2; ++s) { const float* cp = J.cosh + pos * 32 + 16 * s + 8 * h; const float* sp = J.sinh + pos * 32 + 16 * s + 8 * h;
      const f32x4 c0 = *(const f32x4*)cp, c1 = *(const f32x4*)(cp + 4), s0 = *(const f32x4*)sp, s1 = *(const f32x4*)(sp + 4);
#pragma unroll
      for (int j = 0; j < 8; ++j) { const float c = j < 4 ? c0[j & 3] : c1[j & 3], sn = j < 4 ? s0[j & 3] : s1[j & 3]; const float x1 = x[s][j], x2 = x[s + 2][j];
        x[s][j] = x1 * c - x2 * sn; x[s + 2][j] = x1 * sn + x2 * c; } }
  }
#pragma unroll
  for (int s = 0; s < 4; ++s) { u32x4 w; w.x = pk2(x[s][0] * J.qscale, x[s][1] * J.qscale); w.y = pk2(x[s][2] * J.qscale, x[s][3] * J.qscale);
    w.z = pk2(x[s][4] * J.qscale, x[s][5] * J.qscale); w.w = pk2(x[s][6] * J.qscale, x[s][7] * J.qscale); qf[s] = __builtin_bit_cast(bf16x8, w); }
}
template <int DK> DI void attn_unit(const AttnJob& J, LAS unsigned char* lds) {
  constexpr int KP = DK * 2 + 16, VP = 144, KBUF = 64 * KP, VBUF = 64 * VP, NS = DK / 16;
  const int tid = opaque_tid(), lane = tid & 63, wave = tid >> 6, r32 = lane & 31, h = lane >> 5;
  LAS unsigned char* Kl = lds; LAS unsigned char* Vl = lds + 2 * KBUF;
  const bf16_t* qrow = J.Q + (size_t)(wave * 32 + r32) * J.qp;
  bf16x8 qf[NS];
#pragma unroll
  for (int s = 0; s < NS; ++s) qf[s] = *(const bf16x8*)(qrow + 16 * s + 8 * h);
  if constexpr (DK == 64) q_fix64(qf, J, J.qpos0 + wave * 32 + r32, h);
  if (DK == 96) { if (J.rope_cos) {
    const float* cs = J.rope_cos + (J.qpos0 + wave * 32 + r32) * 16 + 8 * h; const float* sn = J.rope_sin + (J.qpos0 + wave * 32 + r32) * 16 + 8 * h;
#pragma unroll
    for (int j = 0; j < 8; ++j) { const float x1 = bf2f((unsigned short)qf[NS - 2][j]), x2 = bf2f((unsigned short)qf[NS - 1][j]); const float c = cs[j], s_ = sn[j];
      qf[NS - 2][j] = (short)f2bf(x1 * c - x2 * s_); qf[NS - 1][j] = (short)f2bf(x1 * s_ + x2 * c); } } }
  const int nt0 = J.s0n >> 6, nt = nt0 + (J.s1n >> 6);
  const int srow = tid >> 3, sch = tid & 7;
  const int s2row = (tid >> 2) & 63, s2ch = tid & 3;
  u32x4 rk, rv, rk2;
  auto tile_row = [&](int t) -> int { return t < nt0 ? J.s0row + 64 * t : J.s1row + 64 * (t - nt0); };
  auto gload = [&](int t) { const int kr0 = tile_row(t);
    rk = *(const u32x4*)(J.K1 + (size_t)(kr0 + srow) * J.k1p + sch * 8);
    rv = *(const u32x4*)(J.V + (size_t)(kr0 + srow) * J.vp + sch * 8);
    if (DK == 96) { if (tid < 256) rk2 = *(const u32x4*)(J.K2 + (size_t)(kr0 + s2row) * J.k2p + s2ch * 8); } };
  auto lstore = [&](int b) {
    *(LAS u32x4*)(Kl + b * KBUF + srow * KP + sch * 16) = rk;
    *(LAS u32x4*)(Vl + b * VBUF + srow * VP + sch * 16) = rv;
    if (DK == 96) { if (tid < 256) *(LAS u32x4*)(Kl + b * KBUF + s2row * KP + 128 + s2ch * 16) = rk2; } };
  gload(0); lstore(0); __syncthreads();
  float m = 0.f, lsum = 0.f; f32x16 O0 = {}, O1 = {};
  const int qpos = J.qpos0 + wave * 32 + r32, qmin = J.qpos0 + wave * 32;
  const int q4 = (lane & 15) >> 2, p4 = lane & 3, blk = (lane >> 4) & 1;
  for (int t = 0; t < nt; ++t) {
    if (t + 1 < nt) gload(t + 1);
    const LAS unsigned char* Kb = Kl + (t & 1) * KBUF; const LAS unsigned char* Vb = Vl + (t & 1) * VBUF;
    bool active = true; int kp0 = 0;
    if (J.win && t >= nt0) { kp0 = J.s1pos0 + 64 * (t - nt0); active = (kp0 + 63 >= qmin - 128) && (kp0 <= qmin + 31 + 128); }
    if (active) {
      f32x16 S0, S1;
#pragma unroll
      for (int i = 0; i < 16; ++i) { S0[i] = -m; S1[i] = -m; }
#pragma unroll
      for (int s = 0; s < NS; ++s) {
        const bf16x8 k0 = *(const LAS bf16x8*)(Kb + r32 * KP + (16 * s + 8 * h) * 2);
        const bf16x8 k1 = *(const LAS bf16x8*)(Kb + (32 + r32) * KP + (16 * s + 8 * h) * 2);
        S0 = MFMA32(k0, qf[s], S0); S1 = MFMA32(k1, qf[s], S1);
      }
      if (J.win && t >= nt0) {
#pragma unroll
        for (int i = 0; i < 16; ++i) { const int kpos = kp0 + crow(i, h); const int d0 = qpos - kpos, d1 = d0 - 32;
          if (d0 > 128 || d0 < -128) S0[i] = -1e30f; if (d1 > 128 || d1 < -128) S1[i] = -1e30f; }
      }
      float mx = fmaxf(S0[0], S1[0]);
#pragma unroll
      for (int i = 1; i < 16; ++i) mx = fmaxf(mx, fmaxf(S0[i], S1[i]));
      mx = fmaxf(mx, __shfl_xor(mx, 32));
      if (__any(mx > 6.0f)) {
        const float dl = fmaxf(mx, 0.f); m += dl; const float alpha = __builtin_amdgcn_exp2f(-dl); lsum *= alpha;
#pragma unroll
        for (int i = 0; i < 16; ++i) { S0[i] -= dl; S1[i] -= dl; O0[i] *= alpha; O1[i] *= alpha; }
      }
      float ps = 0.f;
#pragma unroll
      for (int i = 0; i < 16; ++i) { S0[i] = __builtin_amdgcn_exp2f(S0[i]); S1[i] = __builtin_amdgcn_exp2f(S1[i]); ps += S0[i] + S1[i]; }
      lsum += ps;
#pragma unroll
      for (int kb = 0; kb < 2; ++kb)
#pragma unroll
        for (int s2 = 0; s2 < 2; ++s2) {
          u32x4 pw;
          if (kb == 0) { pw.x = pk2(S0[8 * s2 + 0], S0[8 * s2 + 1]); pw.y = pk2(S0[8 * s2 + 2], S0[8 * s2 + 3]); pw.z = pk2(S0[8 * s2 + 4], S0[8 * s2 + 5]); pw.w = pk2(S0[8 * s2 + 6], S0[8 * s2 + 7]); }
          else         { pw.x = pk2(S1[8 * s2 + 0], S1[8 * s2 + 1]); pw.y = pk2(S1[8 * s2 + 2], S1[8 * s2 + 3]); pw.z = pk2(S1[8 * s2 + 4], S1[8 * s2 + 5]); pw.w = pk2(S1[8 * s2 + 6], S1[8 * s2 + 7]); }
          const bf16x8 pf = __builtin_bit_cast(bf16x8, pw);
          const LAS unsigned char* vb = Vb + (kb * 32 + 16 * s2 + 4 * h + q4) * VP + (blk * 16 + 4 * p4) * 2;
          { const s16x4 lo = vtr(vb), hi = vtr(vb + 8 * VP); const bf16x8 vf = __builtin_shufflevector(lo, hi, 0, 1, 2, 3, 4, 5, 6, 7); O0 = MFMA32(vf, pf, O0); }
          { const s16x4 lo = vtr(vb + 64), hi = vtr(vb + 64 + 8 * VP); const bf16x8 vf = __builtin_shufflevector(lo, hi, 0, 1, 2, 3, 4, 5, 6, 7); O1 = MFMA32(vf, pf, O1); }
        }
    }
    if (t + 1 < nt) lstore((t + 1) & 1);
    __syncthreads();
  }
  lsum += __shfl_xor(lsum, 32);
  if (J.has_sink) lsum += __builtin_amdgcn_exp2f(J.sink2 - m);
  const float inv = 1.f / lsum;
  bf16_t* orow = J.O + (size_t)(wave * 32 + r32) * J.op;
#pragma unroll
  for (int g = 0; g < 4; ++g) {
    u32x2 w0, w1; w0.x = pk2(O0[4 * g] * inv, O0[4 * g + 1] * inv); w0.y = pk2(O0[4 * g + 2] * inv, O0[4 * g + 3] * inv);
    w1.x = pk2(O1[4 * g] * inv, O1[4 * g + 1] * inv); w1.y = pk2(O1[4 * g + 2] * inv, O1[4 * g + 3] * inv);
    *(u32x2*)(orow + 8 * g + 4 * h) = w0; *(u32x2*)(orow + 32 + 8 * g + 4 * h) = w1;
  }
}

template <int DK> DI void attn_unit2(const AttnJob& J, LAS unsigned char* lds) {
  constexpr int KP = DK * 2 + 16, VP = 144, KBUF = 64 * KP, VBUF = 64 * VP, NS = DK / 16;
  const int tid = opaque_tid(), lane = tid & 63, wave = tid >> 6, r32 = lane & 31, h = lane >> 5;
  LAS unsigned char* Kl = lds; LAS unsigned char* Vl = lds + 2 * KBUF;
  bf16x8 qf[2][NS];
#pragma unroll
  for (int qb = 0; qb < 2; ++qb) {
    const bf16_t* qrow = J.Q + (size_t)(wave * 64 + qb * 32 + r32) * J.qp;
#pragma unroll
    for (int s = 0; s < NS; ++s) qf[qb][s] = *(const bf16x8*)(qrow + 16 * s + 8 * h);
    if constexpr (DK == 64) q_fix64(qf[qb], J, J.qpos0 + wave * 64 + qb * 32 + r32, h);
    if (DK == 96) { if (J.rope_cos) {
      const float* cs = J.rope_cos + (J.qpos0 + wave * 64 + qb * 32 + r32) * 16 + 8 * h; const float* sn = J.rope_sin + (J.qpos0 + wave * 64 + qb * 32 + r32) * 16 + 8 * h;
#pragma unroll
      for (int j = 0; j < 8; ++j) { const float x1 = bf2f((unsigned short)qf[qb][NS - 2][j]), x2 = bf2f((unsigned short)qf[qb][NS - 1][j]); const float c = cs[j], s_ = sn[j];
        qf[qb][NS - 2][j] = (short)f2bf(x1 * c - x2 * s_); qf[qb][NS - 1][j] = (short)f2bf(x1 * s_ + x2 * c); } } }
  }
  const int nt0 = J.s0n >> 6, nt = nt0 + (J.s1n >> 6);
  const int srow = tid >> 3, sch = tid & 7; const int s2row = (tid >> 2) & 63, s2ch = tid & 3;
  u32x4 rk, rv, rk2;
  auto tile_row = [&](int t) -> int { return t < nt0 ? J.s0row + 64 * t : J.s1row + 64 * (t - nt0); };
  auto gload = [&](int t) { const int kr0 = tile_row(t);
    rk = *(const u32x4*)(J.K1 + (size_t)(kr0 + srow) * J.k1p + sch * 8);
    rv = *(const u32x4*)(J.V + (size_t)(kr0 + srow) * J.vp + sch * 8);
    if (DK == 96) { if (tid < 256) rk2 = *(const u32x4*)(J.K2 + (size_t)(kr0 + s2row) * J.k2p + s2ch * 8); } };
  auto lstore = [&](int b) {
    *(LAS u32x4*)(Kl + b * KBUF + srow * KP + sch * 16) = rk;
    *(LAS u32x4*)(Vl + b * VBUF + srow * VP + sch * 16) = rv;
    if (DK == 96) { if (tid < 256) *(LAS u32x4*)(Kl + b * KBUF + s2row * KP + 128 + s2ch * 16) = rk2; } };
  gload(0); lstore(0); __syncthreads();
  float m[2] = {0.f, 0.f}, lsum[2] = {0.f, 0.f}; f32x16 O[2][2];
#pragma unroll
  for (int qb = 0; qb < 2; ++qb) { O[qb][0] = (f32x16){}; O[qb][1] = (f32x16){}; }
  const int q4 = (lane & 15) >> 2, p4 = lane & 3, blk = (lane >> 4) & 1;
  const int qmin = J.qpos0 + wave * 64;
  for (int t = 0; t < nt; ++t) {
    if (t + 1 < nt) gload(t + 1);
    const LAS unsigned char* Kb = Kl + (t & 1) * KBUF; const LAS unsigned char* Vb = Vl + (t & 1) * VBUF;
    bool active = true; int kp0 = 0;
    if (J.win && t >= nt0) { kp0 = J.s1pos0 + 64 * (t - nt0); active = (kp0 + 63 >= qmin - 128) && (kp0 <= qmin + 63 + 128); }
    if (active) {
    f32x16 S[2][2];
#pragma unroll
    for (int qb = 0; qb < 2; ++qb)
#pragma unroll
      for (int i = 0; i < 16; ++i) { S[qb][0][i] = -m[qb]; S[qb][1][i] = -m[qb]; }
#pragma unroll
    for (int s = 0; s < NS; ++s) {
      const bf16x8 k0 = *(const LAS bf16x8*)(Kb + r32 * KP + (16 * s + 8 * h) * 2);
      const bf16x8 k1 = *(const LAS bf16x8*)(Kb + (32 + r32) * KP + (16 * s + 8 * h) * 2);
#pragma unroll
      for (int qb = 0; qb < 2; ++qb) { S[qb][0] = MFMA32(k0, qf[qb][s], S[qb][0]); S[qb][1] = MFMA32(k1, qf[qb][s], S[qb][1]); }
    }
    if (J.win && t >= nt0) {
#pragma unroll
      for (int qb = 0; qb < 2; ++qb) { const int qpos = qmin + qb * 32 + r32;
#pragma unroll
        for (int i = 0; i < 16; ++i) { const int kpos = kp0 + crow(i, h); const int d0 = qpos - kpos, d1 = d0 - 32;
          if (d0 > 128 || d0 < -128) S[qb][0][i] = -1e30f; if (d1 > 128 || d1 < -128) S[qb][1][i] = -1e30f; } }
    }
#pragma unroll
    for (int qb = 0; qb < 2; ++qb) {
      float mx = fmaxf(S[qb][0][0], S[qb][1][0]);
#pragma unroll
      for (int i = 1; i < 16; ++i) mx = fmaxf(mx, fmaxf(S[qb][0][i], S[qb][1][i]));
      mx = fmaxf(mx, __shfl_xor(mx, 32));
      if (__any(mx > 6.0f)) {
        const float dl = fmaxf(mx, 0.f); m[qb] += dl; const float alpha = __builtin_amdgcn_exp2f(-dl); lsum[qb] *= alpha;
#pragma unroll
        for (int i = 0; i < 16; ++i) { S[qb][0][i] -= dl; S[qb][1][i] -= dl; O[qb][0][i] *= alpha; O[qb][1][i] *= alpha; }
      }
      float ps = 0.f;
#pragma unroll
      for (int i = 0; i < 16; ++i) { S[qb][0][i] = __builtin_amdgcn_exp2f(S[qb][0][i]); S[qb][1][i] = __builtin_amdgcn_exp2f(S[qb][1][i]); ps += S[qb][0][i] + S[qb][1][i]; }
      lsum[qb] += ps;
    }
#pragma unroll
    for (int kb = 0; kb < 2; ++kb)
#pragma unroll
      for (int s2 = 0; s2 < 2; ++s2) {
        const LAS unsigned char* vb = Vb + (kb * 32 + 16 * s2 + 4 * h + q4) * VP + (blk * 16 + 4 * p4) * 2;
        const s16x4 lo0 = vtr(vb), hi0 = vtr(vb + 8 * VP), lo1 = vtr(vb + 64), hi1 = vtr(vb + 64 + 8 * VP);
        const bf16x8 vf0 = __builtin_shufflevector(lo0, hi0, 0, 1, 2, 3, 4, 5, 6, 7), vf1 = __builtin_shufflevector(lo1, hi1, 0, 1, 2, 3, 4, 5, 6, 7);
#pragma unroll
        for (int qb = 0; qb < 2; ++qb) {
          u32x4 pw; pw.x = pk2(S[qb][kb][8 * s2 + 0], S[qb][kb][8 * s2 + 1]); pw.y = pk2(S[qb][kb][8 * s2 + 2], S[qb][kb][8 * s2 + 3]);
          pw.z = pk2(S[qb][kb][8 * s2 + 4], S[qb][kb][8 * s2 + 5]); pw.w = pk2(S[qb][kb][8 * s2 + 6], S[qb][kb][8 * s2 + 7]);
          const bf16x8 pf = __builtin_bit_cast(bf16x8, pw);
          O[qb][0] = MFMA32(vf0, pf, O[qb][0]); O[qb][1] = MFMA32(vf1, pf, O[qb][1]);
        }
      }
    }
    if (t + 1 < nt) lstore((t + 1) & 1);
    __syncthreads();
  }
#pragma unroll
  for (int qb = 0; qb < 2; ++qb) {
    float l = lsum[qb]; l += __shfl_xor(l, 32); if (J.has_sink) l += __builtin_amdgcn_exp2f(J.sink2 - m[qb]); const float inv = 1.f / l;
    bf16_t* orow = J.O + (size_t)(wave * 64 + qb * 32 + r32) * J.op;
#pragma unroll
    for (int db = 0; db < 2; ++db)
#pragma unroll
      for (int gp = 0; gp < 2; ++gp) {
        u32x2 pa, pb; pa.x = pk2(O[qb][db][8 * gp] * inv, O[qb][db][8 * gp + 1] * inv); pa.y = pk2(O[qb][db][8 * gp + 2] * inv, O[qb][db][8 * gp + 3] * inv);
        pb.x = pk2(O[qb][db][8 * gp + 4] * inv, O[qb][db][8 * gp + 5] * inv); pb.y = pk2(O[qb][db][8 * gp + 6] * inv, O[qb][db][8 * gp + 7] * inv);
        const unsigned sx = h ? pa.x : pb.x, sy = h ? pa.y : pb.y;
        const unsigned rx = __shfl_xor(sx, 32), ry = __shfl_xor(sy, 32);
        u32x4 w; if (h) { w.x = rx; w.y = ry; w.z = pb.x; w.w = pb.y; } else { w.x = pa.x; w.y = pa.y; w.z = rx; w.w = ry; }
        *(u32x4*)(orow + db * 32 + 16 * gp + 8 * h) = w;
      }
  }
}

DI void phase_attn_even(const Params& p, LAS unsigned char* lds) {
  const bf16_t* H = (const bf16_t*)(p.ws + WS_H); const bf16_t* QB = (const bf16_t*)(p.ws + WS_QB); const bf16_t* KVB = (const bf16_t*)(p.ws + WS_KVB); bf16_t* Y = (bf16_t*)(p.ws + WS_Y);
  for (int u = xcd_vid(); u < 1280; u += gridDim.x) {
    AttnJob J; J.win = 0; J.qpos0 = 0; J.s1pos0 = 0; J.sink2 = 0.f; J.has_sink = 0; J.rope_cos = nullptr; J.rope_sin = nullptr;
    J.qg = p.ev_qa_g; J.cosh = (const float*)(p.ws + WS_TAB); J.sinh = J.cosh + 2048 * 32; J.qscale = 0.125f * LOG2E; J.q_rope = 0;
    int typeB, b, head, qrow0, s1n; const bool big = u < 1024; J.q_rope = big ? 1 : 0;
    if (big) { typeB = u >> 9; const int v = u & 511; b = v >> 5; head = (v >> 2) & 7; qrow0 = b * SEQ + (v & 3) * 512; s1n = SEQ; J.qpos0 = (v & 3) * 512;
      J.rope_cos = (const float*)(p.ws + WS_TAB) + 2 * 2048 * 32; J.rope_sin = J.rope_cos + 2048 * 16; }
    else { const int v = u - 1024; typeB = v >> 7; b = (v & 127) >> 3; head = v & 7; qrow0 = ML + b * CTX; s1n = 0; }
    J.s0row = ML + b * CTX; J.s0n = CTX; J.s1row = b * SEQ; J.s1n = s1n;
    if (!typeB) {
      J.Q = H + (size_t)qrow0 * EV_PITCH + head * 64; J.qp = EV_PITCH;
      J.K1 = H + 512 + (head >> 2) * 64; J.k1p = EV_PITCH; J.K2 = nullptr; J.k2p = 0;
      J.V = H + 640 + (head >> 2) * 64; J.vp = EV_PITCH;
      J.O = Y + (size_t)qrow0 * DM + head * 64; J.op = DM;
      if (big) attn_unit2<64>(J, lds); else attn_unit<64>(J, lds);
    } else {
      J.Q = QB + (size_t)qrow0 * 1792 + head * 96; J.qp = 1792;
      J.K1 = QB + 768 + head * 128; J.k1p = 1792; J.K2 = H + 1152; J.k2p = EV_PITCH;
      J.V = QB + 768 + head * 128 + 64; J.vp = 1792;
      J.O = Y + (size_t)qrow0 * DM + 512 + head * 64; J.op = DM;
      if (big) attn_unit2<96>(J, lds); else attn_unit<96>(J, lds);
    }
  }
}
DI void phase_attn_odd(const Params& p, LAS unsigned char* lds) {
  const bf16_t* H = (const bf16_t*)(p.ws + WS_H); bf16_t* Y = (bf16_t*)(p.ws + WS_Y);
  for (int u = xcd_vid(); u < 512; u += gridDim.x) {
    const int b = u >> 5, head = (u >> 2) & 7, q0 = (u & 3) * 512, qrow0 = b * SEQ + q0;
    const int lo = q0 - 128 < 0 ? 0 : q0 - 128, hi = q0 + 640 > SEQ ? SEQ : q0 + 640;
    AttnJob J; J.rope_cos = nullptr; J.rope_sin = nullptr; J.qg = nullptr; J.cosh = (const float*)(p.ws + WS_TAB); J.sinh = J.cosh + 2048 * 32; J.qscale = 0.125f * LOG2E; J.q_rope = 1; J.win = 1; J.qpos0 = q0; J.s1pos0 = lo; J.sink2 = p.od_sink[head] * LOG2E; J.has_sink = 1;
    J.s0row = ML + b * CTX; J.s0n = CTX; J.s1row = b * SEQ + lo; J.s1n = hi - lo;
    J.Q = H + (size_t)qrow0 * OD_PITCH + 1024 + head * 64; J.qp = OD_PITCH;
    J.K1 = H + 1536 + (head >> 2) * 64; J.k1p = OD_PITCH; J.K2 = nullptr; J.k2p = 0;
    J.V = H + 1664 + (head >> 2) * 64; J.vp = OD_PITCH;
    J.O = Y + (size_t)qrow0 * DM + 512 + head * 64; J.op = DM;
    attn_unit2<64>(J, lds);
  }
}
DI void phase_sgu(const Params& p, LAS unsigned char* lds) {
  constexpr int RP = 1056;
  const bf16_t* H = (const bf16_t*)(p.ws + WS_H); bf16_t* Y = (bf16_t*)(p.ws + WS_Y);
  const int tid = opaque_tid(), lane = tid & 63, g = tid >> 6, r32 = lane & 31, h = lane >> 5;
  const int q4 = (lane & 15) >> 2, p4 = lane & 3, blk = (lane >> 4) & 1;
  for (int u = blockIdx.x; u < 256; u += gridDim.x) {
    const int row0 = (u >> 4) * SEQ + (u & 15) * 128;
    __syncthreads();
    for (int i = tid; i < 128 * 64; i += NT) { const int r = i >> 6, ch = i & 63;
      *(LAS u32x4*)(lds + r * RP + ch * 16) = *(const u32x4*)(H + (size_t)(row0 + r) * OD_PITCH + 512 + ch * 8); }
    __syncthreads();
    f32x16 acc[4][2];
#pragma unroll
    for (int a = 0; a < 4; ++a) { acc[a][0] = (f32x16){}; acc[a][1] = (f32x16){}; }
    const float* wg = p.od_sgu_w + (size_t)g * 128 * 128;
#pragma unroll 1
    for (int s = 0; s < 8; ++s) {
      const LAS unsigned char* vb = lds + (16 * s + 4 * h + q4) * RP + (g * 64 + blk * 16 + 4 * p4) * 2;
      const s16x4 l0 = vtr(vb), h0 = vtr(vb + 8 * RP), l1 = vtr(vb + 64), h1 = vtr(vb + 64 + 8 * RP);
      const bf16x8 vf0 = __builtin_shufflevector(l0, h0, 0, 1, 2, 3, 4, 5, 6, 7), vf1 = __builtin_shufflevector(l1, h1, 0, 1, 2, 3, 4, 5, 6, 7);
#pragma unroll
      for (int pb = 0; pb < 4; ++pb) {
        const float* wp = wg + (size_t)(pb * 32 + r32) * 128 + 16 * s + 4 * h;
        const f32x4 w0 = *(const f32x4*)wp, w1 = *(const f32x4*)(wp + 8);
        u32x4 pw; pw.x = pk2(w0.x, w0.y); pw.y = pk2(w0.z, w0.w); pw.z = pk2(w1.x, w1.y); pw.w = pk2(w1.z, w1.w);
        const bf16x8 wf = __builtin_bit_cast(bf16x8, pw);
        acc[pb][0] = MFMA32(vf0, wf, acc[pb][0]); acc[pb][1] = MFMA32(vf1, wf, acc[pb][1]);
      }
    }
#pragma unroll
    for (int pb = 0; pb < 4; ++pb) {
      const int pp = pb * 32 + r32; const float bs = p.od_sgu_b[g * 128 + pp];
      const bf16_t* ur = H + (size_t)(row0 + pp) * OD_PITCH + g * 64; bf16_t* yr = Y + (size_t)(row0 + pp) * DM + g * 64;
#pragma unroll
      for (int db = 0; db < 2; ++db)
#pragma unroll
        for (int g4 = 0; g4 < 4; ++g4) { const int d0 = db * 32 + 8 * g4 + 4 * h;
          const u32x2 uu = *(const u32x2*)(ur + d0);
          const float y0 = geluf_(bflo(uu.x)) * (acc[pb][db][4 * g4] + bs), y1 = geluf_(bfhi(uu.x)) * (acc[pb][db][4 * g4 + 1] + bs);
          const float y2 = geluf_(bflo(uu.y)) * (acc[pb][db][4 * g4 + 2] + bs), y3 = geluf_(bfhi(uu.y)) * (acc[pb][db][4 * g4 + 3] + bs);
          u32x2 w; w.x = pk2(y0, y1); w.y = pk2(y2, y3); *(u32x2*)(yr + d0) = w; }
    }
  }
  __syncthreads();
}

#define GAS __attribute__((address_space(1)))
#define XB_TMO      128
#define XB_XCNT(j)  (256  + 64 * (j))
#define XB_XSUB(j)  (1280 + 64 * (j))
#define XB_XGEN(j)  (2304 + 64 * (j))
#define XB_TOP      3328
#define XB_TOPGEN   3392
#define XCD_BAR_WORDS 3456
#define XB_SPIN_CAP (1u << 18)

__device__ __forceinline__ unsigned xb_ld(unsigned* p)              { return __hip_atomic_load(p, __ATOMIC_RELAXED, __HIP_MEMORY_SCOPE_AGENT); }
__device__ __forceinline__ unsigned xb_add(unsigned* p, unsigned v) { return __hip_atomic_fetch_add(p, v, __ATOMIC_RELAXED, __HIP_MEMORY_SCOPE_AGENT); }
__device__ __forceinline__ unsigned xb_xcc_id() { return (unsigned)__builtin_amdgcn_s_getreg((3 << 11) | 20) & 0xFu; }
#define XB_SPIN(cond, bar) do { unsigned _sp = 0; while (cond) { __builtin_amdgcn_s_sleep(1); \
    if ((++_sp & 255u) == 0u) { if (xb_ld(&(bar)[XB_TMO])) break; if (_sp > XB_SPIN_CAP) { atomicAdd(&(bar)[XB_TMO], 1u); break; } } } } while (0)

struct XcdBarrier {
    unsigned* bar; unsigned x;
    volatile LAS unsigned* st;
};

__device__ __forceinline__ XcdBarrier xcd_barrier_post(unsigned* bar, volatile LAS unsigned* st) {
    XcdBarrier b; b.bar = bar; b.x = xb_xcc_id(); b.st = st;
    if (threadIdx.x == 0) (void)xb_add(&bar[XB_XCNT(b.x)], 1u);
    return b;
}
__device__ __forceinline__ void xcd_barrier_complete(unsigned* bar, unsigned x, unsigned& nloc, unsigned& nx) {
    const unsigned G = gridDim.x * gridDim.y * gridDim.z;
    unsigned sum, cnt, mine, sp = 0u;
    for (;;) {
        sum = 0u; cnt = 0u; mine = 0u;
#pragma unroll
        for (unsigned j = 0; j < 16; ++j) { const unsigned c = xb_ld(&bar[XB_XCNT(j)]); sum += c; cnt += (c > 0u) ? 1u : 0u; mine = (j == x) ? c : mine; }
        if (sum == G) break;
        __builtin_amdgcn_s_sleep(1);
        if ((++sp & 255u) == 0u) { if (xb_ld(&bar[XB_TMO])) break; if (sp > XB_SPIN_CAP) { atomicAdd(&bar[XB_TMO], 1u); break; } }
    }
    nloc = mine > 0u ? mine : 1u; nx = cnt > 0u ? cnt : 1u;
}

__device__ __forceinline__ void xcd_barrier(const XcdBarrier& b) {
    asm volatile("s_waitcnt vmcnt(0)" ::: "memory");
    __syncthreads();
    if (threadIdx.x == 0) {
        unsigned* bar = b.bar;
        __builtin_amdgcn_s_waitcnt(0);
        unsigned nloc = b.st[0], nx = b.st[1];
        if (nloc == 0u) { xcd_barrier_complete(bar, b.x, nloc, nx); b.st[0] = nloc; b.st[1] = nx; }
        const unsigned old = xb_add(&bar[XB_XSUB(b.x)], 1u);
        const unsigned gen = old / nloc;
        if (old + 1u == (gen + 1u) * nloc) {
            __builtin_amdgcn_fence(__ATOMIC_RELEASE, "agent");
            asm volatile("s_waitcnt vmcnt(0)" ::: "memory");
            const unsigned og = xb_add(&bar[XB_TOP], 1u);
            const unsigned tg = og / nx;
            if (og + 1u == (tg + 1u) * nx) xb_add(&bar[XB_TOPGEN], 1u);
            else XB_SPIN(xb_ld(&bar[XB_TOPGEN]) == tg, bar);
            __builtin_amdgcn_fence(__ATOMIC_ACQUIRE, "agent");
            xb_add(&bar[XB_XGEN(b.x)], 1u);
            asm volatile("s_waitcnt vmcnt(0)" ::: "memory");
        } else {
            XB_SPIN(xb_ld(&bar[XB_XGEN(b.x)]) == gen, bar);
            __builtin_amdgcn_fence(__ATOMIC_ACQUIRE, "agent");
            asm volatile("s_waitcnt vmcnt(0)" ::: "memory");
        }
    }
    __syncthreads();
}

constexpr size_t WS_BAR = 1 * MiB + 832 * 1024;
constexpr int LDS_BARST = 143360;

constexpr int LDS_BYTES = 147456;
#define GSYNC() do { XcdBarrier xb_; xb_.bar = (unsigned*)(ws_bar); xb_.x = xb_xcc_id(); xb_.st = (volatile LAS unsigned*)(lds + LDS_BARST); xcd_barrier(xb_); } while (0)
struct OdinOrder {
  pg8::StaticOrder S; int G, c;
  DI void init(int G_, int c_) { S.init(ML, OD_PITCH, G_, c_); G = G_; c = c_; }
  DI bool next(int i, pg8::Unit& u) const { const int L = i * G + c; if (L < 896) return S.next(i, u); if (L >= 912) return false; u.pm = 128 + (L - 896); u.pn = 6; return true; }
  DI void a_ready(const pg8::Unit&) const {}
  DI void done(const pg8::Unit&) const {}
};
template <class Epi> DI void run_gemm(LAS unsigned char* lds, const bf16_t* A, int lda, const bf16_t* Bt, int ldb, int M, int N, int K, const Epi& E) {
  pg8::Gemm g{A, Bt, M, N, K, lda, ldb}; pg8::StaticOrder S; S.init(M, N, (int)gridDim.x, (int)blockIdx.x);
  pg8::gemm_phase<Epi, pg8::StaticOrder, true, true>(lds, g, S, E);
}

typedef const unsigned long long __attribute__((address_space(4)))* kargp_t;
DI Params load_params(kargp_t q) { asm volatile("" : "+s"(q)); Params r; unsigned long long* d = (unsigned long long*)&r;
#pragma unroll
  for (int i = 0; i < 30; ++i) d[i] = q[i];
  return r; }
#define PH_BEGIN { const Params p = load_params(kp); unsigned char* ws = p.ws; (void)ws;
#ifdef PROBE_A
#define TSL ((LAS unsigned long long*)(lds + 143360))
#define PH_END } GSYNC(); if (blockIdx.x == 0 && threadIdx.x == 0) { const unsigned long long now_ = __builtin_amdgcn_s_memrealtime(); if (ph_id == PROBE_A) TSL[0] = now_; if (ph_id == PROBE_B) TSL[1] = now_; if (ph_id == PROBE_C) TSL[2] = now_; if (ph_id == PROBE_D) TSL[3] = now_; } ++ph_id;
#else
#define PH_END } GSYNC();
#endif
#define WSP(T, off) ((T*)(ws + (off)))
typedef pg8::EpiBf16<0> EB;

__global__ void __launch_bounds__(NT, 2) fwd_kernel(Params p_unused) {
  extern __shared__ __attribute__((aligned(16))) unsigned char lds_raw[];
  LAS unsigned char* lds = (LAS unsigned char*)lds_raw;
  cg::grid_group grid = cg::this_grid();
  const kargp_t kp = (kargp_t)__builtin_amdgcn_kernarg_segment_ptr();
  constexpr size_t MOD1 = WS_MOD + (size_t)17 * 6144 * 4;
#ifdef PROBE_A
  int ph_id = 0; if (blockIdx.x == 0 && threadIdx.x == 0) { const unsigned long long now_ = __builtin_amdgcn_s_memrealtime(); TSL[0] = now_; TSL[1] = now_; TSL[2] = now_; TSL[3] = now_; }
#endif

  unsigned* ws_bar;
  { const Params p = load_params(kp); ws_bar = (unsigned*)(p.ws + WS_BAR);
    if (threadIdx.x < 2) ((LAS unsigned*)(lds + LDS_BARST))[threadIdx.x] = 0u;
    __syncthreads();
    (void)xcd_barrier_post(ws_bar, (volatile LAS unsigned*)(lds + LDS_BARST));
    phase_prologue(p, lds); }
  GSYNC();
  if (p_unused.ws == nullptr) grid.sync();
  PH_BEGIN phase_norm_mod(p.x, p.ctx, p.norm1_g, WSP(const float, WS_MOD), 0, 1, WSP(bf16_t, WS_Z), 0, MT); PH_END
  PH_BEGIN run_gemm(lds, WSP(const bf16_t, WS_Z), DM, WSP(const bf16_t, WS_W_EVIN), DM, MT, EV_PITCH, DM, EB{WSP(bf16_t, WS_H), EV_PITCH, nullptr, 0, 0, 1.f}); PH_END
  PH_BEGIN phase_post_even(p); PH_END
  PH_BEGIN run_gemm(lds, WSP(const bf16_t, WS_H) + 768, EV_PITCH, WSP(const bf16_t, WS_W_QUP), 384, MT, 1792, 384, EB{WSP(bf16_t, WS_QB), 1792, nullptr, 768, 768, 0.10206207261596577f * LOG2E}); PH_END
  PH_BEGIN phase_attn_even(p, lds); PH_END
  PH_BEGIN run_gemm(lds, WSP(const bf16_t, WS_Y), DM, WSP(const bf16_t, WS_W_EVOUT), DM, ML, DM, DM, EpiRes{p.x, p.ctx, p.out, WSP(float, WS_HC), WSP(const float, WS_MOD) + 2 * 1024, 0}); PH_END
  PH_BEGIN
    if (blockIdx.x < 64) { pg8::Gemm g{WSP(const bf16_t, WS_Y) + (size_t)ML * DM, WSP(const bf16_t, WS_W_EVOUT), MC, DM, DM, DM, DM}; pg8::StaticOrder S; S.init(MC, DM, 64, (int)blockIdx.x);
      pg8::gemm_phase<EpiRes, pg8::StaticOrder, true, true>(lds, g, S, EpiRes{p.x, p.ctx, p.out, WSP(float, WS_HC), WSP(const float, WS_MOD) + 2 * 1024, ML}); }
    else phase_norm_mod(p.out, WSP(const float, WS_HC), p.norm2_g, WSP(const float, WS_MOD), 3, 4, WSP(bf16_t, WS_Z), 0, ML, 64, (int)gridDim.x - 64);
  PH_END
  PH_BEGIN phase_norm_mod(p.out, WSP(const float, WS_HC), p.norm2_g, WSP(const float, WS_MOD), 3, 4, WSP(bf16_t, WS_Z), ML, MT); PH_END
  PH_BEGIN run_gemm(lds, WSP(const bf16_t, WS_Z), DM, WSP(const bf16_t, WS_W_UP), DM, MT, FF2, DM, EpiConv{WSP(bf16_t, WS_ACT), WSP(float, WS_HALO), p.ffn_conv_w, p.ffn_conv_b, (LAS float*)(lds + 131072)}); PH_END
  PH_BEGIN { pg8::StaticOrder S; S.init(ML, DM, (int)gridDim.x, (int)blockIdx.x); conv_fix_my_tiles(S, 0, WSP(const float, WS_HALO), WSP(bf16_t, WS_ACT), p.ffn_conv_w, p.ffn_conv_b); }
    run_gemm(lds, WSP(const bf16_t, WS_ACT), FF, WSP(const bf16_t, WS_W_DOWN), FF, ML, DM, FF, EpiRes{p.out, WSP(const float, WS_HC), p.out, WSP(float, WS_HC), WSP(const float, WS_MOD) + 5 * 1024, 0}); PH_END
  PH_BEGIN
    if (blockIdx.x < 64) { pg8::Gemm g{WSP(const bf16_t, WS_ACT) + (size_t)ML * FF, WSP(const bf16_t, WS_W_DOWN), MC, DM, FF, FF, FF}; pg8::StaticOrder S; S.init(MC, DM, 64, (int)blockIdx.x);
      conv_fix_my_tiles(S, 128, WSP(const float, WS_HALO), WSP(bf16_t, WS_ACT), p.ffn_conv_w, p.ffn_conv_b);
      pg8::gemm_phase<EpiRes, pg8::StaticOrder, true, true>(lds, g, S, EpiRes{p.out, WSP(const float, WS_HC), p.out, WSP(float, WS_HC), WSP(const float, WS_MOD) + 5 * 1024, ML}); }
    else phase_norm_mod(p.out, WSP(const float, WS_HC), p.norm1_g + DM, WSP(const float, MOD1), 0, 1, WSP(bf16_t, WS_Z), 0, ML, 64, (int)gridDim.x - 64);
  PH_END
  PH_BEGIN phase_norm_mod(p.out, WSP(const float, WS_HC), p.norm1_g + DM, WSP(const float, MOD1), 0, 1, WSP(bf16_t, WS_Z), ML, MT); PH_END
  PH_BEGIN { pg8::Gemm g{WSP(const bf16_t, WS_Z), WSP(const bf16_t, WS_W_ODIN), MT, OD_PITCH, DM, DM, DM}; OdinOrder S; S.init((int)gridDim.x, (int)blockIdx.x);
    pg8::gemm_phase<EB, OdinOrder, true, true>(lds, g, S, EB{WSP(bf16_t, WS_H), OD_PITCH, nullptr, 0, 0, 1.f}); } PH_END
  PH_BEGIN phase_post_odd(p); PH_END
  PH_BEGIN phase_sgu(p, lds); }
  PH_BEGIN phase_attn_odd(p, lds); PH_END
  PH_BEGIN run_gemm(lds, WSP(const bf16_t, WS_Y), DM, WSP(const bf16_t, WS_W_ODOUT), DM, ML, DM, DM, EpiRes{p.out, WSP(const float, WS_HC), p.out, WSP(float, WS_HC), WSP(const float, MOD1) + 2 * 1024, 0}); PH_END
  PH_BEGIN phase_norm_mod(p.out, WSP(const float, WS_HC), p.norm2_g + DM, WSP(const float, MOD1), 3, 4, WSP(bf16_t, WS_Z), 0, ML); PH_END
  PH_BEGIN run_gemm(lds, WSP(const bf16_t, WS_Z), DM, WSP(const bf16_t, WS_W_UP) + (size_t)FF2 * DM, DM, ML, FF2, DM, EpiConv{WSP(bf16_t, WS_ACT), WSP(float, WS_HALO), p.ffn_conv_w + 3 * FF2, p.ffn_conv_b + FF2, (LAS float*)(lds + 131072)}); PH_END
  PH_BEGIN { pg8::StaticOrder S; S.init(ML, DM, (int)gridDim.x, (int)blockIdx.x); conv_fix_my_tiles(S, 0, WSP(const float, WS_HALO), WSP(bf16_t, WS_ACT), p.ffn_conv_w + 3 * FF2, p.ffn_conv_b + FF2); }
    run_gemm(lds, WSP(const bf16_t, WS_ACT), FF, WSP(const bf16_t, WS_W_DOWN) + (size_t)DM * FF, FF, ML, DM, FF, EpiRes{p.out, WSP(const float, WS_HC), p.out, WSP(float, WS_HC), WSP(const float, MOD1) + 5 * 1024, 0}); PH_END
  { const Params p = load_params(kp); phase_final_norm(p.out, p.final_g); }
#ifdef PROBE_A
  { const Params p = load_params(kp); float* slot = (float*)(p.ws + WS_TAB + 900 * 1024);
    if (blockIdx.x == 0 && threadIdx.x == 0) { slot[0] = (float)(TSL[3] - TSL[2]) * 1e-4f; slot[1] = (float)(TSL[1] - TSL[0]) * 1e-4f; }
    GSYNC();
    const float d = *slot;
    for (int i = blockIdx.x * NT + threadIdx.x; i < (1 << 20); i += gridDim.x * NT) p.out[i] += (i == 0) ? slot[1] : d; }
#endif
}

extern "C" void kernel_launch(void* const* d_in, const int* in_sizes, int n_in, void* d_out, int out_size, void* d_ws, size_t ws_size, hipStream_t stream) {
  static int grid = 0;
  if (grid == 0) {
    int dev = 0, cus = 0, per_cu = 0;
    hipGetDevice(&dev); hipDeviceGetAttribute(&cus, hipDeviceAttributeMultiprocessorCount, dev);
    hipFuncSetAttribute((const void*)fwd_kernel, hipFuncAttributeMaxDynamicSharedMemorySize, LDS_BYTES);
    if (hipOccupancyMaxActiveBlocksPerMultiprocessor(&per_cu, (const void*)fwd_kernel, NT, LDS_BYTES) != hipSuccess || per_cu < 1) per_cu = 1;
    (void)hipGetLastError();
    if (cus <= 0) cus = 256;
    grid = cus;
  }
  Params p{};
  const float** f = (const float**)&p;
  for (int i = 0; i < 28; ++i) f[i] = (const float*)d_in[i];
  p.out = (float*)d_out; p.ws = (unsigned char*)d_ws;
  (void)hipMemsetAsync((unsigned char*)d_ws + WS_BAR, 0, XCD_BAR_WORDS * 4, stream);
  void* args[] = {&p};
  hipError_t e = hipLaunchCooperativeKernel((const void*)fwd_kernel, dim3(grid), dim3(NT), args, LDS_BYTES, stream);
  if (e != hipSuccess) fprintf(stderr, "cooperative launch failed: %s (grid %d)\n", hipGetErrorString(e), grid);
}
```
